# Optimizing an MI355X kernel written in HIP

```python
import math
import jax, jax.numpy as jnp
from jax import lax
import numpy as np

D_MODEL = 1024
BATCH = 8
SEQ = 4096
DEPTH = 4

N_MEM = 256
NSA_HEADS = 8
NSA_KV_GROUPS = 2
NSA_HEAD_DIM = 64
NSA_CMP_LEN = 32
NSA_CMP_STRIDE = 16
NSA_CMP_HIDDEN = 256
NSA_SEL_LEN = 64
NSA_SEL_TOPK = 16
NSA_WINDOW = 512
NSA_Q_BLOCK = 64
NSA_Q_W = NSA_HEADS * NSA_HEAD_DIM
NSA_KV_W = NSA_KV_GROUPS * NSA_HEAD_DIM
RWKV_HEADS = 4
RWKV_HEAD_DIM = 64
RWKV_W = RWKV_HEADS * RWKV_HEAD_DIM
RWKV_DECAY_RANK = 64
RWKV_ICLR_RANK = 64
RWKV_GATE_RANK = 128
RWKV_LN_EPS = 64e-5
RWKV_SPLIT_SIZES = (RWKV_W, RWKV_W, RWKV_W, RWKV_DECAY_RANK, RWKV_ICLR_RANK, RWKV_GATE_RANK)
RWKV_SHIFT_W = 3 * RWKV_W + RWKV_DECAY_RANK + RWKV_ICLR_RANK + RWKV_GATE_RANK
S5_GROUPS = 16
S5_GROUP_WIDTH = 16
S5_STATE = 64
S5_W = S5_GROUPS * S5_GROUP_WIDTH
XA_HEADS = 4
XA_HEAD_DIM = 64
XA_W = XA_HEADS * XA_HEAD_DIM
D_FF = -(-8 * D_MODEL // (3 * 256)) * 256
IN_SPLIT_SIZES = (NSA_Q_W, 6 * NSA_KV_W, 3 * NSA_HEADS, RWKV_SHIFT_W, S5_W, 3 * D_MODEL)
IN_WIDTH = sum(IN_SPLIT_SIZES)
ROPE_THETA = 10000.0
NORM_EPS = 1e-6
NEG_INF = -1e30
SEL_FORCE_SCORE = 1e9

kernel_name = 'hybrid_nsa_rwkv7_s5_gated_trunk'


def _split_last(z, sizes):
    offsets = []
    acc = 0
    for size in sizes[:-1]:
        acc += size
        offsets.append(acc)
    return jnp.split(z, offsets, axis=-1)


def rmsnorm(x, g):
    xf = x.astype(jnp.float32)
    y = xf * lax.rsqrt(jnp.mean(xf * xf, axis=-1, keepdims=True) + NORM_EPS)
    return (y * g.astype(jnp.float32)).astype(x.dtype)


def rope_tables(seq, dim):
    inv = 1.0 / (ROPE_THETA ** (jnp.arange(0, dim, 2, dtype=jnp.float32) / dim))
    ang = jnp.arange(seq, dtype=jnp.float32)[:, None] * inv[None, :]
    return jnp.cos(ang), jnp.sin(ang)


def apply_rope(x, cos, sin):
    x1, x2 = jnp.split(x, 2, axis=-1)
    c = cos[None, :, None, :].astype(x.dtype)
    s = sin[None, :, None, :].astype(x.dtype)
    return jnp.concatenate([x1 * c - x2 * s, x1 * s + x2 * c], axis=-1)


def _compress_blocks(t, pos, w1, w2):
    B, S, G, hd = t.shape
    r = NSA_CMP_LEN // NSA_CMP_STRIDE
    chunks = t.reshape(B, S // NSA_CMP_STRIDE, NSA_CMP_STRIDE, G, hd)
    n_cmp = chunks.shape[1] - r + 1
    blocks = jnp.concatenate([chunks[:, i:i + n_cmp] for i in range(r)], axis=2)
    blocks = blocks + pos[:, None, :]
    flat = blocks.transpose(0, 1, 3, 2, 4).reshape(B, n_cmp, G, NSA_CMP_LEN * hd)
    return jax.nn.gelu(flat @ w1) @ w2


def nsa_attention(q, k_cmp, v_cmp, k_sel, v_sel, k_win, v_win, gates,
                  pos_k, pos_v, ck_w1, ck_w2, cv_w1, cv_w2, cos, sin):
    B, S, H, hd = q.shape
    G = NSA_KV_GROUPS
    R = H // G
    L = NSA_SEL_LEN
    QB = NSA_Q_BLOCK
    W = NSA_WINDOW
    n_sel = S // L
    top_k = min(NSA_SEL_TOPK, n_sel)
    scale = hd ** -0.5

    kc = _compress_blocks(k_cmp, pos_k, ck_w1, ck_w2)
    vc = _compress_blocks(v_cmp, pos_v, cv_w1, cv_w2)
    n_cmp = kc.shape[1]
    cmp_start = np.arange(n_cmp) * NSA_CMP_STRIDE
    sel_start = np.arange(n_sel) * L
    overlap = jnp.asarray(((cmp_start[:, None] < sel_start[None, :] + L) &
                           (cmp_start[:, None] + NSA_CMP_LEN > sel_start[None, :])).astype(np.float32))
    cmp_end = jnp.arange(n_cmp) * NSA_CMP_STRIDE + (NSA_CMP_LEN - 1)

    q_grp = q.reshape(B, S, G, R, hd)
    q_rot = apply_rope(q, cos, sin).reshape(B, S, G, R, hd)
    ks_blocks = apply_rope(k_sel, cos, sin).reshape(B, n_sel, L, G, hd).transpose(0, 3, 1, 2, 4)
    vs_blocks = v_sel.reshape(B, n_sel, L, G, hd).transpose(0, 3, 1, 2, 4)
    pad = ((0, 0), (W, 0), (0, 0), (0, 0))
    kw_pad = jnp.pad(apply_rope(k_win, cos, sin), pad)
    vw_pad = jnp.pad(v_win, pad)
    gates = gates.reshape(B, S, G, R, 3)
    b_ix = jnp.arange(B)[:, None, None]
    g_ix = jnp.arange(G)[None, :, None]
    blk = jnp.arange(n_sel)
    tok = jnp.arange(L)

    def query_block(c):
        t0 = c * QB
        t = t0 + jnp.arange(QB)
        qc = lax.dynamic_slice_in_dim(q_grp, t0, QB, axis=1)
        qr = lax.dynamic_slice_in_dim(q_rot, t0, QB, axis=1)
        gc = lax.dynamic_slice_in_dim(gates, t0, QB, axis=1)
        s = jnp.einsum('bqgrd,bngd->bgrqn', qc, kc).astype(jnp.float32) * scale
        ok = cmp_end[None, :] <= t[:, None]
        p_cmp = jax.nn.softmax(jnp.where(ok, s, NEG_INF), axis=-1) * (t >= NSA_CMP_LEN - 1)[:, None]
        o_cmp = jnp.einsum('bgrqn,bngd->bqgrd', p_cmp.astype(vc.dtype), vc)
        imp = jnp.einsum('bgrqn,nj->bgqj', p_cmp, overlap)
        cur = (t // L)[:, None]
        forced = (blk == 0) | (blk == cur) | (blk == cur - 1)
        imp = jnp.where(blk <= cur, jnp.where(forced, SEL_FORCE_SCORE, imp), NEG_INF)
        _, idx = lax.top_k(imp, top_k)
        idx_flat = idx.reshape(B, G, QB * top_k)
        ks = ks_blocks[b_ix, g_ix, idx_flat].reshape(B, G, QB, top_k, L, hd)
        vs = vs_blocks[b_ix, g_ix, idx_flat].reshape(B, G, QB, top_k, L, hd)
        key_pos = idx[..., None] * L + tok
        ok = key_pos <= t[:, None, None]
        s = jnp.einsum('bqgrd,bgqkld->bgrqkl', qr, ks).astype(jnp.float32) * scale
        s = jnp.where(ok[:, :, None], s, NEG_INF).reshape(B, G, R, QB, top_k * L)
        p = jax.nn.softmax(s, axis=-1).reshape(B, G, R, QB, top_k, L).astype(vs.dtype)
        o_sel = jnp.einsum('bgrqkl,bgqkld->bqgrd', p, vs)
        kw = lax.dynamic_slice_in_dim(kw_pad, t0, QB + W, axis=1)
        vw = lax.dynamic_slice_in_dim(vw_pad, t0, QB + W, axis=1)
        pos = t0 - W + jnp.arange(QB + W)
        ok = (pos[None, :] <= t[:, None]) & (pos[None, :] > t[:, None] - W) & (pos[None, :] >= 0)
        s = jnp.einsum('bqgrd,bkgd->bgrqk', qr, kw).astype(jnp.float32) * scale
        p = jax.nn.softmax(jnp.where(ok, s, NEG_INF), axis=-1).astype(vw.dtype)
        o_win = jnp.einsum('bgrqk,bkgd->bqgrd', p, vw)
        o = gc[..., 0:1] * o_cmp + gc[..., 1:2] * o_sel + gc[..., 2:3] * o_win
        return o.reshape(B, QB, H * hd)

    out = lax.map(query_block, jnp.arange(S // QB))
    return out.transpose(1, 0, 2, 3).reshape(B, S, H * hd)


def rwkv7_time_mix(z, mu, w0, w2, a0, a2, g2, k_k, k_a, r_k, ln_w, ln_b):
    B, S, _ = z.shape
    H, N = RWKV_HEADS, RWKV_HEAD_DIM
    z_prev = jnp.pad(z, ((0, 0), (1, 0), (0, 0)))[:, :-1]
    z = z + (z_prev - z) * mu
    r, k, v, w_lr, a_lr, g_lr = _split_last(z, RWKV_SPLIT_SIZES)
    w = -jax.nn.softplus(-(w0 + jnp.tanh(w_lr) @ w2)) - 0.5
    decay = jnp.exp(-jnp.exp(w.astype(jnp.float32)))
    a = jax.nn.sigmoid(a0 + a_lr @ a2)
    g = jax.nn.sigmoid(g_lr) @ g2

    def heads(t):
        return t.astype(jnp.float32).reshape(B, S, H, N)

    kk = heads(k * k_k)
    kk = kk / jnp.maximum(jnp.linalg.norm(kk, axis=-1, keepdims=True), 1e-12)
    k = k * (1.0 + (a - 1.0) * k_a)
    r, k, v, a, decay = heads(r), heads(k), heads(v), heads(a), heads(decay)

    def step(state, inp):
        r_t, k_t, v_t, kk_t, a_t, w_t = inp
        sa = jnp.einsum('bhvk,bhk->bhv', state, -kk_t)
        state = (state * w_t[:, :, None, :]
                 + sa[..., None] * (kk_t * a_t)[:, :, None, :]
                 + v_t[..., None] * k_t[:, :, None, :])
        return state, jnp.einsum('bhvk,bhk->bhv', state, r_t)

    xs = tuple(jnp.swapaxes(t, 0, 1) for t in (r, k, v, kk, a, decay))
    _, y = lax.scan(step, jnp.zeros((B, H, N, N), jnp.float32), xs)
    y = jnp.swapaxes(y, 0, 1)
    mean = jnp.mean(y, axis=-1, keepdims=True)
    var = jnp.mean(jnp.square(y - mean), axis=-1, keepdims=True)
    yn = ((y - mean) * lax.rsqrt(var + RWKV_LN_EPS)).reshape(B, S, RWKV_W) * ln_w + ln_b
    bonus = (jnp.sum(r * k * r_k.astype(jnp.float32), axis=-1, keepdims=True) * v).reshape(B, S, RWKV_W)
    return ((yn + bonus) * g).astype(z.dtype)


def _complex_affine_combine(e1, e2):
    a1r, a1i, b1r, b1i = e1
    a2r, a2i, b2r, b2i = e2
    ar = a1r * a2r - a1i * a2i
    ai = a1r * a2i + a1i * a2r
    br = a2r * b1r - a2i * b1i + b2r
    bi = a2r * b1i + a2i * b1r + b2i
    return ar, ai, br, bi


def s5_layer(u, lam_re, lam_im, log_dt, b_re, b_im, c_re, c_im, d, w_glu):
    B, S, _ = u.shape
    uf = u.astype(jnp.float32).reshape(B, S, S5_GROUPS, S5_GROUP_WIDTH)
    dt = jnp.exp(log_dt.astype(jnp.float32))[:, None]
    lr = lam_re.astype(jnp.float32)
    li = lam_im.astype(jnp.float32)
    mag = jnp.exp(lr * dt)
    abar_re = mag * jnp.cos(li * dt)
    abar_im = mag * jnp.sin(li * dt)
    den = lr * lr + li * li
    coef_re = ((abar_re - 1.0) * lr + abar_im * li) / den
    coef_im = (abar_im * lr - (abar_re - 1.0) * li) / den
    bu_re = jnp.einsum('bsgh,gph->bsgp', uf, b_re.astype(jnp.float32))
    bu_im = jnp.einsum('bsgh,gph->bsgp', uf, b_im.astype(jnp.float32))
    in_re = coef_re * bu_re - coef_im * bu_im
    in_im = coef_re * bu_im + coef_im * bu_re
    a_re = jnp.broadcast_to(abar_re, (1, S) + abar_re.shape)
    a_im = jnp.broadcast_to(abar_im, (1, S) + abar_im.shape)
    _, _, x_re, x_im = lax.associative_scan(_complex_affine_combine, (a_re, a_im, in_re, in_im), axis=1)
    y = (jnp.einsum('bsgp,ghp->bsgh', x_re, c_re.astype(jnp.float32))
         - jnp.einsum('bsgp,ghp->bsgh', x_im, c_im.astype(jnp.float32))
         + d.astype(jnp.float32) * uf)
    y = jax.nn.gelu(y.reshape(B, S, S5_W))
    y = y * jax.nn.sigmoid(y @ w_glu.astype(jnp.float32))
    return y.astype(u.dtype)


def hybrid_mixer(h, w_in, nsa_cmp_pos_k, nsa_cmp_pos_v, nsa_ck_w1, nsa_ck_w2, nsa_cv_w1, nsa_cv_w2,
                 rwkv_mu, rwkv_w0, rwkv_w2, rwkv_a0, rwkv_a2, rwkv_g2, rwkv_k_k, rwkv_k_a, rwkv_r_k,
                 rwkv_ln_w, rwkv_ln_b, s5_lam_re, s5_lam_im, s5_log_dt, s5_b_re, s5_b_im, s5_c_re,
                 s5_c_im, s5_d, s5_w_glu, w_up_nsa, w_up_rwkv, w_up_s5, w_out, cos, sin):
    B, S, _ = h.shape
    z = h @ w_in
    z_q, z_kv, z_ng, z_rwkv, z_s5, z_mg = _split_last(z, IN_SPLIT_SIZES)
    q = z_q.reshape(B, S, NSA_HEADS, NSA_HEAD_DIM)
    kvs = [t.reshape(B, S, NSA_KV_GROUPS, NSA_HEAD_DIM) for t in jnp.split(z_kv, 6, axis=-1)]
    nsa_gates = jax.nn.sigmoid(z_ng).reshape(B, S, NSA_HEADS, 3)
    y_nsa = nsa_attention(q, kvs[0], kvs[1], kvs[2], kvs[3], kvs[4], kvs[5], nsa_gates,
                          nsa_cmp_pos_k, nsa_cmp_pos_v, nsa_ck_w1, nsa_ck_w2, nsa_cv_w1, nsa_cv_w2, cos, sin)
    y_rwkv = rwkv7_time_mix(z_rwkv, rwkv_mu, rwkv_w0, rwkv_w2, rwkv_a0, rwkv_a2, rwkv_g2,
                            rwkv_k_k, rwkv_k_a, rwkv_r_k, rwkv_ln_w, rwkv_ln_b)
    y_s5 = s5_layer(z_s5, s5_lam_re, s5_lam_im, s5_log_dt, s5_b_re, s5_b_im, s5_c_re, s5_c_im, s5_d, s5_w_glu)
    g_nsa, g_rwkv, g_s5 = jnp.split(jax.nn.sigmoid(z_mg), 3, axis=-1)
    merged = g_nsa * (y_nsa @ w_up_nsa) + g_rwkv * (y_rwkv @ w_up_rwkv) + g_s5 * (y_s5 @ w_up_s5)
    return merged @ w_out


def cross_attention(h, m, w_q, w_k, w_v, w_o):
    B, S, _ = h.shape
    M = m.shape[1]
    q = (h @ w_q).reshape(B, S, XA_HEADS, XA_HEAD_DIM)
    k = (m @ w_k).reshape(B, M, XA_HEADS, XA_HEAD_DIM)
    v = (m @ w_v).reshape(B, M, XA_HEADS, XA_HEAD_DIM)
    s = jnp.einsum('bshd,bmhd->bhsm', q, k).astype(jnp.float32) * (XA_HEAD_DIM ** -0.5)
    p = jax.nn.softmax(s, axis=-1).astype(v.dtype)
    return jnp.einsum('bhsm,bmhd->bshd', p, v).reshape(B, S, XA_W) @ w_o


def swiglu_ffn(h, w_gate, w_up, w_down):
    return (jax.nn.silu(h @ w_gate) * (h @ w_up)) @ w_down


def setup_inputs(seed: int = 0) -> dict:
    key = jax.random.key(seed)
    split = jax.random.split(key, 64)
    keys = iter([split[i] for i in range(64)])

    def normal(shape, scale):
        return jax.random.normal(next(keys), shape, jnp.float32) * scale

    def uniform(shape, lo, hi):
        return jax.random.uniform(next(keys), shape, jnp.float32, lo, hi)

    L = DEPTH
    hd = NSA_HEAD_DIM
    ramp = (jnp.arange(RWKV_W, dtype=jnp.float32) / (RWKV_W - 1)) ** 0.7
    lam_im_base = math.pi * jnp.arange(S5_STATE, dtype=jnp.float32)
    return {
        'x': normal((BATCH, SEQ, D_MODEL), 1.0),
        'mem': normal((BATCH, N_MEM, D_MODEL), 1.0),
        'norm_gains': 1.0 + normal((L, 6, D_MODEL), 0.05),
        'mem_norm': 1.0 + normal((L, D_MODEL), 0.05),
        'w_in': normal((L, D_MODEL, IN_WIDTH), D_MODEL ** -0.5),
        'nsa_cmp_pos_k': normal((L, NSA_CMP_LEN, hd), 0.02),
        'nsa_cmp_pos_v': normal((L, NSA_CMP_LEN, hd), 0.02),
        'nsa_ck_w1': normal((L, NSA_CMP_LEN * hd, NSA_CMP_HIDDEN), (NSA_CMP_LEN * hd) ** -0.5),
        'nsa_ck_w2': normal((L, NSA_CMP_HIDDEN, hd), NSA_CMP_HIDDEN ** -0.5),
        'nsa_cv_w1': normal((L, NSA_CMP_LEN * hd, NSA_CMP_HIDDEN), (NSA_CMP_LEN * hd) ** -0.5),
        'nsa_cv_w2': normal((L, NSA_CMP_HIDDEN, hd), NSA_CMP_HIDDEN ** -0.5),
        'rwkv_mu': uniform((L, RWKV_SHIFT_W), 0.0, 1.0),
        'rwkv_w0': -6.0 + 5.0 * ramp + normal((L, RWKV_W), 0.1),
        'rwkv_w2': normal((L, RWKV_DECAY_RANK, RWKV_W), 0.1 * RWKV_DECAY_RANK ** -0.5),
        'rwkv_a0': normal((L, RWKV_W), 0.1),
        'rwkv_a2': normal((L, RWKV_ICLR_RANK, RWKV_W), RWKV_ICLR_RANK ** -0.5),
        'rwkv_g2': normal((L, RWKV_GATE_RANK, RWKV_W), RWKV_GATE_RANK ** -0.5),
        'rwkv_k_k': 0.85 + normal((L, RWKV_W), 0.02),
        'rwkv_k_a': 1.0 + normal((L, RWKV_W), 0.02),
        'rwkv_r_k': normal((L, RWKV_HEADS, RWKV_HEAD_DIM), 0.1),
        'rwkv_ln_w': 1.0 + normal((L, RWKV_W), 0.05),
        'rwkv_ln_b': normal((L, RWKV_W), 0.02),
        's5_lam_re': -0.5 + normal((L, S5_GROUPS, S5_STATE), 0.01),
        's5_lam_im': lam_im_base + normal((L, S5_GROUPS, S5_STATE), 0.01),
        's5_log_dt': uniform((L, S5_GROUPS), math.log(1e-3), math.log(1e-1)),
        's5_b_re': normal((L, S5_GROUPS, S5_STATE, S5_GROUP_WIDTH), (2 * S5_GROUP_WIDTH) ** -0.5),
        's5_b_im': normal((L, S5_GROUPS, S5_STATE, S5_GROUP_WIDTH), (2 * S5_GROUP_WIDTH) ** -0.5),
        's5_c_re': normal((L, S5_GROUPS, S5_GROUP_WIDTH, S5_STATE), S5_STATE ** -0.5),
        's5_c_im': normal((L, S5_GROUPS, S5_GROUP_WIDTH, S5_STATE), S5_STATE ** -0.5),
        's5_d': normal((L, S5_GROUPS, S5_GROUP_WIDTH), 1.0),
        's5_w_glu': normal((L, S5_W, S5_W), S5_W ** -0.5),
        'w_up_nsa': normal((L, NSA_Q_W, D_MODEL), NSA_Q_W ** -0.5),
        'w_up_rwkv': normal((L, RWKV_W, D_MODEL), RWKV_W ** -0.5),
        'w_up_s5': normal((L, S5_W, D_MODEL), S5_W ** -0.5),
        'w_out': normal((L, D_MODEL, D_MODEL), D_MODEL ** -0.5),
        'xa_w_q': normal((L, D_MODEL, XA_W), D_MODEL ** -0.5),
        'xa_w_k': normal((L, D_MODEL, XA_W), D_MODEL ** -0.5),
        'xa_w_v': normal((L, D_MODEL, XA_W), D_MODEL ** -0.5),
        'xa_w_o': normal((L, XA_W, D_MODEL), XA_W ** -0.5),
        'ffn_w_gate': normal((L, D_MODEL, D_FF), D_MODEL ** -0.5),
        'ffn_w_up': normal((L, D_MODEL, D_FF), D_MODEL ** -0.5),
        'ffn_w_down': normal((L, D_FF, D_MODEL), D_FF ** -0.5),
    }


def reference(x, mem, norm_gains, mem_norm, w_in, nsa_cmp_pos_k, nsa_cmp_pos_v, nsa_ck_w1, nsa_ck_w2,
              nsa_cv_w1, nsa_cv_w2, rwkv_mu, rwkv_w0, rwkv_w2, rwkv_a0, rwkv_a2, rwkv_g2, rwkv_k_k,
              rwkv_k_a, rwkv_r_k, rwkv_ln_w, rwkv_ln_b, s5_lam_re, s5_lam_im, s5_log_dt, s5_b_re,
              s5_b_im, s5_c_re, s5_c_im, s5_d, s5_w_glu, w_up_nsa, w_up_rwkv, w_up_s5, w_out,
              xa_w_q, xa_w_k, xa_w_v, xa_w_o, ffn_w_gate, ffn_w_up, ffn_w_down):
    cos, sin = rope_tables(x.shape[1], NSA_HEAD_DIM)
    for l in range(DEPTH):
        h = rmsnorm(x, norm_gains[l, 0])
        y = hybrid_mixer(h, w_in[l], nsa_cmp_pos_k[l], nsa_cmp_pos_v[l], nsa_ck_w1[l], nsa_ck_w2[l],
                         nsa_cv_w1[l], nsa_cv_w2[l], rwkv_mu[l], rwkv_w0[l], rwkv_w2[l], rwkv_a0[l],
                         rwkv_a2[l], rwkv_g2[l], rwkv_k_k[l], rwkv_k_a[l], rwkv_r_k[l], rwkv_ln_w[l],
                         rwkv_ln_b[l], s5_lam_re[l], s5_lam_im[l], s5_log_dt[l], s5_b_re[l], s5_b_im[l],
                         s5_c_re[l], s5_c_im[l], s5_d[l], s5_w_glu[l], w_up_nsa[l], w_up_rwkv[l],
                         w_up_s5[l], w_out[l], cos, sin)
        x = x + rmsnorm(y, norm_gains[l, 1])
        h = rmsnorm(x, norm_gains[l, 2])
        m = rmsnorm(mem, mem_norm[l])
        x = x + rmsnorm(cross_attention(h, m, xa_w_q[l], xa_w_k[l], xa_w_v[l], xa_w_o[l]), norm_gains[l, 3])
        h = rmsnorm(x, norm_gains[l, 4])
        x = x + rmsnorm(swiglu_ffn(h, ffn_w_gate[l], ffn_w_up[l], ffn_w_down[l]), norm_gains[l, 5])
    return x
```

```cpp
#include <hip/hip_runtime.h>
#include <stdint.h>
#include <cstdio>

#ifndef MK_N_LAUNCHES
#define MK_N_LAUNCHES 1
#endif

#ifndef ONLY_PHASE
#define ONLY_PHASE -1
#endif
#define PON(k) (ONLY_PHASE < 0 || ONLY_PHASE == (k))
#define LAS __attribute__((address_space(3)))
typedef unsigned short bf16_t;
typedef short bf16x8 __attribute__((ext_vector_type(8)));
typedef short bf16x4 __attribute__((ext_vector_type(4)));
typedef float f32x4 __attribute__((ext_vector_type(4)));
typedef float f32x2 __attribute__((ext_vector_type(2)));
typedef unsigned u32x4 __attribute__((ext_vector_type(4)));
typedef unsigned u32x2 __attribute__((ext_vector_type(2)));
typedef unsigned long long u64;

constexpr int NB = 8, SEQ = 4096, DM = 1024, TOK = NB * SEQ, DEPTH = 4;
constexpr int INW = 5656, DFF = 2816;
constexpr int NTHR = 512;
constexpr int PH_PER_LAYER = 17, N_PHASES = 1 + DEPTH * PH_PER_LAYER;
constexpr int REPS[18] = {1, 1, 1, 1, 1, 1, 1, 1, 1, 1, 1, 1, 1, 1, 1, 1, 1, 1};
constexpr int REP_P4A = 1, REP_P4B = 1;
#define PROBE_EXP2X 0
#define PROBE_MFMA2X 0
constexpr int REP_NSA = 1, REP_S5P2 = 1, REP_PREP = 1, REP_S5P1 = 1, REP_CMPG = 1;

constexpr size_t MiB = 1ull << 20;
constexpr size_t WS_CTL = 0;
constexpr size_t CTL_BYTES = 32768;
constexpr size_t WS_ROPE = 1 * MiB;
constexpr size_t WS_MISC = 2 * MiB;
constexpr size_t WS_KCC = WS_MISC;
constexpr size_t WS_VCCT = WS_MISC + 512 * 1024;
constexpr size_t WS_XEND = WS_MISC + 1 * MiB;
constexpr size_t WS_KX = WS_MISC + 2 * MiB;
constexpr size_t WS_VXT = WS_MISC + 3 * MiB;
constexpr size_t WS_MEMN = WS_MISC + 4 * MiB;
constexpr size_t WS_BONUS = WS_MISC + 8 * MiB;
constexpr size_t WS_CBIAS = WS_MISC + 9 * MiB;
constexpr size_t WS_W = 18 * MiB;
constexpr size_t W_IN1 = WS_W + 0, W_MG = WS_W + 6 * MiB, W_UPN = WS_W + 12 * MiB, W_UPR = WS_W + 13 * MiB, W_UPS = WS_W + 13 * MiB + 512 * 1024,
                 W_OUT = WS_W + 14 * MiB, W_C1K = WS_W + 16 * MiB, W_C1V = WS_W + 17 * MiB, W_XQ = WS_W + 18 * MiB, W_XKV = WS_W + 19 * MiB,
                 W_XO = WS_W + 20 * MiB, W_GLU = WS_W + 21 * MiB, W_LORA = WS_W + 21 * MiB + 512 * 1024, W_GU = WS_W + 22 * MiB, W_DN = WS_W + 33 * MiB;
constexpr size_t WS_H = 58 * MiB;
constexpr size_t WS_Q = 122 * MiB, WS_KC = 154 * MiB, WS_VC = 162 * MiB, WS_KS = 170 * MiB, WS_KW = 178 * MiB, WS_YS5 = 186 * MiB,
                 WS_VST = 202 * MiB, WS_VWT = 210 * MiB, WS_NG = 218 * MiB, WS_ZR = 220 * MiB, WS_ZS = 284 * MiB,
                 WS_YSCAN = 300 * MiB, WS_YS5G = 332 * MiB, WS_LIN = 364 * MiB, WS_RG = 380 * MiB, WS_LW = 396 * MiB, WS_LA = 412 * MiB,
                 WS_PQ = 428 * MiB, WS_END = 508 * MiB;
constexpr size_t WS_CS_AR = 476 * MiB, WS_CS_BKT = 348 * MiB, WS_CS_VMT = 154 * MiB, WS_CS_AAK = 186 * MiB, WS_CS_ARBK = 190 * MiB, WS_CS_GAM = 198 * MiB, WS_CS_MM = 428 * MiB;
constexpr size_t WS_XLAST = 300 * MiB;
constexpr size_t WS_YCAT = 220 * MiB;
constexpr size_t WS_G = 284 * MiB  , WS_MERGED = 122 * MiB, WS_YOUT = 364 * MiB;
constexpr size_t WS_QX = 122 * MiB, WS_XAO = 138 * MiB, WS_A2 = 122 * MiB;
constexpr int CTL_Q0 = 4096;

constexpr int LDS_STAGE = 131072;
constexpr int LDS_CTL_OFF = LDS_STAGE;
constexpr int LDS_BYTES = LDS_STAGE + 256;

struct Params { const float* in[42]; float* out; unsigned char* ws; int ph_lo, ph_hi; };

__device__ __forceinline__ float bf2f(bf16_t b) { return __uint_as_float(((unsigned)b) << 16); }
__device__ __forceinline__ float bflo(unsigned w) { return __uint_as_float(w << 16); }
__device__ __forceinline__ float bfhi(unsigned w) { return __uint_as_float(w & 0xffff0000u); }
__device__ __forceinline__ bf16_t f2bf(float f) { unsigned u = __float_as_uint(f); u += 0x7FFFu + ((u >> 16) & 1u); return (bf16_t)(u >> 16); }
__device__ __forceinline__ unsigned pk2(float lo, float hi) { return (unsigned)f2bf(lo) | ((unsigned)f2bf(hi) << 16); }
__device__ __forceinline__ float sigmoidf_(float x) { return __builtin_amdgcn_rcpf(1.0f + __expf(-x)); }
__device__ __forceinline__ float gelu_tanh(float x) { const float u = 0.7978845608028654f * (x + 0.044715f * x * x * x); return 0.5f * x * (1.0f + tanhf(u)); }
template <int CTRL> __device__ __forceinline__ float dpp_mov(float x) { return __int_as_float(__builtin_amdgcn_update_dpp(0, __float_as_int(x), CTRL, 0xF, 0xF, false)); }
__device__ __forceinline__ float quad_sum(float x) { x += dpp_mov<0xB1>(x); x += dpp_mov<0x4E>(x); return x; }
__device__ __forceinline__ float row16_sum(float x) { x = quad_sum(x); x += dpp_mov<0x141>(x); x += dpp_mov<0x140>(x); return x; }

__device__ __forceinline__ float xmax16(float x) { const unsigned u = __float_as_uint(x); auto r = __builtin_amdgcn_permlane16_swap(u, u, false, false); return fmaxf(__uint_as_float(r[0]), __uint_as_float(r[1])); }
__device__ __forceinline__ float xmax32(float x) { const unsigned u = __float_as_uint(x); auto r = __builtin_amdgcn_permlane32_swap(u, u, false, false); return fmaxf(__uint_as_float(r[0]), __uint_as_float(r[1])); }
__device__ __forceinline__ float xsum16(float x) { const unsigned u = __float_as_uint(x); auto r = __builtin_amdgcn_permlane16_swap(u, u, false, false); return __uint_as_float(r[0]) + __uint_as_float(r[1]); }
__device__ __forceinline__ float xsum32(float x) { const unsigned u = __float_as_uint(x); auto r = __builtin_amdgcn_permlane32_swap(u, u, false, false); return __uint_as_float(r[0]) + __uint_as_float(r[1]); }

__device__ __forceinline__ float wave_sum(float v) { v = row16_sum(v); v = xsum16(v); return xsum32(v); }

#define XB_TMO      128
#define XB_XCNT(j)  (256  + 64 * (j))
#define XB_XSUB(j)  (1280 + 64 * (j))
#define XB_XGEN(j)  (2304 + 64 * (j))
#define XB_TOP      3328
#define XB_TOPGEN   3392
#define XCD_BAR_WORDS 3456
#define XB_SPIN_CAP (1u << 18)
__device__ __forceinline__ unsigned xb_ld(unsigned* p)              { return __hip_atomic_load(p, __ATOMIC_RELAXED, __HIP_MEMORY_SCOPE_AGENT); }
__device__ __forceinline__ unsigned xb_add(unsigned* p, unsigned v) { return __hip_atomic_fetch_add(p, v, __ATOMIC_RELAXED, __HIP_MEMORY_SCOPE_AGENT); }
__device__ __forceinline__ unsigned xb_xcc_id() { return (unsigned)__builtin_amdgcn_s_getreg((3 << 11) | 20) & 0xFu; }
#define XB_SPIN(cond, bar) do { unsigned _sp = 0; while (cond) { __builtin_amdgcn_s_sleep(1); \
    if ((++_sp & 255u) == 0u) { if (xb_ld(&(bar)[XB_TMO])) break; if (_sp > XB_SPIN_CAP) { atomicAdd(&(bar)[XB_TMO], 1u); break; } } } } while (0)
struct XcdBarrier { unsigned* bar; unsigned x; volatile LAS unsigned* st; };
__device__ __forceinline__ XcdBarrier xcd_barrier_post(unsigned* bar, volatile LAS unsigned* st) {
    XcdBarrier b; b.bar = bar; b.x = xb_xcc_id(); b.st = st;
    if (threadIdx.x == 0) (void)xb_add(&bar[XB_XCNT(b.x)], 1u);
    return b;
}
__device__ __forceinline__ void xcd_barrier_complete(unsigned* bar, unsigned x, unsigned& nloc, unsigned& nx) {
    const unsigned G = gridDim.x * gridDim.y * gridDim.z;
    unsigned sum, cnt, mine, sp = 0u;
    for (;;) {
        sum = 0u; cnt = 0u; mine = 0u;
#pragma unroll
        for (unsigned j = 0; j < 16; ++j) { const unsigned c = xb_ld(&bar[XB_XCNT(j)]); sum += c; cnt += (c > 0u) ? 1u : 0u; mine = (j == x) ? c : mine; }
        if (sum == G) break;
        __builtin_amdgcn_s_sleep(1);
        if ((++sp & 255u) == 0u) { if (xb_ld(&bar[XB_TMO])) break; if (sp > XB_SPIN_CAP) { atomicAdd(&bar[XB_TMO], 1u); break; } }
    }
    nloc = mine > 0u ? mine : 1u; nx = cnt > 0u ? cnt : 1u;
}
__device__ __forceinline__ void xcd_barrier(const XcdBarrier& b) {
    asm volatile("s_waitcnt vmcnt(0)" ::: "memory");
    __syncthreads();
    if (threadIdx.x == 0) {
        unsigned* bar = b.bar;
        __builtin_amdgcn_s_waitcnt(0);
        unsigned nloc = b.st[0], nx = b.st[1];
        if (nloc == 0u) { xcd_barrier_complete(bar, b.x, nloc, nx); b.st[0] = nloc; b.st[1] = nx; }
        const unsigned old = xb_add(&bar[XB_XSUB(b.x)], 1u);
        const unsigned gen = old / nloc;
        if (old + 1u == (gen + 1u) * nloc) {
            __builtin_amdgcn_fence(__ATOMIC_RELEASE, "agent");
            asm volatile("s_waitcnt vmcnt(0)" ::: "memory");
            const unsigned og = xb_add(&bar[XB_TOP], 1u);
            const unsigned tg = og / nx;
            if (og + 1u == (tg + 1u) * nx) xb_add(&bar[XB_TOPGEN], 1u);
            else XB_SPIN(xb_ld(&bar[XB_TOPGEN]) == tg, bar);
            __builtin_amdgcn_fence(__ATOMIC_ACQUIRE, "agent");
            xb_add(&bar[XB_XGEN(b.x)], 1u);
            asm volatile("s_waitcnt vmcnt(0)" ::: "memory");
        } else {
            XB_SPIN(xb_ld(&bar[XB_XGEN(b.x)]) == gen, bar);
            __builtin_amdgcn_fence(__ATOMIC_ACQUIRE, "agent");
            asm volatile("s_waitcnt vmcnt(0)" ::: "memory");
        }
    }
    __syncthreads();
}

namespace pg8 {
#define PG8_LAS __attribute__((address_space(3)))
constexpr int BM = 256, BK = 64, HALF = 128, HTB = HALF * BK * 2, STAGE_BYTES = 8 * HTB, NXCD = 8, WGM = 8;
__host__ __device__ __forceinline__ int lds_byte(int r, int c) { const int st = (r >> 4) * 2 + (c >> 5), rr = r & 15, cc = c & 31, ob = rr * 64 + cc * 2; return st * 1024 + (ob ^ (((ob >> 9) & 1) << 5)); }
__host__ __device__ __forceinline__ void stage_rc(int b, int& R, int& C) { const int st = b / 1024, sb = b % 1024, swz = sb ^ (((sb >> 9) & 1) << 5); R = (st >> 1) * 16 + swz / 64; C = (st & 1) * 32 + (swz % 64) / 2; }
__host__ __device__ __forceinline__ int perm32(int rho) { const int n = rho >> 4, i = rho & 15; return 8 * (i >> 2) + 4 * n + (i & 3); }
struct Unit { int pm, pn; };
struct Gemm { const bf16_t* A; const bf16_t* Bt; int M, N, K; };
struct StaticOrder {
    int nM, nN, nwg, G, c;
    __host__ __device__ void init(int M, int N, int G_, int c_) { nM = M / BM; nN = N / BM; nwg = nM * nN; G = G_; c = c_; }
    __host__ __device__ bool next(int i, Unit& u) const {
        const long L = (long)i * G + c; if (L >= nwg) return false;
        int wgid = (int)L; { const int q = nwg / NXCD, r = nwg % NXCD, xcd = wgid % NXCD, off = wgid / NXCD; wgid = (xcd < r ? xcd * (q + 1) : r * (q + 1) + (xcd - r) * q) + off; }
        const int nig = WGM * nN, gid = wgid / nig, fm = gid * WGM, gsz = (nM - fm) < WGM ? (nM - fm) : WGM;
        u.pm = fm + ((wgid % nig) % gsz); u.pn = (wgid % nig) / gsz; return true;
    }
    __device__ __forceinline__ void a_ready(const Unit&) const {}
    __device__ __forceinline__ void done(const Unit&) const {}
};
typedef __bf16 bf16v2_t __attribute__((ext_vector_type(2)));
typedef float f32x2_t __attribute__((ext_vector_type(2)));
typedef __bf16 bf16v4_t __attribute__((ext_vector_type(4)));
typedef __bf16 bf16v8_t __attribute__((ext_vector_type(8)));
typedef float f32x8_t __attribute__((ext_vector_type(8)));
typedef unsigned u32x2_t __attribute__((ext_vector_type(2)));
__device__ __forceinline__ unsigned cvt_pk_bf16(float lo, float hi) { const f32x2_t f = {lo, hi}; return __builtin_bit_cast(unsigned, __builtin_convertvector(f, bf16v2_t)); }
__device__ __forceinline__ u32x2_t cvt4_bf16(const f32x4 a) { return __builtin_bit_cast(u32x2_t, __builtin_convertvector(a, bf16v4_t)); }
__device__ __forceinline__ bf16x8 cvt8_bf16(const f32x4 a, const f32x4 b) { const f32x8_t f = __builtin_shufflevector(a, b, 0, 1, 2, 3, 4, 5, 6, 7); return __builtin_bit_cast(bf16x8, __builtin_convertvector(f, bf16v8_t)); }

struct NoHook { static constexpr bool ACTIVE = false; __device__ __forceinline__ void operator()(f32x4 (&)[2][2][4][2], const Unit&, int, int, int, int, int) const {} };
template <class Epi, class Sched, class Hook = NoHook>
__device__ __forceinline__ void gemm_phase(PG8_LAS unsigned char* lds, const Gemm g, const Sched& S, const Epi& E, const int tid, const Hook& H = Hook()) {
    const int wid = __builtin_amdgcn_readfirstlane(tid >> 6), lane = tid & 63, wr = wid >> 2, wc = wid & 3, fr = lane & 15, fq = lane >> 4;
    const int K = g.K, nt = K / BK;
    unsigned voffA[2], voffB[2];
#pragma unroll
    for (int i = 0; i < 2; ++i) { int R, C; stage_rc(tid * 16 + i * 8192, R, C); const int Rb = Epi::PERM ? ((R & ~31) + perm32(R & 31)) : R;
        voffA[i] = (unsigned)(R * K + C) * 2u; voffB[i] = (unsigned)(Rb * K + C) * 2u; }
    const size_t kstep = (size_t)(BK * 2);
    const size_t hstep = (size_t)HALF * K * 2;
    const size_t tstep = 2 * hstep;
    const unsigned ldsw = (unsigned)wid * 1024u;
    const int aoff = lds_byte(wr * 64 + fr, fq * 8), boff = lds_byte(wc * 32 + fr, fq * 8);
#define PG8_SA(b, h) (((b) * 2 + (h)) * HTB)
#define PG8_SB(b, h) ((4 + (b) * 2 + (h)) * HTB)
#define PG8_STAGE(bufoff, gbase, voff) do { _Pragma("unroll") for (int _i = 0; _i < 2; ++_i) \
        __builtin_amdgcn_global_load_lds((const unsigned*)((const char*)(gbase) + (voff)[_i]), (PG8_LAS unsigned*)(lds + (bufoff) + ldsw + _i * 8192), 16, 0, 0); } while (0)
#define PG8_LDA(dst, b, h) do { _Pragma("unroll") for (int m = 0; m < 4; ++m) _Pragma("unroll") for (int k = 0; k < 2; ++k) dst[m][k] = *(const PG8_LAS bf16x8*)(lds + PG8_SA(b, h) + aoff + m * 2048 + k * 1024); } while (0)
#define PG8_LDB(dst, b, h) do { _Pragma("unroll") for (int n = 0; n < 2; ++n) _Pragma("unroll") for (int k = 0; k < 2; ++k) dst[n][k] = *(const PG8_LAS bf16x8*)(lds + PG8_SB(b, h) + boff + n * 2048 + k * 1024); } while (0)
#define PG8_MMA(ai, bj, At, Bt) do { __builtin_amdgcn_s_setprio(1); _Pragma("unroll") for (int m = 0; m < 4; ++m) _Pragma("unroll") for (int n = 0; n < 2; ++n) _Pragma("unroll") for (int k = 0; k < 2; ++k) \
        acc[ai][bj][m][n] = __builtin_amdgcn_mfma_f32_16x16x32_bf16(Bt[n][k], At[m][k], acc[ai][bj][m][n], 0, 0, 0); __builtin_amdgcn_s_setprio(0); } while (0)
#define PG8_WAIT_V(n) asm volatile("s_waitcnt vmcnt(" #n ")" ::: "memory")
#define PG8_WAIT_L(n) asm volatile("s_waitcnt lgkmcnt(" #n ")" ::: "memory")
#define PG8_BAR __builtin_amdgcn_s_barrier()
#define PG8_SCHED __builtin_amdgcn_sched_barrier(0)
    Unit cur, nxt; int ui = 0;
    if (!S.next(0, cur)) return;
    f32x4 acc[2][2][4][2];
#pragma unroll
    for (int a = 0; a < 2; ++a)
#pragma unroll
        for (int b = 0; b < 2; ++b)
#pragma unroll
            for (int m = 0; m < 4; ++m)
#pragma unroll
                for (int n = 0; n < 2; ++n) acc[a][b][m][n] = (f32x4){0.f, 0.f, 0.f, 0.f};
    bf16x8 At[4][2], B0[2][2], B1[2][2];
    const char* cA = (const char*)g.A + (size_t)cur.pm * tstep; const char* cB = (const char*)g.Bt + (size_t)cur.pn * tstep;
    S.a_ready(cur);
    PG8_STAGE(PG8_SB(0, 0), cB, voffB); PG8_STAGE(PG8_SA(0, 0), cA, voffA); PG8_STAGE(PG8_SB(0, 1), cB + hstep, voffB); PG8_STAGE(PG8_SA(0, 1), cA + hstep, voffA);
    if (wr == 1) PG8_BAR;
    PG8_WAIT_V(4); PG8_BAR;
    PG8_STAGE(PG8_SB(1, 0), cB + kstep, voffB); PG8_STAGE(PG8_SA(1, 0), cA + kstep, voffA); PG8_STAGE(PG8_SB(1, 1), cB + hstep + kstep, voffB);
    PG8_WAIT_V(6); PG8_BAR;
    for (;;) {
        const bool has_next = S.next(ui + 1, nxt);
        const char* nA = has_next ? (const char*)g.A + (size_t)nxt.pm * tstep : cA; const char* nB = has_next ? (const char*)g.Bt + (size_t)nxt.pn * tstep : cB;
#pragma nounroll
        for (int t = 0; t < nt; t += 2) {
            const bool last = (t == nt - 2);
            const char* a1 = cA + (size_t)(t + 1) * kstep;
            const char* a2 = last ? nA : cA + (size_t)(t + 2) * kstep; const char* b2 = last ? nB : cB + (size_t)(t + 2) * kstep;
            const char* a3 = a2 + kstep; const char* b3 = b2 + kstep;
            if (last && has_next) S.a_ready(nxt);
            if (Hook::ACTIVE) { if (t == 8 || t == 12) H(acc, cur, t, wr, wc, fr, fq); }
            PG8_LDB(B0, 0, 0); PG8_SCHED; PG8_LDA(At, 0, 0); PG8_STAGE(PG8_SA(1, 1), a1 + hstep, voffA);
            PG8_WAIT_L(8); PG8_BAR; PG8_WAIT_L(0); PG8_MMA(0, 0, At, B0); PG8_BAR; PG8_SCHED;
            PG8_LDB(B1, 0, 1); PG8_STAGE(PG8_SB(0, 0), b2, voffB);
            PG8_BAR; PG8_WAIT_L(0); PG8_MMA(0, 1, At, B1); PG8_BAR;
            PG8_LDA(At, 0, 1); PG8_STAGE(PG8_SA(0, 0), a2, voffA);
            PG8_BAR; PG8_WAIT_L(0); PG8_MMA(1, 0, At, B0); PG8_BAR; PG8_SCHED;
            PG8_STAGE(PG8_SB(0, 1), b2 + hstep, voffB);
            PG8_WAIT_V(6); PG8_BAR; PG8_MMA(1, 1, At, B1); PG8_BAR;
            PG8_LDB(B0, 1, 0); PG8_SCHED; PG8_LDA(At, 1, 0); PG8_STAGE(PG8_SA(0, 1), a2 + hstep, voffA);
            PG8_WAIT_L(8); PG8_BAR; PG8_WAIT_L(0); PG8_MMA(0, 0, At, B0); PG8_BAR; PG8_SCHED;
            PG8_LDB(B1, 1, 1); PG8_STAGE(PG8_SB(1, 0), b3, voffB);
            PG8_BAR; PG8_WAIT_L(0); PG8_MMA(0, 1, At, B1); PG8_BAR;
            PG8_LDA(At, 1, 1); PG8_STAGE(PG8_SA(1, 0), a3, voffA);
            PG8_BAR; PG8_WAIT_L(0); PG8_MMA(1, 0, At, B0); PG8_BAR; PG8_SCHED;
            PG8_STAGE(PG8_SB(1, 1), b3 + hstep, voffB);
            PG8_WAIT_V(6); PG8_BAR; PG8_MMA(1, 1, At, B1); PG8_BAR;
        }
        E(acc, cur, wr, wc, fr, fq); S.done(cur);
        if (!has_next) break;
#pragma unroll
        for (int a = 0; a < 2; ++a)
#pragma unroll
            for (int b = 0; b < 2; ++b)
#pragma unroll
                for (int m = 0; m < 4; ++m)
#pragma unroll
                    for (int n = 0; n < 2; ++n) acc[a][b][m][n] = (f32x4){0.f, 0.f, 0.f, 0.f};
        cur = nxt; cA = nA; cB = nB; ++ui;
    }
    PG8_WAIT_V(0);
    if (wr == 0) PG8_BAR;
    PG8_BAR;
#undef PG8_SA
#undef PG8_SB
#undef PG8_STAGE
#undef PG8_LDA
#undef PG8_LDB
#undef PG8_MMA
#undef PG8_WAIT_V
#undef PG8_WAIT_L
#undef PG8_BAR
#undef PG8_SCHED
}
}

__device__ __forceinline__ int vperm(int t) { const int kq = (t >> 2) & 7, e = t & 3; return (t & ~31) | ((kq < 4 ? 2 * kq : 2 * (kq - 4) + 1) << 2) | e; }
template <class F> struct Epi8 {
    static constexpr bool PERM = true, AFTER_DRAIN = false;
    F f;
    __device__ __forceinline__ void operator()(const f32x4 (&acc)[2][2][4][2], const pg8::Unit& u, int wr, int wc, int fr, int fq) const {
        const int row0 = u.pm * 256 + wr * 64 + fr, col0 = u.pn * 256 + wc * 32 + 8 * fq;
#pragma unroll
        for (int ai = 0; ai < 2; ++ai)
#pragma unroll
            for (int m = 0; m < 4; ++m)
            {
#pragma unroll
                for (int bj = 0; bj < 2; ++bj) f(row0 + ai * 128 + m * 16, col0 + bj * 128, acc[ai][bj][m][0], acc[ai][bj][m][1], u.pn);
                asm volatile("" ::: "memory"); }
    }
};
__device__ __forceinline__ u32x4 pack8(const f32x4 a, const f32x4 b) {
    return __builtin_bit_cast(u32x4, pg8::cvt8_bf16(a, b));
}
struct FStore { bf16_t* O; int ld;
    __device__ __forceinline__ void operator()(int row, int col, f32x4 a, f32x4 b, int) const { *(u32x4*)(O + (unsigned)(row * ld + col)) = pack8(a, b); } };
struct MergeHook { static constexpr bool ACTIVE = true; const bf16_t* G;
    __device__ __forceinline__ void operator()(f32x4 (&acc)[2][2][4][2], const pg8::Unit& u, int t, int wr, int wc, int fr, int fq) const {
        const int cn = t == 8 ? 0 : 1024;
        const int row0 = u.pm * 256 + wr * 64 + fr, col0 = u.pn * 256 + wc * 32 + 8 * fq;
#pragma unroll
        for (int ai = 0; ai < 2; ++ai)
#pragma unroll
            for (int mh = 0; mh < 2; ++mh) {
                u32x4 gn[2][2], gd[2][2];
#pragma unroll
                for (int mm = 0; mm < 2; ++mm)
#pragma unroll
                    for (int bj = 0; bj < 2; ++bj) { const unsigned o = (unsigned)((row0 + ai * 128 + (2 * mh + mm) * 16) * 3072 + cn + col0 + bj * 128);
                        gn[mm][bj] = *(const u32x4*)(G + o); gd[mm][bj] = *(const u32x4*)(G + o + 1024); }
#pragma unroll
                for (int mm = 0; mm < 2; ++mm)
#pragma unroll
                    for (int bj = 0; bj < 2; ++bj) { const int m = 2 * mh + mm;
                        const unsigned nw[4] = {gn[mm][bj].x, gn[mm][bj].y, gn[mm][bj].z, gn[mm][bj].w}, dw[4] = {gd[mm][bj].x, gd[mm][bj].y, gd[mm][bj].z, gd[mm][bj].w};
#pragma unroll
                        for (int j = 0; j < 8; ++j) { const float gnj = (j & 1) ? bfhi(nw[j >> 1]) : bflo(nw[j >> 1]), gdj = (j & 1) ? bfhi(dw[j >> 1]) : bflo(dw[j >> 1]);
                            acc[ai][bj][m][j >> 2][j & 3] *= gnj * __builtin_amdgcn_rcpf(fmaxf(gdj, 1e-12f)); } }
                asm volatile("" ::: "memory"); __builtin_amdgcn_sched_barrier(0);
            }
    } };
struct FMulStore { const bf16_t* G; bf16_t* O;
    __device__ __forceinline__ void operator()(int row, int col, f32x4 a, f32x4 b, int) const {
        const u32x4 g = *(const u32x4*)(G + (unsigned)(row * 3072 + 2048 + col));
        const f32x4 g0 = {bflo(g.x), bfhi(g.x), bflo(g.y), bfhi(g.y)}, g1 = {bflo(g.z), bfhi(g.z), bflo(g.w), bfhi(g.w)};
        *(u32x4*)(O + (unsigned)(row * 1024 + col)) = pack8(g0 * a, g1 * b); } };
struct FSigmoid { bf16_t* O; int ld;
    __device__ __forceinline__ void operator()(int row, int col, f32x4 a, f32x4 b, int) const {
#pragma unroll
        for (int j = 0; j < 4; ++j) { a[j] = sigmoidf_(a[j]); b[j] = sigmoidf_(b[j]); }
        *(u32x4*)(O + (unsigned)(row * ld + col)) = pack8(a, b); } };
struct FGluMul { const bf16_t* Y; bf16_t* O; int ld, ldo;
    __device__ __forceinline__ void operator()(int row, int col, f32x4 a, f32x4 b, int) const {
        const unsigned o = (unsigned)(row * ld + col), oo = (unsigned)(row * ldo + col); const u32x4 y = *(const u32x4*)(Y + o);
        const f32x4 y0 = {bflo(y.x), bfhi(y.x), bflo(y.y), bfhi(y.y)}, y1 = {bflo(y.z), bfhi(y.z), bflo(y.w), bfhi(y.w)};
#pragma unroll
        for (int j = 0; j < 4; ++j) { a[j] = y0[j] * sigmoidf_(a[j]); b[j] = y1[j] * sigmoidf_(b[j]); }
        *(u32x4*)(O + oo) = pack8(a, b); } };
struct FSwiGLU { bf16_t* O; int ld;
    __device__ __forceinline__ void operator()(int row, int col, f32x4 a, f32x4 b, int) const {
        const float o0 = a[0] * sigmoidf_(a[0]) * a[1], o1 = a[2] * sigmoidf_(a[2]) * a[3], o2 = b[0] * sigmoidf_(b[0]) * b[1], o3 = b[2] * sigmoidf_(b[2]) * b[3];
        *(u32x2*)(O + (unsigned)(row * ld + (col >> 1))) = pg8::cvt4_bf16((f32x4){o0, o1, o2, o3}); } };
struct FLora { bf16_t *LW, *LA, *RG;
    __device__ __forceinline__ void operator()(int row, int col, f32x4 a, f32x4 b, int pn) const {
        bf16_t* O = pn == 0 ? LW : (pn == 1 ? LA : RG); *(u32x4*)(O + (unsigned)(row * 256 + (col & 255))) = pack8(a, b); } };
struct FXKV { bf16_t* Kx; bf16_t* Vxt;
    __device__ __forceinline__ void operator()(int row, int col, f32x4 a, f32x4 b, int) const {
        const int bb = row >> 8, m = row & 255;
        if (col < 256) { const int h = col >> 6, d = col & 63; *(u32x4*)(Kx + (unsigned)(((bb * 4 + h) * 256 + m) * 64 + d)) = pack8(a, b); }
        else { const int c = col - 256, h = c >> 6, d = c & 63; bf16_t* p = Vxt + (unsigned)(((bb * 4 + h) * 64 + d) * 256 + vperm(m));
#pragma unroll
            for (int j = 0; j < 4; ++j) { p[j * 256] = f2bf(a[j]); p[(j + 4) * 256] = f2bf(b[j]); } } } };
struct FIn1 { bf16_t *Q, *KC, *VC, *KS, *KW, *VSt, *VWt, *ZR, *ZS, *NG; const float* ropec; const float* ropes;
    __device__ __forceinline__ void operator()(int row, int col, f32x4 a, f32x4 b, int pn) const {
        if (pn < 2) { *(u32x4*)(Q + (unsigned)(row * 512 + col)) = pack8(a, b); }
        else if (pn < 5) {
            const int c = col - 512, which = c >> 7, g = (c >> 6) & 1, j0 = c & 63, bb = row >> 12, t = row & 4095;
            const unsigned base = (unsigned)(((bb * 2 + g) * 4096 + t) * 64);
            if (which == 0) *(u32x4*)(KC + base + j0) = pack8(a, b);
            else if (which == 1) *(u32x4*)(VC + base + j0) = pack8(a, b);
            else if (which == 2 || which == 4) {
                const int i0 = j0 >> 1; const f32x4 cs = *(const f32x4*)(ropec + t * 32 + i0), sn = *(const f32x4*)(ropes + t * 32 + i0);
                const float x1[4] = {a[0], a[2], b[0], b[2]}, x2[4] = {a[1], a[3], b[1], b[3]}; float r1[4], r2[4];
#pragma unroll
                for (int j = 0; j < 4; ++j) { r1[j] = x1[j] * cs[j] - x2[j] * sn[j]; r2[j] = x1[j] * sn[j] + x2[j] * cs[j]; }
                bf16_t* K = (which == 2 ? KS : KW) + base;
                const u32x2 w1 = pg8::cvt4_bf16((f32x4){r1[0], r1[1], r1[2], r1[3]}), w2 = pg8::cvt4_bf16((f32x4){r2[0], r2[1], r2[2], r2[3]});
                *(u32x2*)(K + i0) = w1; *(u32x2*)(K + 32 + i0) = w2;
            } else {
                bf16_t* p = (which == 3 ? VSt : VWt) + (unsigned)(((bb * 2 + g) * 64 + j0) * 4096 + vperm(t));
#pragma unroll
                for (int j = 0; j < 4; ++j) { p[j * 4096] = f2bf(a[j]); p[(j + 4) * 4096] = f2bf(b[j]); }
            }
        }
        else if (pn < 9) { *(u32x4*)(ZR + (unsigned)(row * 1024 + (col - 1280))) = pack8(a, b); }
        else if (pn == 9) { *(u32x4*)(ZS + (unsigned)(row * 256 + (col - 2304))) = pack8(a, b); }
        else { const int c = col - 2560; if (c < 32) *(u32x4*)(NG + (unsigned)(row * 32 + c)) = pack8(a, b); }
    } };

typedef const float* const __attribute__((address_space(4)))* KArgPtrs;
struct Frame {
    const __attribute__((address_space(4))) char* kp; unsigned char* ws; LAS unsigned char* lds;
    int tid, lane, wave, bid, G;
    __device__ __forceinline__ const float* in(int i) const { return (const float*)(const __attribute__((address_space(1))) float*)(((KArgPtrs)kp)[i]); }
    __device__ __forceinline__ float* out() const { return (float*)(__attribute__((address_space(1))) float*)(((KArgPtrs)kp)[42]); }
    __device__ __forceinline__ bf16_t* x16() const { return (bf16_t*)(out() + (size_t)TOK * DM / 2); }
    __device__ __forceinline__ unsigned* ctl() const { return (unsigned*)(ws + WS_CTL); }
};
#define LAUNDER(F) do { __attribute__((address_space(1))) unsigned char* _g = (__attribute__((address_space(1))) unsigned char*)(F).ws; asm volatile("" : "+s"(_g), "+s"((F).kp)); (F).ws = (unsigned char*)_g; } while (0)
#define WSP(T, off) ((T*)(F.ws + (off)))

__device__ __forceinline__ int next_job(const Frame& F, unsigned* counter) {
    volatile LAS int* slot = (volatile LAS int*)(F.lds + LDS_CTL_OFF + 16);
    __syncthreads();
    if (F.tid == 0) *slot = (int)__hip_atomic_fetch_add(counter, 1u, __ATOMIC_RELAXED, __HIP_MEMORY_SCOPE_AGENT);
    __syncthreads();
    return *slot;
}

struct ConvDesc { int N, K; size_t dst; };
__device__ __forceinline__ const float* conv_col(const Frame& F, int l, int kind, int n, int& ld, int& klo, int& khi) {
    klo = 0; khi = 1 << 30;
    switch (kind) {
    case 0: {
        int c; ld = INW;
        if (n < 512) c = n;
        else if (n < 1280) { const int cc = n - 512, which = cc >> 7, g = (cc >> 6) & 1, j = cc & 63; const int dim = (which == 2 || which == 4) ? ((j & 1) ? (j >> 1) + 32 : (j >> 1)) : j; c = 512 + which * 128 + g * 64 + dim; }
        else if (n < 2304) c = 1304 + (n - 1280);
        else if (n < 2560) c = 2328 + (n - 2304);
        else if (n < 2584) c = 1280 + (n - 2560);
        else return nullptr;
        return F.in(4) + (size_t)l * DM * INW + c; }
    case 1: ld = INW; return F.in(4) + (size_t)l * DM * INW + 2584 + n;
    case 2: ld = 1024; return F.in(31) + (size_t)l * 512 * 1024 + n;
    case 3: return nullptr;
    case 4: return nullptr;
    case 5: ld = 1024; return F.in(34) + (size_t)l * 1024 * 1024 + n;
    case 6: ld = 256; return F.in(7) + ((size_t)l * 2048 + (n < 256 ? 0 : 1024)) * 256 + (n & 255);
    case 7: ld = 256; return F.in(9) + ((size_t)l * 2048 + (n < 256 ? 0 : 1024)) * 256 + (n & 255);
    case 8: ld = 256; return F.in(35) + (size_t)l * 1024 * 256 + n;
    case 9: ld = 256; return (n < 256 ? F.in(36) : F.in(37)) + (size_t)l * 1024 * 256 + (n & 255);
    case 10: ld = 1024; return F.in(38) + (size_t)l * 256 * 1024 + n;
    case 11: ld = 256; return F.in(30) + (size_t)l * 256 * 256 + n;
    case 12: ld = DFF; return ((n & 1) ? F.in(40) : F.in(39)) + (size_t)l * 1024 * DFF + (n >> 1);
    case 13: ld = 1024; return F.in(41) + (size_t)l * DFF * 1024 + n;
    default: {
        ld = 256;
        if (n < 256) { klo = 0; khi = 64; return F.in(13) + (size_t)l * 64 * 256 + n; }
        if (n < 512) { klo = 64; khi = 128; return F.in(15) + (size_t)l * 64 * 256 + (n - 256); }
        klo = 128; khi = 256; return F.in(16) + (size_t)l * 128 * 256 + (n - 512); }
    }
}
__device__ __forceinline__ void conv_layer(const Frame& F, int l) {
    const ConvDesc D[15] = {{2816, 1024, W_IN1}, {3072, 1024, W_MG}, {1024, 1024, W_UPN}, {64, 64, WS_W + 39 * MiB}, {64, 64, WS_W + 39 * MiB + 65536}, {1024, 1024, W_OUT}, {512, 1024, W_C1K}, {512, 1024, W_C1V},
                            {256, 1024, W_XQ}, {512, 1024, W_XKV}, {1024, 256, W_XO}, {256, 256, W_GLU}, {5632, 1024, W_GU}, {1024, 2816, W_DN}, {768, 256, W_LORA}};
    LAS float* tile = (LAS float*)F.lds;
    int total = 0;
#pragma unroll
    for (int i = 0; i < 15; ++i) total += (D[i].N / 64) * (D[i].K / 64);
    for (int job = F.bid; job < total; job += F.G) {
        int kind = 0, rem = job;
#pragma unroll
        for (int i = 0; i < 15; ++i) { const int nt = (D[i].N / 64) * (D[i].K / 64); if (rem >= nt && kind == i) { rem -= nt; kind = i + 1; } }
        int K = 0; size_t dst = 0;
#pragma unroll
        for (int i = 0; i < 15; ++i) if (kind == i) { K = D[i].K; dst = D[i].dst; }
        const int ktiles = K / 64, n0 = (rem / ktiles) * 64, k0 = (rem % ktiles) * 64;
        int ld, klo, khi; const float* col = conv_col(F, l, kind, n0 + (F.tid & 63), ld, klo, khi);
        if (kind == 2) { if (k0 >= 768) { col = F.in(33) + (size_t)l * 256 * 1024 + n0 + (F.tid & 63); klo = 768; } else if (k0 >= 512) { col = F.in(32) + (size_t)l * 256 * 1024 + n0 + (F.tid & 63); klo = 512; } else khi = 512; }
        float v[8];
#pragma unroll
        for (int i = 0; i < 8; ++i) { const int k = k0 + (F.tid >> 6) + 8 * i; v[i] = (col != nullptr && k >= klo && k < khi) ? col[(size_t)(k - klo) * ld] : 0.f; }
        __syncthreads();
#pragma unroll
        for (int i = 0; i < 8; ++i) tile[((F.tid >> 6) + 8 * i) * 65 + (F.tid & 63)] = v[i];
        __syncthreads();
        bf16_t* O = WSP(bf16_t, dst);
#pragma unroll
        for (int i = 0; i < 4; ++i) { const int ny = (F.tid >> 5) + 16 * i, kp = F.tid & 31; *(unsigned*)(O + (size_t)(n0 + ny) * K + k0 + 2 * kp) = pk2(tile[(2 * kp) * 65 + ny], tile[(2 * kp + 1) * 65 + ny]); }
    }
    __syncthreads();
}

__device__ __forceinline__ void norm_rows(const Frame& F, int nrows, const float* xin32, const bf16_t* xin16, const bf16_t* Y, const float* gy, bf16_t* X16, float* X32, float* X32hi, const float* gh, bf16_t* H) {
    constexpr int NR = 8;
    const int nw = F.G * 8;
    for (int row0 = F.bid * 8 + F.wave; row0 < nrows; row0 += NR * nw) {
        f32x4 xf[NR][4]; u32x2 xr[NR][4], yr[NR][4];
#pragma unroll
        for (int q = 0; q < NR; ++q) {
            const int row = row0 + q * nw < nrows ? row0 + q * nw : row0;
#pragma unroll
            for (int i = 0; i < 4; ++i) {
                if (xin32) xf[q][i] = *(const f32x4*)(xin32 + (size_t)row * 1024 + i * 256 + F.lane * 4);
                else xr[q][i] = *(const u32x2*)(xin16 + (size_t)row * 1024 + i * 256 + F.lane * 4);
                if (Y) yr[q][i] = *(const u32x2*)(Y + (size_t)row * 1024 + i * 256 + F.lane * 4);
            }
        }
#pragma unroll
        for (int q = 0; q < NR; ++q) {
            const int row = row0 + q * nw;
            if (row < nrows) {
                f32x4 x[4];
#pragma unroll
                for (int i = 0; i < 4; ++i) x[i] = xin32 ? xf[q][i] : (f32x4){bflo(xr[q][i].x), bfhi(xr[q][i].x), bflo(xr[q][i].y), bfhi(xr[q][i].y)};
                if (Y) {
                    f32x4 y[4]; float ss = 0.f;
#pragma unroll
                    for (int i = 0; i < 4; ++i) { y[i] = (f32x4){bflo(yr[q][i].x), bfhi(yr[q][i].x), bflo(yr[q][i].y), bfhi(yr[q][i].y)}; ss += y[i][0] * y[i][0] + y[i][1] * y[i][1] + y[i][2] * y[i][2] + y[i][3] * y[i][3]; }
                    ss = wave_sum(ss); const float rs = rsqrtf(ss * (1.0f / 1024.0f) + 1e-6f);
#pragma unroll
                    for (int i = 0; i < 4; ++i) { const f32x4 g = *(const f32x4*)(gy + i * 256 + F.lane * 4); x[i] += y[i] * rs * g; }
                }
                if (X16) {
#pragma unroll
                    for (int i = 0; i < 4; ++i) *(u32x2*)(X16 + (size_t)row * 1024 + i * 256 + F.lane * 4) = pg8::cvt4_bf16(x[i]);
                }
                if (X32) {
                    float* dst = row < TOK / 2 ? X32 + (size_t)row * 1024 : X32hi + (size_t)(row - TOK / 2) * 1024;
#pragma unroll
                    for (int i = 0; i < 4; ++i) *(f32x4*)(dst + i * 256 + F.lane * 4) = x[i];
                }
                if (H) {
                    float ss = 0.f;
#pragma unroll
                    for (int i = 0; i < 4; ++i) ss += x[i][0] * x[i][0] + x[i][1] * x[i][1] + x[i][2] * x[i][2] + x[i][3] * x[i][3];
                    ss = wave_sum(ss); const float rs = rsqrtf(ss * (1.0f / 1024.0f) + 1e-6f);
#pragma unroll
                    for (int i = 0; i < 4; ++i) { const f32x4 g = *(const f32x4*)(gh + i * 256 + F.lane * 4); const f32x4 h = x[i] * rs * g;
                        *(u32x2*)(H + (size_t)row * 1024 + i * 256 + F.lane * 4) = pg8::cvt4_bf16(h); }
                }
            }
        }
    }
}

__device__ __forceinline__ void rwkv_lin_tile(const Frame& F, int l, int tile) {
    const bf16_t* ZR = WSP(const bf16_t, WS_ZR); bf16_t* LIN = WSP(bf16_t, WS_LIN);
    const float* mu = F.in(11) + (size_t)l * 1024 + 768;
    const int tk = F.tid >> 3, cg = F.tid & 7, row = tile * 64 + tk, t = row & 4095;
    u32x4 z[4], zp[4];
#pragma unroll
    for (int i = 0; i < 4; ++i) { z[i] = *(const u32x4*)(ZR + (size_t)row * 1024 + 768 + cg * 32 + i * 8); zp[i] = (u32x4){0u, 0u, 0u, 0u}; }
    if (t > 0) {
#pragma unroll
        for (int i = 0; i < 4; ++i) zp[i] = *(const u32x4*)(ZR + (size_t)(row - 1) * 1024 + 768 + cg * 32 + i * 8);
    }
#pragma unroll
    for (int i = 0; i < 4; ++i) {
        const f32x4 m0 = *(const f32x4*)(mu + cg * 32 + i * 8), m1 = *(const f32x4*)(mu + cg * 32 + i * 8 + 4);
        const unsigned zw[4] = {z[i].x, z[i].y, z[i].z, z[i].w}, pw[4] = {zp[i].x, zp[i].y, zp[i].z, zp[i].w}; float o[8];
#pragma unroll
        for (int j = 0; j < 8; ++j) { const float zz = (j & 1) ? bfhi(zw[j >> 1]) : bflo(zw[j >> 1]), pp = (j & 1) ? bfhi(pw[j >> 1]) : bflo(pw[j >> 1]); const float m = j < 4 ? m0[j & 3] : m1[j & 3];
            const float zs = zz + (pp - zz) * m; o[j] = cg < 2 ? tanhf(zs) : (cg < 4 ? zs : sigmoidf_(zs)); }
        u32x4 w; w.x = pk2(o[0], o[1]); w.y = pk2(o[2], o[3]); w.z = pk2(o[4], o[5]); w.w = pk2(o[6], o[7]);
        *(u32x4*)(LIN + (size_t)row * 256 + cg * 32 + i * 8) = w;
    }
}

__device__ __forceinline__ f32x4 mm16(const f32x4& XT, const f32x4& Y) {
    f32x4 z = {0.f, 0.f, 0.f, 0.f};
#pragma unroll
    for (int ks = 0; ks < 4; ++ks) z = __builtin_amdgcn_mfma_f32_16x16x4f32(XT[ks], Y[ks], z, 0, 0, 0);
    return z;
}
__device__ __forceinline__ void rwkv_chunk_prep(const Frame& F, int l, int ci) {
    const int bh = ci >> 8, c = ci & 255, b = bh >> 2, h = bh & 3, lane = F.lane, fr = lane & 15, fq = lane >> 4;
    LAS unsigned char* L = F.lds + F.wave * 9216;
    const bf16_t* ZR = WSP(const bf16_t, WS_ZR); const bf16_t* LW = WSP(const bf16_t, WS_LW); const bf16_t* LA = WSP(const bf16_t, WS_LA);
    const int ch = h * 64 + lane;
    const float* mu = F.in(11) + (size_t)l * 1024;
    const float mur = mu[ch], muk = mu[256 + ch], muv = mu[512 + ch], w0 = F.in(12)[l * 256 + ch], a0 = F.in(14)[l * 256 + ch], kkc = F.in(17)[l * 256 + ch], kac = F.in(18)[l * 256 + ch], rkc = F.in(19)[l * 256 + ch];
    const size_t row0 = (size_t)b * 4096 + c * 16;
    float pr = 0.f, pk = 0.f, pv = 0.f;
    if (c > 0) { pr = bf2f(ZR[(row0 - 1) * 1024 + ch]); pk = bf2f(ZR[(row0 - 1) * 1024 + 256 + ch]); pv = bf2f(ZR[(row0 - 1) * 1024 + 512 + ch]); }
    float gam = 1.0f; unsigned bT[8], kT[8], vT[8]; float* BON = WSP(float, WS_BONUS);
    float zr_[16], zk_[16], zv_[16], lw_[16], la_[16];
#pragma unroll
    for (int t = 0; t < 16; ++t) { const size_t row = row0 + t; zr_[t] = bf2f(ZR[row * 1024 + ch]); zk_[t] = bf2f(ZR[row * 1024 + 256 + ch]); zv_[t] = bf2f(ZR[row * 1024 + 512 + ch]);
        lw_[t] = bf2f(LW[row * 256 + ch]); la_[t] = bf2f(LA[row * 256 + ch]); }
    float bprev = 0.f, kprev = 0.f, vprev = 0.f;
#pragma unroll
    for (int t = 0; t < 16; ++t) {
        const float r = zr_[t] + (pr - zr_[t]) * mur, k = zk_[t] + (pk - zk_[t]) * muk, v = zv_[t] + (pv - zv_[t]) * muv; pr = zr_[t]; pk = zk_[t]; pv = zv_[t];
        const float u = w0 + lw_[t]; const float sp = fmaxf(-u, 0.f) + __logf(1.0f + __expf(-fabsf(u))); const float dec = __expf(-__expf(-sp - 0.5f));
        const float a = sigmoidf_(a0 + la_[t]);
        const float kkv = k * kkc; float n2 = row16_sum(kkv * kkv); n2 = xsum16(n2); n2 = xsum32(n2);
        const float kk = kkv * rsqrtf(fmaxf(n2, 1e-24f));
        const float kp = k * (1.0f + (a - 1.0f) * kac);
        float bon = row16_sum(r * kp * rkc); bon = xsum16(bon); bon = xsum32(bon);
        if (lane == 0) BON[(row0 + t) * 4 + h] = bon;
        const float gprev = gam; gam *= dec; const float ginv = __builtin_amdgcn_rcpf(gam);
        const float ah = -gprev * kk, bh_ = kk * a * ginv, kh = kp * ginv, rh = gam * r;
        *(LAS bf16_t*)(L + 0 * 2304 + t * 144 + lane * 2) = f2bf(ah); *(LAS bf16_t*)(L + 1 * 2304 + t * 144 + lane * 2) = f2bf(rh);
        *(LAS bf16_t*)(L + 2 * 2304 + t * 144 + lane * 2) = f2bf(bh_); *(LAS bf16_t*)(L + 3 * 2304 + t * 144 + lane * 2) = f2bf(kh);
        if (t & 1) { bT[t >> 1] = pk2(bprev, bh_); kT[t >> 1] = pk2(kprev, kh); vT[t >> 1] = pk2(vprev, v); } else { bprev = bh_; kprev = kh; vprev = v; }
    }
    {
        bf16_t* BKT = WSP(bf16_t, WS_CS_BKT) + ((size_t)ci * 64 + lane) * 32; bf16_t* VMT = WSP(bf16_t, WS_CS_VMT) + ((size_t)ci * 64 + lane) * 16;
        *(u32x4*)(BKT) = (u32x4){bT[0], bT[1], bT[2], bT[3]}; *(u32x4*)(BKT + 8) = (u32x4){bT[4], bT[5], bT[6], bT[7]};
        *(u32x4*)(BKT + 16) = (u32x4){kT[0], kT[1], kT[2], kT[3]}; *(u32x4*)(BKT + 24) = (u32x4){kT[4], kT[5], kT[6], kT[7]};
        *(u32x4*)(VMT) = (u32x4){vT[0], vT[1], vT[2], vT[3]}; *(u32x4*)(VMT + 8) = (u32x4){vT[4], vT[5], vT[6], vT[7]};
        WSP(float, WS_CS_GAM)[(size_t)ci * 64 + lane] = gam;
    }
    asm volatile("s_waitcnt lgkmcnt(0)" ::: "memory");
    {
        bf16_t* AR = WSP(bf16_t, WS_CS_AR) + (size_t)ci * 2048;
#pragma unroll
        for (int j = 0; j < 4; ++j) { const int e = lane + 64 * j, which = e >> 7, row = (e >> 3) & 15, c16 = e & 7;
            *(u32x4*)(AR + e * 8) = *(const LAS u32x4*)(L + which * 2304 + row * 144 + c16 * 16); }
    }
    bf16x8 Af[2], Rf[2], Bf[2], Kf[2];
#pragma unroll
    for (int ks = 0; ks < 2; ++ks) { Af[ks] = *(const LAS bf16x8*)(L + 0 * 2304 + fr * 144 + ks * 64 + fq * 16); Rf[ks] = *(const LAS bf16x8*)(L + 1 * 2304 + fr * 144 + ks * 64 + fq * 16);
        Bf[ks] = *(const LAS bf16x8*)(L + 2 * 2304 + fr * 144 + ks * 64 + fq * 16); Kf[ks] = *(const LAS bf16x8*)(L + 3 * 2304 + fr * 144 + ks * 64 + fq * 16); }
    f32x4 Pab = {0.f, 0.f, 0.f, 0.f}, PabT = Pab, Pak = Pab, Prb = Pab, Prk = Pab;
#pragma unroll
    for (int ks = 0; ks < 2; ++ks) { Pab = __builtin_amdgcn_mfma_f32_16x16x32_bf16(Af[ks], Bf[ks], Pab, 0, 0, 0); PabT = __builtin_amdgcn_mfma_f32_16x16x32_bf16(Bf[ks], Af[ks], PabT, 0, 0, 0);
        Pak = __builtin_amdgcn_mfma_f32_16x16x32_bf16(Af[ks], Kf[ks], Pak, 0, 0, 0); Prb = __builtin_amdgcn_mfma_f32_16x16x32_bf16(Rf[ks], Bf[ks], Prb, 0, 0, 0); Prk = __builtin_amdgcn_mfma_f32_16x16x32_bf16(Rf[ks], Kf[ks], Prk, 0, 0, 0); }
    f32x4 One = {0.f, 0.f, 0.f, 0.f};
#pragma unroll
    for (int r = 0; r < 4; ++r) { const int rho = 4 * fq + r;
        Pab[r] = fr < rho ? Pab[r] : 0.f; Pak[r] = fr < rho ? Pak[r] : 0.f; PabT[r] = rho < fr ? PabT[r] : 0.f; Prb[r] = fr <= rho ? Prb[r] : 0.f; Prk[r] = fr <= rho ? Prk[r] : 0.f; One[r] = fr == rho ? 1.f : 0.f; }
    {
        bf16_t* AAK = WSP(bf16_t, WS_CS_AAK) + (size_t)ci * 256; bf16_t* ARBK = WSP(bf16_t, WS_CS_ARBK) + (size_t)ci * 512;
#pragma unroll
        for (int r = 0; r < 4; ++r) { const int rho = 4 * fq + r; AAK[rho * 16 + fr] = f2bf(Pak[r]); ARBK[rho * 32 + fr] = f2bf(Prb[r]); ARBK[rho * 32 + 16 + fr] = f2bf(Prk[r]); }
    }
    const f32x4 A2 = mm16(PabT, Pab), A2T = mm16(Pab, PabT), A4 = mm16(A2T, A2), A4T = mm16(A2, A2T), A8 = mm16(A4T, A4);
    const f32x4 G1 = mm16(One + PabT, One + A2), G1T = mm16(One + A2, One + PabT), G2 = mm16(One + A4T, One + A8);
    const f32x4 Mm = mm16(G1T, G2);
    { float* MM = WSP(float, WS_CS_MM) + (size_t)ci * 256;
#pragma unroll
      for (int r = 0; r < 4; ++r) MM[(4 * fq + r) * 16 + fr] = Mm[r]; }
    asm volatile("s_waitcnt lgkmcnt(0)" ::: "memory");
}
constexpr int CS_AH = 0, CS_RH = 2304, CS_BKT = 4608, CS_VMT = 9728, CS_AAK = 11776, CS_ARBK = 12288, CS_MM = 13568, CS_GAM = 14848, CS_REC = 15360;
__device__ __forceinline__ void rwkv_chunk_scan(const Frame& F, int bh) {
    const int b = bh >> 2, h = bh & 3, lane = F.lane, fr = lane & 15, fq = lane >> 4, tid = F.tid;
    const bf16_t* AR = WSP(const bf16_t, WS_CS_AR) + (size_t)bh * 256 * 2048; const bf16_t* BKT = WSP(const bf16_t, WS_CS_BKT) + (size_t)bh * 256 * 2048;
    const bf16_t* VMT = WSP(const bf16_t, WS_CS_VMT) + (size_t)bh * 256 * 1024; const bf16_t* AAK = WSP(const bf16_t, WS_CS_AAK) + (size_t)bh * 256 * 256;
    const bf16_t* ARBK = WSP(const bf16_t, WS_CS_ARBK) + (size_t)bh * 256 * 512; const float* MMg = WSP(const float, WS_CS_MM) + (size_t)bh * 256 * 256; const float* GAM = WSP(const float, WS_CS_GAM) + (size_t)bh * 256 * 64;
    float* YS = WSP(float, WS_YSCAN);
    const unsigned char* g1; int l1, s1;
    if (tid < 256) { g1 = (const unsigned char*)AR + tid * 16; l1 = (tid >> 7) * 2304 + ((tid >> 3) & 15) * 144 + (tid & 7) * 16; s1 = 4096; }
    else { const int e = tid - 256; g1 = (const unsigned char*)BKT + e * 16; l1 = CS_BKT + (e >> 2) * 80 + (e & 3) * 16; s1 = 4096; }
    const unsigned char* g2 = (const unsigned char*)VMT; int l2 = 0, s2 = 0; const bool has2 = tid < 304;
    if (tid < 128) { g2 = (const unsigned char*)VMT + tid * 16; l2 = CS_VMT + (tid >> 1) * 32 + (tid & 1) * 16; s2 = 2048; }
    else if (tid < 160) { const int e = tid - 128; g2 = (const unsigned char*)AAK + e * 16; l2 = CS_AAK + (e >> 1) * 32 + (e & 1) * 16; s2 = 512; }
    else if (tid < 224) { const int e = tid - 160; g2 = (const unsigned char*)ARBK + e * 16; l2 = CS_ARBK + (e >> 2) * 80 + (e & 3) * 16; s2 = 1024; }
    else if (tid < 288) { const int e = tid - 224; g2 = (const unsigned char*)MMg + e * 16; l2 = CS_MM + (e >> 2) * 80 + (e & 3) * 16; s2 = 1024; }
    else if (tid < 304) { const int e = tid - 288; g2 = (const unsigned char*)GAM + e * 16; l2 = CS_GAM + e * 16; s2 = 256; }
    f32x4 S[4];
#pragma unroll
    for (int kt = 0; kt < 4; ++kt) S[kt] = (f32x4){0.f, 0.f, 0.f, 0.f};
    const int v0 = 16 * F.wave;
    u32x4 R0a, R0b = {0u, 0u, 0u, 0u}, R1a, R1b = {0u, 0u, 0u, 0u};
#define CS_LOAD(R, c) do { R##a = *(const u32x4*)(g1 + (size_t)(c) * s1); if (has2) R##b = *(const u32x4*)(g2 + (size_t)(c) * s2); } while (0)
#define CS_WRITE(R, buf) do { *(LAS u32x4*)(F.lds + (buf) * CS_REC + l1) = R##a; if (has2) *(LAS u32x4*)(F.lds + (buf) * CS_REC + l2) = R##b; } while (0)
#define CS_COMPUTE(buf, c) do { if (F.wave < 4) { const LAS unsigned char* B = F.lds + (buf) * CS_REC; \
        bf16x8 sp[2]; \
        _Pragma("unroll") for (int ks = 0; ks < 2; ++ks) sp[ks] = pg8::cvt8_bf16(S[2 * ks], S[2 * ks + 1]); \
        const u32x2 vmf = *(const LAS u32x2*)(B + CS_VMT + (v0 + fr) * 32 + fq * 8); \
        f32x4 wt = {0.f, 0.f, 0.f, 0.f}, yt = {0.f, 0.f, 0.f, 0.f}; \
        _Pragma("unroll") for (int ks = 0; ks < 2; ++ks) { \
            const u32x2 a0_ = *(const LAS u32x2*)(B + CS_AH + fr * 144 + (32 * ks + 4 * fq) * 2), a1_ = *(const LAS u32x2*)(B + CS_AH + fr * 144 + (32 * ks + 16 + 4 * fq) * 2); \
            const u32x2 r0_ = *(const LAS u32x2*)(B + CS_RH + fr * 144 + (32 * ks + 4 * fq) * 2), r1_ = *(const LAS u32x2*)(B + CS_RH + fr * 144 + (32 * ks + 16 + 4 * fq) * 2); \
            wt = __builtin_amdgcn_mfma_f32_16x16x32_bf16(__builtin_bit_cast(bf16x8, ((u32x4){a0_.x, a0_.y, a1_.x, a1_.y})), sp[ks], wt, 0, 0, 0); \
            yt = __builtin_amdgcn_mfma_f32_16x16x32_bf16(__builtin_bit_cast(bf16x8, ((u32x4){r0_.x, r0_.y, r1_.x, r1_.y})), sp[ks], yt, 0, 0, 0); } \
        { const u32x2 ak = *(const LAS u32x2*)(B + CS_AAK + fr * 32 + fq * 8); \
          wt = __builtin_amdgcn_mfma_f32_16x16x32_bf16(__builtin_bit_cast(bf16x8, ((u32x4){ak.x, ak.y, 0u, 0u})), __builtin_bit_cast(bf16x8, ((u32x4){vmf.x, vmf.y, 0u, 0u})), wt, 0, 0, 0); } \
        const f32x4 mrow = *(const LAS f32x4*)(B + CS_MM + fr * 80 + fq * 16); \
        f32x4 ut = {0.f, 0.f, 0.f, 0.f}; \
        _Pragma("unroll") for (int ks = 0; ks < 4; ++ks) ut = __builtin_amdgcn_mfma_f32_16x16x4f32(mrow[ks], wt[ks], ut, 0, 0, 0); \
        const u32x2 utp = pg8::cvt4_bf16(ut); const bf16x8 uv = __builtin_bit_cast(bf16x8, ((u32x4){utp.x, utp.y, vmf.x, vmf.y})); \
        { const u32x2 q0_ = *(const LAS u32x2*)(B + CS_ARBK + fr * 80 + fq * 8), q1_ = *(const LAS u32x2*)(B + CS_ARBK + fr * 80 + 32 + fq * 8); \
          yt = __builtin_amdgcn_mfma_f32_16x16x32_bf16(__builtin_bit_cast(bf16x8, ((u32x4){q0_.x, q0_.y, q1_.x, q1_.y})), uv, yt, 0, 0, 0); } \
        _Pragma("unroll") for (int r = 0; r < 4; ++r) YS[((size_t)b * 4096 + (c) * 16 + 4 * fq + r) * 256 + h * 64 + v0 + fr] = yt[r]; \
        _Pragma("unroll") for (int kt = 0; kt < 4; ++kt) { \
            const u32x2 b0_ = *(const LAS u32x2*)(B + CS_BKT + (16 * kt + fr) * 80 + fq * 8), b1_ = *(const LAS u32x2*)(B + CS_BKT + (16 * kt + fr) * 80 + 32 + fq * 8); \
            const f32x4 gm = *(const LAS f32x4*)(B + CS_GAM + (16 * kt + 4 * fq) * 4); \
            S[kt] = __builtin_amdgcn_mfma_f32_16x16x32_bf16(__builtin_bit_cast(bf16x8, ((u32x4){b0_.x, b0_.y, b1_.x, b1_.y})), uv, S[kt], 0, 0, 0) * gm; } } } while (0)
    CS_LOAD(R0, 0); CS_LOAD(R1, 1);
    __syncthreads();
    CS_WRITE(R0, 0); CS_LOAD(R0, 2);
    __syncthreads();
    for (int c = 0; c < 256; c += 2) {
        CS_COMPUTE(0, c);
        CS_WRITE(R1, 1); if (c + 3 < 256) CS_LOAD(R1, c + 3);
        __syncthreads();
        CS_COMPUTE(1, c + 1);
        if (c + 2 < 256) { CS_WRITE(R0, 0); if (c + 4 < 256) CS_LOAD(R0, c + 4); }
        __syncthreads();
    }
#undef CS_LOAD
#undef CS_WRITE
#undef CS_COMPUTE
}

__device__ __forceinline__ void rwkv_post(const Frame& F, int l) {
    const float* YS = WSP(const float, WS_YSCAN); const bf16_t* VMT = WSP(const bf16_t, WS_CS_VMT); const bf16_t* RG = WSP(const bf16_t, WS_RG); const float* BON = WSP(const float, WS_BONUS);
    bf16_t* YR = WSP(bf16_t, WS_YCAT) + 512;
    for (int ci = F.bid * 8 + F.wave; ci < 32 * 256; ci += F.G * 8) {
        const int bh = ci >> 8, c = ci & 255, b = bh >> 2, h = bh & 3, ch = h * 64 + F.lane;
        const float lnw = F.in(20)[l * 256 + ch], lnb = F.in(21)[l * 256 + ch];
        const u32x4 v0 = *(const u32x4*)(VMT + ((size_t)ci * 64 + F.lane) * 16), v1 = *(const u32x4*)(VMT + ((size_t)ci * 64 + F.lane) * 16 + 8);
        const unsigned vw[8] = {v0.x, v0.y, v0.z, v0.w, v1.x, v1.y, v1.z, v1.w};
        const size_t row0 = (size_t)b * 4096 + c * 16;
        float y[16], g[16], bo[16];
#pragma unroll
        for (int t = 0; t < 16; ++t) { y[t] = YS[(row0 + t) * 256 + ch]; g[t] = bf2f(RG[(row0 + t) * 256 + ch]); bo[t] = BON[(row0 + t) * 4 + h]; }
#pragma unroll
        for (int t = 0; t < 16; ++t) {
            const float mean = wave_sum(y[t]) * (1.0f / 64.0f); const float d = y[t] - mean; const float var = wave_sum(d * d) * (1.0f / 64.0f);
            const float yn = d * rsqrtf(var + 64e-5f) * lnw + lnb; const float v = (t & 1) ? bfhi(vw[t >> 1]) : bflo(vw[t >> 1]);
            YR[(row0 + t) * 1024 + ch] = f2bf((yn + bo[t] * v) * g[t]);
        }
    }
}

struct S5Coef { float are, aim; bf16x8 Bf[8]; };
__device__ __forceinline__ void s5_abar(const Frame& F, int l, int g, int p, float& are, float& aim, float& cre, float& cim) {
    const float lr = F.in(22)[(l * 16 + g) * 64 + p], li = F.in(23)[(l * 16 + g) * 64 + p], dt = expf(F.in(24)[l * 16 + g]);
    const float mag = expf(lr * dt); float sn, cs; sincosf(li * dt, &sn, &cs);
    are = mag * cs; aim = mag * sn;
    const float den = lr * lr + li * li; cre = ((are - 1.0f) * lr + aim * li) / den; cim = (aim * lr - (are - 1.0f) * li) / den;
}
__device__ __forceinline__ void s5_setup(const Frame& F, int l, int g, int lane, S5Coef& C) {
    float cre, cim; s5_abar(F, l, g, lane, C.are, C.aim, cre, cim);
    const int fr = lane & 15, fq = lane >> 4;
#pragma unroll
    for (int pt = 0; pt < 4; ++pt) {
        const int p = 16 * pt + fr; float are, aim, c_re, c_im; s5_abar(F, l, g, p, are, aim, c_re, c_im);
        u32x4 wr = {0u, 0u, 0u, 0u}, wi = {0u, 0u, 0u, 0u};
        if (fq < 2) {
            const float* bre = F.in(25) + ((size_t)(l * 16 + g) * 64 + p) * 16 + 8 * fq; const float* bim = F.in(26) + ((size_t)(l * 16 + g) * 64 + p) * 16 + 8 * fq;
            float re[8], im[8];
#pragma unroll
            for (int j = 0; j < 8; ++j) { re[j] = c_re * bre[j] - c_im * bim[j]; im[j] = c_re * bim[j] + c_im * bre[j]; }
            wr = (u32x4){pk2(re[0], re[1]), pk2(re[2], re[3]), pk2(re[4], re[5]), pk2(re[6], re[7])}; wi = (u32x4){pk2(im[0], im[1]), pk2(im[2], im[3]), pk2(im[4], im[5]), pk2(im[6], im[7])};
        }
        C.Bf[pt] = __builtin_bit_cast(bf16x8, wr); C.Bf[pt + 4] = __builtin_bit_cast(bf16x8, wi);
    }
}
template <int NSTEPS>
__device__ __forceinline__ void s5_stage_u(const bf16_t* ZS, int b, int g, int t0, LAS unsigned char* us, int lane) {
#pragma unroll
    for (int i = 0; i < NSTEPS / 32; ++i) { const int id = lane + 64 * i, step = id >> 1, hf = id & 1;
        const u32x4 v = *(const u32x4*)(ZS + ((size_t)(b * 4096 + t0 + step) * 256 + g * 16 + hf * 8));
        *(LAS u32x4*)(us + id * 16) = v; }
    asm volatile("s_waitcnt vmcnt(0) lgkmcnt(0)" ::: "memory");
}
__device__ __forceinline__ void s5_project16(const S5Coef& C, const LAS unsigned char* us16, LAS unsigned* bu, int fr, int fq) {
    u32x4 a = {0u, 0u, 0u, 0u};
    if (fq < 2) a = *(const LAS u32x4*)(us16 + fr * 32 + fq * 16);
    const bf16x8 af = __builtin_bit_cast(bf16x8, a);
    f32x4 c[8];
#pragma unroll
    for (int i = 0; i < 8; ++i) { const int nt = (i >> 1) + 4 * (i & 1);
        c[nt] = __builtin_amdgcn_mfma_f32_16x16x32_bf16(af, C.Bf[nt], (f32x4){0.f, 0.f, 0.f, 0.f}, 0, 0, 0); }
    asm volatile("s_nop 15\n\ts_nop 15\n\ts_nop 15\n\ts_nop 15\n\ts_nop 15\n\ts_nop 15\n\ts_nop 15\n\ts_nop 15\n\ts_nop 15\n\ts_nop 15" : "+v"(c[0]), "+v"(c[1]), "+v"(c[2]), "+v"(c[3]), "+v"(c[4]), "+v"(c[5]), "+v"(c[6]), "+v"(c[7]));
    unsigned w[16];
#pragma unroll
    for (int pt = 0; pt < 4; ++pt)
#pragma unroll
        for (int r = 0; r < 4; ++r) w[pt * 4 + r] = pg8::cvt_pk_bf16(c[pt][r], c[pt + 4][r]);
    asm volatile("" : "+v"(w[0]), "+v"(w[1]), "+v"(w[2]), "+v"(w[3]), "+v"(w[4]), "+v"(w[5]), "+v"(w[6]), "+v"(w[7]), "+v"(w[8]), "+v"(w[9]), "+v"(w[10]), "+v"(w[11]), "+v"(w[12]), "+v"(w[13]), "+v"(w[14]), "+v"(w[15]));
#pragma unroll
    for (int pt = 0; pt < 4; ++pt)
#pragma unroll
        for (int r = 0; r < 4; ++r) bu[(4 * fq + r) * 64 + 16 * pt + fr] = w[pt * 4 + r];
    asm volatile("s_waitcnt lgkmcnt(0)" : "+v"(w[0]), "+v"(w[1]), "+v"(w[2]), "+v"(w[3]), "+v"(w[4]), "+v"(w[5]), "+v"(w[6]), "+v"(w[7]), "+v"(w[8]), "+v"(w[9]), "+v"(w[10]), "+v"(w[11]), "+v"(w[12]), "+v"(w[13]), "+v"(w[14]), "+v"(w[15]) :: "memory");
}
__device__ __forceinline__ void s5_pass1(const Frame& F, int l, int item) {
    const int b = item >> 8, g = (item >> 4) & 15, ch = item & 15, p = F.lane, fr = F.lane & 15, fq = F.lane >> 4;
    LAS unsigned char* us = F.lds + F.wave * 12288;
    LAS unsigned* bu = (LAS unsigned*)(us + 8192);
    S5Coef C; s5_setup(F, l, g, F.lane, C);
    s5_stage_u<256>(WSP(const bf16_t, WS_ZS), b, g, ch * 256, us, F.lane);
    float xr = 0.f, xi = 0.f;
    for (int t16 = 0; t16 < 16; ++t16) {
        s5_project16(C, us + t16 * 512, bu, fr, fq);
#pragma unroll
        for (int q = 0; q < 16; ++q) { const unsigned v = bu[q * 64 + p]; const float nr = C.are * xr - C.aim * xi + bflo(v), ni = C.are * xi + C.aim * xr + bfhi(v); xr = nr; xi = ni; }
        asm volatile("s_waitcnt lgkmcnt(0)" ::: "memory");
    }
    *(f32x2*)(WSP(float, WS_XEND) + ((size_t)((b * 16 + g) * 16 + ch) * 64 + p) * 2) = (f32x2){xr, xi};
}
__device__ __forceinline__ void s5_pass2(const Frame& F, int l, int item) {
    const int b = item >> 8, g = (item >> 4) & 15, ch = item & 15, p = F.lane, fr = F.lane & 15, fq = F.lane >> 4;
    LAS unsigned char* us = F.lds + F.wave * 12544;
    LAS unsigned* bu = (LAS unsigned*)(us + 4096); LAS unsigned char* xs = us + 8192;
    S5Coef C; s5_setup(F, l, g, F.lane, C);
    bf16x8 cb[4];
    {
        const float* cre = F.in(27) + ((size_t)(l * 16 + g) * 16 + fr) * 64; const float* cim = F.in(28) + ((size_t)(l * 16 + g) * 16 + fr) * 64;
#pragma unroll
        for (int ks = 0; ks < 4; ++ks) { const float* src = (ks < 2 ? cre : cim) + (ks & 1) * 32 + 8 * fq; const f32x4 a0 = *(const f32x4*)src, a1 = *(const f32x4*)(src + 4); const float sg = ks < 2 ? 1.f : -1.f;
            u32x4 w; w.x = pk2(sg * a0[0], sg * a0[1]); w.y = pk2(sg * a0[2], sg * a0[3]); w.z = pk2(sg * a1[0], sg * a1[1]); w.w = pk2(sg * a1[2], sg * a1[3]); cb[ks] = __builtin_bit_cast(bf16x8, w); }
    }
    float ar = C.are, ai = C.aim;
#pragma unroll
    for (int i = 0; i < 8; ++i) { const float nr = ar * ar - ai * ai, ni = 2.f * ar * ai; ar = nr; ai = ni; }
    float xr = 0.f, xi = 0.f;
    const float* XE = WSP(const float, WS_XEND) + ((size_t)((b * 16 + g) * 16) * 64 + p) * 2;
    for (int c2 = 0; c2 < ch; ++c2) { const f32x2 e = *(const f32x2*)(XE + (size_t)c2 * 128); const float nr = ar * xr - ai * xi + e[0], ni = ar * xi + ai * xr + e[1]; xr = nr; xi = ni; }
    bf16_t* YG = WSP(bf16_t, WS_YS5G);
    const float dcoef = F.in(29)[(l * 16 + g) * 16 + fr];
    for (int t16 = 0; t16 < 16; ++t16) {
        if ((t16 & 7) == 0) s5_stage_u<128>(WSP(const bf16_t, WS_ZS), b, g, ch * 256 + t16 * 16, us, F.lane);
        const LAS unsigned char* us16 = us + (t16 & 7) * 512;
        s5_project16(C, us16, bu, fr, fq);
#pragma unroll
        for (int q = 0; q < 16; ++q) { const unsigned v = bu[q * 64 + p]; const float nr = C.are * xr - C.aim * xi + bflo(v), ni = C.are * xi + C.aim * xr + bfhi(v); xr = nr; xi = ni;
            *(LAS bf16_t*)(xs + q * 272 + p * 2) = f2bf(xr); *(LAS bf16_t*)(xs + q * 272 + 128 + p * 2) = f2bf(xi); }
        asm volatile("s_waitcnt lgkmcnt(0)" ::: "memory");
        f32x4 acc = {0.f, 0.f, 0.f, 0.f};
#pragma unroll
        for (int ks = 0; ks < 4; ++ks) { const bf16x8 af = *(const LAS bf16x8*)(xs + fr * 272 + ks * 64 + fq * 16); acc = __builtin_amdgcn_mfma_f32_16x16x32_bf16(af, cb[ks], acc, 0, 0, 0); }
#pragma unroll
        for (int r = 0; r < 4; ++r) { const int st = 4 * fq + r; const float u = bf2f(*(const LAS bf16_t*)(us16 + st * 32 + fr * 2));
            YG[(size_t)(b * 4096 + ch * 256 + t16 * 16 + st) * 256 + g * 16 + fr] = f2bf(gelu_tanh(acc[r] + dcoef * u)); }
        asm volatile("s_waitcnt lgkmcnt(0)" ::: "memory");
    }
}

__device__ __forceinline__ void cmp_bias(const Frame& F, int l, int w) {
    const int kv = w >> 5, part = w & 31;
    const float* pos = F.in(kv ? 6 : 5) + (size_t)l * 2048; const float* w1 = F.in(kv ? 9 : 7) + (size_t)l * 2048 * 256;
    LAS float* red = (LAS float*)F.lds;
    __syncthreads();
    const int j = F.tid & 255, hf = F.tid >> 8; float s = 0.f;
#pragma unroll 8
    for (int ii = 0; ii < 32; ++ii) { const int i = part * 64 + hf * 32 + ii; s += pos[i] * w1[(size_t)i * 256 + j]; }
    red[F.tid] = s;
    __syncthreads();
    if (F.tid < 256) WSP(float, WS_CBIAS)[(size_t)w * 256 + F.tid] = red[F.tid] + red[F.tid + 256];
    __syncthreads();
}
__device__ __forceinline__ void cmp_finalize(const Frame& F, int l) {
    LAS float* hid = (LAS float*)F.lds + F.wave * 256; LAS float* biasL = (LAS float*)F.lds + 2048;
    __syncthreads();
    { const float* part = WSP(const float, WS_CBIAS) + (size_t)(F.tid >> 8) * 32 * 256 + (F.tid & 255); float sb = 0.f;
#pragma unroll 8
      for (int q = 0; q < 32; ++q) sb += part[q * 256];
      biasL[F.tid] = sb; }
    __syncthreads();
    for (int idx = F.bid * 8 + F.wave; idx < 2 * 4096; idx += F.G * 8) {
        const int kv = idx >> 12, bg = (idx >> 8) & 15, n = idx & 255;
        const bf16_t* PQ = WSP(const bf16_t, WS_PQ + (size_t)kv * 4 * MiB); const LAS float* bias = biasL + kv * 256;
        const float* w2 = F.in(kv ? 10 : 8) + (size_t)l * 256 * 64;
        float o = 0.f;
        if (n < 255) {
            asm volatile("s_waitcnt lgkmcnt(0)" ::: "memory");
#pragma unroll
            for (int i = 0; i < 4; ++i) { const int j = F.lane + 64 * i; hid[j] = gelu_tanh(bf2f(PQ[(size_t)(bg * 256 + n) * 512 + j]) + bf2f(PQ[(size_t)(bg * 256 + n + 1) * 512 + 256 + j]) + bias[j]); }
            asm volatile("s_waitcnt lgkmcnt(0)" ::: "memory");
#pragma unroll 8
            for (int j = 0; j < 256; ++j) o += hid[j] * w2[j * 64 + F.lane];
        }
        if (kv == 0) WSP(bf16_t, WS_KCC)[(size_t)(bg * 256 + n) * 64 + F.lane] = f2bf(o);
        else WSP(bf16_t, WS_VCCT)[(size_t)(bg * 64 + F.lane) * 256 + vperm(n)] = f2bf(o);
    }
}

struct AttnAcc { float m[2], l[2]; f32x4 o[2][4]; };
__device__ __forceinline__ void attn_init(AttnAcc& a) {
#pragma unroll
    for (int mt = 0; mt < 2; ++mt) { a.m[mt] = -1e30f; a.l[mt] = 0.f;
#pragma unroll
        for (int dt = 0; dt < 4; ++dt) a.o[mt][dt] = (f32x4){0.f, 0.f, 0.f, 0.f}; }
}
constexpr int KP = 160, VP = 160;
constexpr int TB_K0 = 0, TB_V0 = 10240, TB_K1 = 20480, TB_V1 = 30720, TB_END = 40960;
struct MaskInfo { int qb; int tq[2]; int nmax[2]; u64 selm[2]; };
template <int KIND> __device__ __forceinline__ bool mask_el(const MaskInfo& M, int mt, int tile, int kl) {
    if (KIND == 0) return tile * 64 + kl <= M.nmax[mt];
    if (KIND == 1) return kl <= M.tq[mt];
    if (KIND == 2) return tile == M.qb ? (kl <= M.tq[mt]) : (kl > M.tq[mt]);
    return true;
}
template <int MODE, int KIND, bool MASKED, int MT0 = 0, int MT1 = 2>
__device__ __forceinline__ void attn_tile(const LAS unsigned char* Kt, const LAS unsigned char* Vt, const bf16x8 (&qf)[2][2], AttnAcc& a, const MaskInfo& M, int tile, float cexp,
                                          int fr, int fq, LAS float* impA, LAS float* impB, int qbase) {
    f32x4 s[2][4];
#pragma unroll
    for (int nt = 0; nt < 4; ++nt) {
        const bf16x8 k0 = *(const LAS bf16x8*)(Kt + (16 * nt + fr) * KP + fq * 16), k1 = *(const LAS bf16x8*)(Kt + (16 * nt + fr) * KP + 64 + fq * 16);
#pragma unroll
        for (int mt = MT0; mt < MT1; ++mt) { f32x4 z = {0.f, 0.f, 0.f, 0.f}; z = __builtin_amdgcn_mfma_f32_16x16x32_bf16(k0, qf[mt][0], z, 0, 0, 0); z = __builtin_amdgcn_mfma_f32_16x16x32_bf16(k1, qf[mt][1], z, 0, 0, 0); s[mt][nt] = z;
#if PROBE_MFMA2X
            if (MODE == 0) { f32x4 z2 = {1.f, 0.f, 0.f, 0.f}; z2 = __builtin_amdgcn_mfma_f32_16x16x32_bf16(k1, qf[mt][0], z2, 0, 0, 0); z2 = __builtin_amdgcn_mfma_f32_16x16x32_bf16(k0, qf[mt][1], z2, 0, 0, 0); asm volatile("" :: "v"(z2)); }
#endif
        }
    }
#pragma unroll
    for (int mt = MT0; mt < MT1; ++mt) {
        bool flag = true;
        if (KIND == 1) flag = ((M.selm[mt] >> tile) & 1ull) != 0ull;
        float mx = -1e30f;
#pragma unroll
        for (int nt = 0; nt < 4; ++nt)
#pragma unroll
            for (int r = 0; r < 4; ++r) { float v = s[mt][nt][r]; if (MASKED) { v = mask_el<KIND>(M, mt, tile, 16 * nt + 4 * fq + r) ? v : -1e30f; s[mt][nt][r] = v; } mx = fmaxf(mx, v); }
        if (MODE != 2) {
            mx = xmax16(mx); mx = xmax32(mx);
            mx = flag ? mx : -1e30f;
            const float mnew = fmaxf(a.m[mt], mx), alpha = __builtin_amdgcn_exp2f((a.m[mt] - mnew) * cexp); a.m[mt] = mnew;
            const float mc = (flag && mnew > -1e29f) ? mnew * cexp : 1e30f;
            float ps = 0.f;
#pragma unroll
            for (int nt = 0; nt < 4; ++nt)
#pragma unroll
                for (int r = 0; r < 4; ++r) { const float pv = __builtin_amdgcn_exp2f(__builtin_fmaf(s[mt][nt][r], cexp, -mc));
#if PROBE_EXP2X
                    { float dummy = __builtin_amdgcn_exp2f(__builtin_fmaf(s[mt][nt][r], cexp * 0.5f, -mc)); asm volatile("" :: "v"(dummy)); }
#endif
                    s[mt][nt][r] = pv; ps += pv; }
            a.l[mt] = a.l[mt] * alpha + ps;
            if (MODE == 0) {
                if (__ballot(alpha != 1.0f) != 0ull) {
#pragma unroll
                    for (int dt = 0; dt < 4; ++dt) a.o[mt][dt] *= alpha;
                }
            }
        } else {
            const float mc = a.m[mt] > -1e29f ? a.m[mt] * cexp : 1e30f;
#pragma unroll
            for (int nt = 0; nt < 4; ++nt) {
#pragma unroll
                for (int r = 0; r < 4; ++r) s[mt][nt][r] = __builtin_amdgcn_exp2f(__builtin_fmaf(s[mt][nt][r], cexp, -mc)) * a.l[mt];
                float A4 = (s[mt][nt][0] + s[mt][nt][1]) + (s[mt][nt][2] + s[mt][nt][3]), B1 = s[mt][nt][3];
                A4 = quad_sum(A4); B1 = quad_sum(B1);
                if ((fr & 3) == 0) { const int ql = qbase + ((fr + 16 * mt) >> 2), J = 16 * tile + 4 * nt + fq; impA[ql * 64 + J] = A4; impB[ql * 64 + J] = B1; }
            }
        }
    }
    if (MODE != 1) {
#pragma unroll
        for (int ks = 0; ks < 2; ++ks) {
            bf16x8 pb[2];
#pragma unroll
            for (int mt = MT0; mt < MT1; ++mt) {
                const f32x4 p0 = s[mt][2 * ks], p1 = s[mt][2 * ks + 1];
                pb[mt] = pg8::cvt8_bf16(p0, p1);
            }
#pragma unroll
            for (int dt = 0; dt < 4; ++dt) {
                const bf16x8 vf = *(const LAS bf16x8*)(Vt + (16 * dt + fr) * VP + (32 * ks + 8 * fq) * 2);
#pragma unroll
                for (int mt = MT0; mt < MT1; ++mt) a.o[mt][dt] = __builtin_amdgcn_mfma_f32_16x16x32_bf16(vf, pb[mt], a.o[mt][dt], 0, 0, 0);
            }
        }
    }
}
template <int KIND> __device__ __forceinline__ bool tile_masked(int qb, int tile) {
    if (KIND == 0) { const int t0 = qb * 64; const int nmin = t0 >= 31 ? ((t0 - 31) >> 4) : -1; return tile * 64 + 63 > nmin; }
    if (KIND == 1) return tile == qb;
    if (KIND == 2) return tile == qb || tile == qb - 8;
    return false;
}
__device__ __forceinline__ int pop_tile(u64& m) { if (m == 0ull) return -1; const int t = __builtin_ctzll(m); m &= m - 1ull; return t; }
template <int MODE, int KIND>
__device__ __forceinline__ void attn_run(const Frame& F, u64 tmask, const bf16_t* Kb, const bf16_t* Vb, int vstride, const bf16x8 (&qf)[2][2], AttnAcc& a, const MaskInfo& M,
                                         LAS float* impA, LAS float* impB, int qbase) {
    const int fr = F.lane & 15, fq = F.lane >> 4, lr = F.tid >> 3, lc = F.tid & 7;
    const float cexp = 0.125f * 1.4426950408889634f;
    if (tmask == 0ull) return;
    const unsigned kofs = (unsigned)(lr * 64 + lc * 8), vofs = (unsigned)(lr * vstride + lc * 8);
    const int kl = lr * KP + lc * 16, vl = lr * VP + lc * 16;
#define AT_LOAD(R, t) do { R##k = *(const u32x4*)(Kb + (kofs + (unsigned)(t) * 4096u)); if (MODE != 1) R##v = *(const u32x4*)(Vb + (vofs + (unsigned)(t) * 64u)); } while (0)
#define AT_WRITE(R, kb, vb) do { *(LAS u32x4*)(F.lds + (kb) + kl) = R##k; if (MODE != 1) *(LAS u32x4*)(F.lds + (vb) + vl) = R##v; } while (0)
#define AT_CALL(MSK, A0, A1) attn_tile<MODE, KIND, MSK, A0, A1>(F.lds + (kb_), F.lds + (vb_), qf, a, M, (t_), cexp, fr, fq, impA, impB, qbase)
#define AT_COMPUTE(kb, vb, t) do { const int kb_ = (kb), vb_ = (vb), t_ = (t); bool n0 = true, n1 = true; \
        if (KIND == 1) { n0 = __ballot(((M.selm[0] >> t_) & 1ull) != 0ull) != 0ull; n1 = __ballot(((M.selm[1] >> t_) & 1ull) != 0ull) != 0ull; } \
        if (tile_masked<KIND>(M.qb, t_)) { if (n0 || n1) AT_CALL(true, 0, 2); }                        \
        else if (KIND != 1 || (n0 && n1)) AT_CALL(false, 0, 2); \
        else if (n0) AT_CALL(false, 0, 1); \
        else if (n1) AT_CALL(false, 1, 2); } while (0)
    u32x4 R0k = {0u, 0u, 0u, 0u}, R0v = {0u, 0u, 0u, 0u}, R1k = {0u, 0u, 0u, 0u}, R1v = {0u, 0u, 0u, 0u};
    int t0 = pop_tile(tmask), t1 = pop_tile(tmask), t2 = pop_tile(tmask), t3 = pop_tile(tmask);
    AT_LOAD(R0, t0);
    if (t1 >= 0) AT_LOAD(R1, t1);
    __syncthreads();
    AT_WRITE(R0, TB_K0, TB_V0);
    if (t2 >= 0) AT_LOAD(R0, t2);
    __syncthreads();
    for (;;) {
        AT_COMPUTE(TB_K0, TB_V0, t0);
        if (t1 < 0) break;
        AT_WRITE(R1, TB_K1, TB_V1);
        if (t3 >= 0) AT_LOAD(R1, t3);
        __syncthreads();
        t0 = t1; t1 = t2; t2 = t3; t3 = pop_tile(tmask);
        AT_COMPUTE(TB_K1, TB_V1, t0);
        if (t1 < 0) break;
        AT_WRITE(R0, TB_K0, TB_V0);
        if (t3 >= 0) AT_LOAD(R0, t3);
        __syncthreads();
        t0 = t1; t1 = t2; t2 = t3; t3 = pop_tile(tmask);
    }
#undef AT_LOAD
#undef AT_WRITE
#undef AT_COMPUTE
#undef AT_CALL
}

__device__ __forceinline__ void nsa_item(const Frame& F, int b, int g, int qb) {
    const int fr = F.lane & 15, fq = F.lane >> 4, t0 = qb * 64, qbase = 8 * F.wave;
    LAS float* impA = (LAS float*)(F.lds + 40960); LAS float* impB = (LAS float*)(F.lds + 40960 + 16384);
    LAS u64* selL = (LAS u64*)(F.lds + 106496); LAS u64* worL = (LAS u64*)(F.lds + 106496 + 512);
    const bf16_t* Q = WSP(const bf16_t, WS_Q); const bf16_t* NG = WSP(const bf16_t, WS_NG);
    const float* ropec = WSP(const float, WS_ROPE); const float* ropes = ropec + 4096 * 32;
    int ql[2]; const int r = fr & 3, head = g * 4 + r;
    bf16x8 qf[2][2];
    MaskInfo M; M.qb = qb;
#pragma unroll
    for (int mt = 0; mt < 2; ++mt) {
        ql[mt] = qbase + ((fr + 16 * mt) >> 2); M.tq[mt] = ql[mt]; const int t = t0 + ql[mt]; M.nmax[mt] = t >= 31 ? ((t - 31) >> 4) : -1; M.selm[mt] = 0ull;
#pragma unroll
        for (int ks = 0; ks < 2; ++ks) qf[mt][ks] = *(const bf16x8*)(Q + ((size_t)(b * 4096 + t) * 512 + head * 64 + ks * 32 + fq * 8));
    }
    LAS float* ysl = (LAS float*)(F.lds + 40960) + F.tid;
    const int ntc = (4 * qb + 2) / 64 + 1; const u64 cmask = (ntc >= 64) ? ~0ull : ((1ull << ntc) - 1ull);
    const bf16_t* KCc = WSP(const bf16_t, WS_KCC) + (size_t)((b * 2 + g) * 256) * 64; const bf16_t* VCt = WSP(const bf16_t, WS_VCCT) + (size_t)((b * 2 + g) * 64) * 256;
    AttnAcc a; attn_init(a);
    attn_run<1, 0>(F, cmask, KCc, VCt, 256, qf, a, M, impA, impB, qbase);
#pragma unroll
    for (int mt = 0; mt < 2; ++mt) { float L = a.l[mt]; L = xsum16(L); L = xsum32(L); a.l[mt] = L > 0.f ? 1.0f / L : 0.f; }
    attn_run<2, 0>(F, cmask, KCc, VCt, 256, qf, a, M, impA, impB, qbase);
    __syncthreads();
    {
        u64 wor = 0ull;
        for (int qi = 0; qi < 8; ++qi) {
            const int q = qbase + qi, J = F.lane; u64 m;
            if (qb < 16) m = (2ull << qb) - 1ull;
            else {
                const float val = impA[q * 64 + J] + (J > 0 ? impB[q * 64 + (J > 0 ? J - 1 : 0)] : 0.f);
                const bool forced = (J == 0) || (J == qb) || (J == qb - 1);
                const unsigned key = (J <= qb) ? (forced ? 0x7f000000u : (val > 0.f ? __float_as_uint(val) : 0u)) : 0u;
                const u64 valid = (2ull << qb) - 1ull;
                unsigned thr = 0u;
                for (int bit = 30; bit >= 0; --bit) { const unsigned cand = thr | (1u << bit); if (__builtin_popcountll(__ballot(key >= cand) & valid) >= 16) thr = cand; }
                const u64 gt = __ballot(key > thr) & valid, eq = __ballot(key == thr) & valid; const int need = 16 - __builtin_popcountll(gt);
                const bool sel = (key > thr) || (key == thr && __builtin_popcountll(eq & ((1ull << J) - 1ull)) < need);
                m = __ballot(sel && J <= qb);
            }
            if (F.lane == 0) selL[q] = m;
            wor |= m;
        }
        if (F.lane == 0) worL[F.wave] = wor;
    }
    __syncthreads();
    u64 umask = 0ull;
#pragma unroll
    for (int w = 0; w < 8; ++w) umask |= worL[w];
    M.selm[0] = selL[ql[0]]; M.selm[1] = selL[ql[1]];
#pragma unroll
    for (int mt = 0; mt < 2; ++mt) { const float gt = sigmoidf_(bf2f(NG[(size_t)(b * 4096 + t0 + ql[mt]) * 32 + head * 3 + 0]));
#pragma unroll
        for (int dt = 0; dt < 4; ++dt)
#pragma unroll
            for (int r4 = 0; r4 < 4; ++r4) ysl[((mt * 4 + dt) * 4 + r4) * 512] = a.o[mt][dt][r4] * gt; }
#pragma unroll
    for (int mt = 0; mt < 2; ++mt) {
        const int t = t0 + ql[mt]; const f32x4 c0 = *(const f32x4*)(ropec + t * 32 + 8 * fq), c1 = *(const f32x4*)(ropec + t * 32 + 8 * fq + 4), s0 = *(const f32x4*)(ropes + t * 32 + 8 * fq), s1 = *(const f32x4*)(ropes + t * 32 + 8 * fq + 4);
        bf16x8 r1, r2;
#pragma unroll
        for (int j = 0; j < 8; ++j) { const float x1 = bf2f((bf16_t)qf[mt][0][j]), x2 = bf2f((bf16_t)qf[mt][1][j]); const float cs = j < 4 ? c0[j & 3] : c1[j & 3], sn = j < 4 ? s0[j & 3] : s1[j & 3];
            r1[j] = (short)f2bf(x1 * cs - x2 * sn); r2[j] = (short)f2bf(x1 * sn + x2 * cs); }
        qf[mt][0] = r1; qf[mt][1] = r2;
    }
    const size_t kvoff = (size_t)((b * 2 + g) * 4096) * 64, vtoff = (size_t)((b * 2 + g) * 64) * 4096;
    attn_init(a);
    attn_run<0, 1>(F, umask, WSP(const bf16_t, WS_KS) + kvoff, WSP(const bf16_t, WS_VST) + vtoff, 4096, qf, a, M, impA, impB, qbase);
#pragma unroll
    for (int mt = 0; mt < 2; ++mt) { float L = a.l[mt]; L = xsum16(L); L = xsum32(L);
        const float sc = (L > 0.f ? 1.0f / L : 0.f) * sigmoidf_(bf2f(NG[(size_t)(b * 4096 + t0 + ql[mt]) * 32 + head * 3 + 1]));
#pragma unroll
        for (int dt = 0; dt < 4; ++dt)
#pragma unroll
            for (int r4 = 0; r4 < 4; ++r4) ysl[((mt * 4 + dt) * 4 + r4) * 512] += a.o[mt][dt][r4] * sc; }
    const int wlo = qb >= 8 ? qb - 8 : 0; const u64 wmask = ((2ull << qb) - 1ull) & ~((1ull << wlo) - 1ull);
    attn_init(a);
    attn_run<0, 2>(F, wmask, WSP(const bf16_t, WS_KW) + kvoff, WSP(const bf16_t, WS_VWT) + vtoff, 4096, qf, a, M, impA, impB, qbase);
#pragma unroll
    for (int mt = 0; mt < 2; ++mt) { float L = a.l[mt]; L = xsum16(L); L = xsum32(L);
        const float sc = (L > 0.f ? 1.0f / L : 0.f) * sigmoidf_(bf2f(NG[(size_t)(b * 4096 + t0 + ql[mt]) * 32 + head * 3 + 2]));
#pragma unroll
        for (int dt = 0; dt < 4; ++dt)
#pragma unroll
            for (int r4 = 0; r4 < 4; ++r4) a.o[mt][dt][r4] = ysl[((mt * 4 + dt) * 4 + r4) * 512] + a.o[mt][dt][r4] * sc; }
    bf16_t* Y = WSP(bf16_t, WS_YCAT);
#pragma unroll
    for (int mt = 0; mt < 2; ++mt)
#pragma unroll
        for (int dt = 0; dt < 4; ++dt) *(u32x2*)(Y + ((size_t)(b * 4096 + t0 + ql[mt]) * 1024 + head * 64 + 16 * dt + 4 * fq)) = pg8::cvt4_bf16(a.o[mt][dt]);
    __syncthreads();
}

__device__ __forceinline__ void xa_item(const Frame& F, int item) {
    const int b = item >> 6, head = (item >> 4) & 3, qt = item & 15, fr = F.lane & 15, fq = F.lane >> 4, t0 = qt * 256 + 32 * F.wave;
    const bf16_t* QX = WSP(const bf16_t, WS_QX);
    bf16x8 qf[2][2];
#pragma unroll
    for (int mt = 0; mt < 2; ++mt)
#pragma unroll
        for (int ks = 0; ks < 2; ++ks) qf[mt][ks] = *(const bf16x8*)(QX + ((size_t)(b * 4096 + t0 + fr + 16 * mt) * 256 + head * 64 + ks * 32 + fq * 8));
    MaskInfo M; M.qb = 0; M.tq[0] = M.tq[1] = 0; M.nmax[0] = M.nmax[1] = 0; M.selm[0] = M.selm[1] = 0ull;
    AttnAcc a; attn_init(a);
    attn_run<0, 3>(F, 0xFull, WSP(const bf16_t, WS_KX) + (size_t)((b * 4 + head) * 256) * 64, WSP(const bf16_t, WS_VXT) + (size_t)((b * 4 + head) * 64) * 256, 256, qf, a, M, nullptr, nullptr, 0);
    bf16_t* O = WSP(bf16_t, WS_XAO);
#pragma unroll
    for (int mt = 0; mt < 2; ++mt) { float L = a.l[mt]; L = xsum16(L); L = xsum32(L); const float sc = L > 0.f ? 1.0f / L : 0.f;
#pragma unroll
        for (int dt = 0; dt < 4; ++dt) *(u32x2*)(O + ((size_t)(b * 4096 + t0 + fr + 16 * mt) * 256 + head * 64 + 16 * dt + 4 * fq)) = pg8::cvt4_bf16(a.o[mt][dt] * sc); }
    __syncthreads();
}

template <class Fn> __device__ __forceinline__ void run_gemm(const Frame& F, const bf16_t* A, const bf16_t* Bt, int M, int N, int K, int G, int c, const Fn& fn) {
    pg8::Gemm g{A, Bt, M, N, K}; pg8::StaticOrder S; S.init(M, N, G, c); Epi8<Fn> E{fn};
    pg8::gemm_phase<Epi8<Fn>, pg8::StaticOrder>((PG8_LAS unsigned char*)F.lds, g, S, E, F.tid);
}

__global__ void __launch_bounds__(NTHR, 2) trunk_fwd(Params prm) {
    extern __shared__ __attribute__((aligned(16))) unsigned char lds_raw[];
    Frame F0; F0.kp = (const __attribute__((address_space(4))) char*)__builtin_amdgcn_kernarg_segment_ptr(); F0.ws = prm.ws; F0.lds = (LAS unsigned char*)lds_raw;
    F0.tid = threadIdx.x; F0.lane = F0.tid & 63; F0.wave = __builtin_amdgcn_readfirstlane(F0.tid >> 6); F0.bid = blockIdx.x; F0.G = gridDim.x;
    const int lo = prm.ph_lo, hi = prm.ph_hi;
    if (F0.tid < 8) ((LAS unsigned*)(F0.lds + LDS_CTL_OFF))[F0.tid] = 0u;
    __syncthreads();
    XcdBarrier bar; bar.bar = F0.ctl(); bar.x = 0; bar.st = nullptr;
    if (hi - lo > 1) bar = xcd_barrier_post(F0.ctl(), (volatile LAS unsigned*)(F0.lds + LDS_CTL_OFF));
#define IN(k) (lo <= (k) && (k) < hi)
#define SEAM(k) do { if (IN(k) && IN((k) + 1)) xcd_barrier(bar); } while (0)
#define PHASE_FRAME Frame F = F0; LAUNDER(F); asm volatile("" : "+v"(F.tid), "+s"(F.bid), "+s"(F.G), "+s"(F.wave)); F.lane = F.tid & 63
    if (PON(0) && IN(0)) {
        PHASE_FRAME;
        float* rc = WSP(float, WS_ROPE); float* rs = rc + 4096 * 32;
        for (int i = F.bid * NTHR + F.tid; i < 4096 * 32; i += F.G * NTHR) { const int t = i >> 5, j = i & 31; const float inv = 1.0f / powf(10000.0f, (float)j / 32.0f); const float ang = (float)t * inv;
            float sn, cs; sincosf(ang, &sn, &cs); rc[i] = cs; rs[i] = sn; }
        conv_layer(F, 0);
        norm_rows(F, TOK, F.in(0), nullptr, nullptr, nullptr, F.x16(), nullptr, nullptr, F.in(2), WSP(bf16_t, WS_H));
    }
    SEAM(0);
    for (int l = 0; l < DEPTH; ++l) {
        const int g0 = 1 + l * PH_PER_LAYER;
        if (PON(1) && IN(g0 + 0)) for (int rep = 0; rep < REPS[1]; ++rep) {
            PHASE_FRAME;
            FIn1 fn{WSP(bf16_t, WS_Q), WSP(bf16_t, WS_KC), WSP(bf16_t, WS_VC), WSP(bf16_t, WS_KS), WSP(bf16_t, WS_KW), WSP(bf16_t, WS_VST), WSP(bf16_t, WS_VWT), WSP(bf16_t, WS_ZR), WSP(bf16_t, WS_ZS), WSP(bf16_t, WS_NG),
                    WSP(const float, WS_ROPE), WSP(const float, WS_ROPE) + 4096 * 32};
            run_gemm(F, WSP(const bf16_t, WS_H), WSP(const bf16_t, W_IN1), TOK, 2816, 1024, F.G, F.bid, fn);
        }
        SEAM(g0 + 0);
        if (PON(2) && IN(g0 + 1)) for (int rep = 0; rep < REPS[2]; ++rep) {
            { PHASE_FRAME;
              if (F.bid < 32) run_gemm(F, WSP(const bf16_t, WS_KC), WSP(const bf16_t, W_C1K), 4096, 512, 1024, 32, F.bid, FStore{WSP(bf16_t, WS_PQ), 512});
              else if (F.bid < 64) run_gemm(F, WSP(const bf16_t, WS_VC), WSP(const bf16_t, W_C1V), 4096, 512, 1024, 32, F.bid - 32, FStore{WSP(bf16_t, WS_PQ + 4 * MiB), 512});
              else if (F.bid < 128) cmp_bias(F, l, F.bid - 64); }
            for (;;) {
                PHASE_FRAME;
                const int job = next_job(F, F.ctl() + CTL_Q0 + 64 * ((l * 4 + 0) * 4 + rep));
                if (job >= 256 + 512) break;
                if (job < 256) s5_pass1(F, l, job * 8 + F.wave);
                else rwkv_lin_tile(F, l, job - 256);
            }
        }
        SEAM(g0 + 1);
        if (PON(3) && IN(g0 + 2)) for (int rep = 0; rep < REPS[3]; ++rep) {
            { PHASE_FRAME; run_gemm(F, WSP(const bf16_t, WS_LIN), WSP(const bf16_t, W_LORA), TOK, 768, 256, F.G, F.bid, FLora{WSP(bf16_t, WS_LW), WSP(bf16_t, WS_LA), WSP(bf16_t, WS_RG)}); }
            { PHASE_FRAME; cmp_finalize(F, l); }
        }
        SEAM(g0 + 2);
        if (PON(4) && IN(g0 + 3)) for (int rep = 0; rep < REPS[4]; ++rep) { PHASE_FRAME; __syncthreads(); for (int it = F.bid * 8 + F.wave; it < 32 * 256; it += F.G * 8) rwkv_chunk_prep(F, l, it); }
        SEAM(g0 + 3);
        if (PON(5) && IN(g0 + 4)) for (int rep = 0; rep < REPS[5]; ++rep) {
#if !defined(SUB) || SUB == 1
            if (F0.bid < 32) for (int ra = 0; ra < REP_P4A; ++ra) { PHASE_FRAME; rwkv_chunk_scan(F, F.bid); }
#endif
            for (int rq = 0; rq < REP_P4B; ++rq)
            for (;;) {
                PHASE_FRAME;
                const int job = next_job(F, F.ctl() + CTL_Q0 + 64 * ((l * 4 + 1) * 4 + rep * 2 + rq));
                if (job >= 1024 + 256) break;
#if !defined(SUB) || SUB == 2
                if (job < 1024) { const int qb = 63 - (job >> 4), bg = job & 15; for (int rr = 0; rr < REP_NSA; ++rr) nsa_item(F, bg >> 1, bg & 1, qb); }
#endif
#if !defined(SUB) || SUB == 3
                if (job >= 1024) { __syncthreads(); for (int rr = 0; rr < REP_S5P2; ++rr) s5_pass2(F, l, (job - 1024) * 8 + F.wave); }
#endif
            }
        }
        SEAM(g0 + 4);
        if (PON(6) && IN(g0 + 5)) for (int rep = 0; rep < REPS[6]; ++rep) {
#if !defined(SUB) || SUB == 1
            if (F0.bid < 128) { PHASE_FRAME; run_gemm(F, WSP(const bf16_t, WS_YS5G), WSP(const bf16_t, W_GLU), TOK, 256, 256, 128, F.bid, FGluMul{WSP(const bf16_t, WS_YS5G), WSP(bf16_t, WS_YCAT) + 768, 256, 1024}); }
#endif
#if !defined(SUB) || SUB == 2
            { PHASE_FRAME; rwkv_post(F, l); }
#endif
        }
        SEAM(g0 + 5);
        if (PON(7) && IN(g0 + 6)) for (int rep = 0; rep < REPS[7]; ++rep) {
            { PHASE_FRAME; run_gemm(F, WSP(const bf16_t, WS_H), WSP(const bf16_t, W_MG), TOK, 3072, 1024, F.G, F.bid, FSigmoid{WSP(bf16_t, WS_G), 3072}); }
        }
        SEAM(g0 + 6);
        if (PON(8) && IN(g0 + 7)) for (int rep = 0; rep < REPS[8]; ++rep) {
            { PHASE_FRAME;
              pg8::Gemm g{WSP(const bf16_t, WS_YCAT), WSP(const bf16_t, W_UPN), TOK, 1024, 1024}; pg8::StaticOrder S; S.init(TOK, 1024, F.G, F.bid);
              Epi8<FMulStore> E{FMulStore{WSP(const bf16_t, WS_G), WSP(bf16_t, WS_MERGED)}};
              MergeHook H{WSP(const bf16_t, WS_G)};
              pg8::gemm_phase<Epi8<FMulStore>, pg8::StaticOrder, MergeHook>((PG8_LAS unsigned char*)F.lds, g, S, E, F.tid, H); }
        }
        SEAM(g0 + 7);
        if (PON(9) && IN(g0 + 8)) for (int rep = 0; rep < REPS[9]; ++rep) { PHASE_FRAME; run_gemm(F, WSP(const bf16_t, WS_MERGED), WSP(const bf16_t, W_OUT), TOK, 1024, 1024, F.G, F.bid, FStore{WSP(bf16_t, WS_YOUT), 1024}); }
        SEAM(g0 + 8);
        if (PON(10) && IN(g0 + 9)) {
            PHASE_FRAME; const float* gains = F.in(2) + (size_t)l * 6 * 1024;
            norm_rows(F, TOK, nullptr, F.x16(), WSP(const bf16_t, WS_YOUT), gains + 1024, F.x16(), nullptr, nullptr, gains + 2048, WSP(bf16_t, WS_H));
            norm_rows(F, NB * 256, F.in(1), nullptr, nullptr, nullptr, nullptr, nullptr, nullptr, F.in(3) + (size_t)l * 1024, WSP(bf16_t, WS_MEMN));
        }
        SEAM(g0 + 9);
        if (PON(11) && IN(g0 + 10)) for (int rep = 0; rep < REPS[11]; ++rep) {
            PHASE_FRAME;
            if (F.bid < 128) run_gemm(F, WSP(const bf16_t, WS_H), WSP(const bf16_t, W_XQ), TOK, 256, 1024, 128, F.bid, FStore{WSP(bf16_t, WS_QX), 256});
            else if (F.bid < 144) run_gemm(F, WSP(const bf16_t, WS_MEMN), WSP(const bf16_t, W_XKV), NB * 256, 512, 1024, 16, F.bid - 128, FXKV{WSP(bf16_t, WS_KX), WSP(bf16_t, WS_VXT)});
        }
        SEAM(g0 + 10);
        if (PON(12) && IN(g0 + 11)) for (int rep = 0; rep < REPS[12]; ++rep) { PHASE_FRAME; for (int it = F.bid; it < 512; it += F.G) xa_item(F, it); }
        SEAM(g0 + 11);
        if (PON(13) && IN(g0 + 12)) for (int rep = 0; rep < REPS[13]; ++rep) { PHASE_FRAME; run_gemm(F, WSP(const bf16_t, WS_XAO), WSP(const bf16_t, W_XO), TOK, 1024, 256, F.G, F.bid, FStore{WSP(bf16_t, WS_YOUT), 1024}); }
        SEAM(g0 + 12);
        if (PON(14) && IN(g0 + 13)) { PHASE_FRAME; const float* gains = F.in(2) + (size_t)l * 6 * 1024;
            norm_rows(F, TOK, nullptr, F.x16(), WSP(const bf16_t, WS_YOUT), gains + 3 * 1024, l + 1 < DEPTH ? F.x16() : WSP(bf16_t, WS_XLAST), nullptr, nullptr, gains + 4 * 1024, WSP(bf16_t, WS_H)); }
        SEAM(g0 + 13);
        if (PON(15) && IN(g0 + 14)) for (int rep = 0; rep < REPS[15]; ++rep) { PHASE_FRAME; run_gemm(F, WSP(const bf16_t, WS_H), WSP(const bf16_t, W_GU), TOK, 2 * DFF, 1024, F.G, F.bid, FSwiGLU{WSP(bf16_t, WS_A2), DFF}); }
        SEAM(g0 + 14);
        if (PON(16) && IN(g0 + 15)) for (int rep = 0; rep < REPS[16]; ++rep) { PHASE_FRAME; run_gemm(F, WSP(const bf16_t, WS_A2), WSP(const bf16_t, W_DN), TOK, 1024, DFF, F.G, F.bid, FStore{WSP(bf16_t, WS_YOUT), 1024}); }
        SEAM(g0 + 15);
        if (PON(17) && IN(g0 + 16)) {
            PHASE_FRAME; const float* gains = F.in(2) + (size_t)l * 6 * 1024;
            for (int rep = 1; rep < REPS[17]; ++rep) conv_layer(F, l);
            if (l + 1 < DEPTH) { norm_rows(F, TOK, nullptr, F.x16(), WSP(const bf16_t, WS_YOUT), gains + 5 * 1024, F.x16(), nullptr, nullptr, gains + 6 * 1024, WSP(bf16_t, WS_H)); conv_layer(F, l + 1); }
            else norm_rows(F, TOK, nullptr, WSP(const bf16_t, WS_XLAST), WSP(const bf16_t, WS_YOUT), gains + 5 * 1024, nullptr, F.out(), F.out() + (size_t)TOK * DM / 2, nullptr, nullptr);
        }
        SEAM(g0 + 16);
    }
#undef IN
#undef SEAM
}

extern "C" void kernel_launch(void* const* d_in, const int* in_sizes, int n_in, void* d_out, int out_size, void* d_ws, size_t ws_size, hipStream_t stream) {
    static int grid = 0;
    if (grid == 0) {
        if (n_in != 42 || out_size != TOK * DM || ws_size < WS_END) { fprintf(stderr, "kernel_launch: unexpected shapes (n_in %d out %d ws %zu)\n", n_in, out_size, ws_size); grid = -1; return; }
        int dev = 0, cus = 0, per_cu = 0;
        if (hipGetDevice(&dev) != hipSuccess || hipDeviceGetAttribute(&cus, hipDeviceAttributeMultiprocessorCount, dev) != hipSuccess) { grid = -1; return; }
        if (hipFuncSetAttribute((const void*)trunk_fwd, hipFuncAttributeMaxDynamicSharedMemorySize, LDS_BYTES) != hipSuccess) { fprintf(stderr, "kernel_launch: hipFuncSetAttribute failed\n"); grid = -1; return; }
        if (hipOccupancyMaxActiveBlocksPerMultiprocessor(&per_cu, (const void*)trunk_fwd, NTHR, LDS_BYTES) != hipSuccess || per_cu < 1) fprintf(stderr, "kernel_launch: occupancy query reports %d\n", per_cu);
        (void)hipGetLastError();
        grid = cus;
    }
    if (grid < 0) return;
    (void)hipMemsetAsync((char*)d_ws + WS_CTL, 0, CTL_BYTES, stream);
    Params p{};
    for (int i = 0; i < 42; ++i) p.in[i] = (const float*)d_in[i];
    p.out = (float*)d_out; p.ws = (unsigned char*)d_ws;
#if MK_N_LAUNCHES == 1
    p.ph_lo = 0; p.ph_hi = N_PHASES;
    hipLaunchKernelGGL(trunk_fwd, dim3(grid), dim3(NTHR), LDS_BYTES, stream, p);
#else
    for (int ph = 0; ph < N_PHASES; ++ph) { p.ph_lo = ph; p.ph_hi = ph + 1; hipLaunchKernelGGL(trunk_fwd, dim3(grid), dim3(NTHR), LDS_BYTES, stream, p); }
#endif
}
```

```cpp
#include <hip/hip_runtime.h>
#include <stdint.h>
#include <cstdio>

#ifndef MK_N_LAUNCHES
#define MK_N_LAUNCHES 1
#endif

#ifndef ONLY_PHASE
#define ONLY_PHASE -1
#endif
#define PON(k) (ONLY_PHASE < 0 || ONLY_PHASE == (k))
#define LAS __attribute__((address_space(3)))
typedef unsigned short bf16_t;
typedef short bf16x8 __attribute__((ext_vector_type(8)));
typedef short bf16x4 __attribute__((ext_vector_type(4)));
typedef float f32x4 __attribute__((ext_vector_type(4)));
typedef float f32x2 __attribute__((ext_vector_type(2)));
typedef unsigned u32x4 __attribute__((ext_vector_type(4)));
typedef unsigned u32x2 __attribute__((ext_vector_type(2)));
typedef unsigned long long u64;

constexpr int NB = 8, SEQ = 4096, DM = 1024, TOK = NB * SEQ, DEPTH = 4;
constexpr int INW = 5656, DFF = 2816;
constexpr int NTHR = 512;
constexpr int PH_PER_LAYER = 17, N_PHASES = 1 + DEPTH * PH_PER_LAYER;
constexpr int REPS[18] = {1, 1, 1, 1, 1, 1, 1, 1, 1, 1, 1, 1, 1, 1, 1, 1, 1, 1};
constexpr int REP_P4A = 1, REP_P4B = 1;
#define PROBE_EXP2X 0
#define PROBE_MFMA2X 0
constexpr int REP_NSA = 1, REP_S5P2 = 1, REP_PREP = 1, REP_S5P1 = 1, REP_CMPG = 1;

constexpr size_t MiB = 1ull << 20;
constexpr size_t WS_CTL = 0;
constexpr size_t CTL_BYTES = 32768;
constexpr size_t WS_ROPE = 1 * MiB;
constexpr size_t WS_MISC = 2 * MiB;
constexpr size_t WS_KCC = WS_MISC;
constexpr size_t WS_VCCT = WS_MISC + 512 * 1024;
constexpr size_t WS_XEND = WS_MISC + 1 * MiB;
constexpr size_t WS_KX = WS_MISC + 2 * MiB;
constexpr size_t WS_VXT = WS_MISC + 3 * MiB;
constexpr size_t WS_MEMN = WS_MISC + 4 * MiB;
constexpr size_t WS_BONUS = WS_MISC + 8 * MiB;
constexpr size_t WS_CBIAS = WS_MISC + 9 * MiB;
constexpr size_t WS_W = 18 * MiB;
constexpr size_t W_IN1 = WS_W + 0, W_MG = WS_W + 6 * MiB, W_UPN = WS_W + 12 * MiB, W_UPR = WS_W + 13 * MiB, W_UPS = WS_W + 13 * MiB + 512 * 1024,
                 W_OUT = WS_W + 14 * MiB, W_C1K = WS_W + 16 * MiB, W_C1V = WS_W + 17 * MiB, W_XQ = WS_W + 18 * MiB, W_XKV = WS_W + 19 * MiB,
                 W_XO = WS_W + 20 * MiB, W_GLU = WS_W + 21 * MiB, W_LORA = WS_W + 21 * MiB + 512 * 1024, W_GU = WS_W + 22 * MiB, W_DN = WS_W + 33 * MiB;
constexpr size_t WS_H = 58 * MiB;
constexpr size_t WS_Q = 122 * MiB, WS_KC = 154 * MiB, WS_VC = 162 * MiB, WS_KS = 170 * MiB, WS_KW = 178 * MiB, WS_YS5 = 186 * MiB,
                 WS_VST = 202 * MiB, WS_VWT = 210 * MiB, WS_NG = 218 * MiB, WS_ZR = 220 * MiB, WS_ZS = 284 * MiB,
                 WS_YSCAN = 300 * MiB, WS_YS5G = 332 * MiB, WS_LIN = 364 * MiB, WS_RG = 380 * MiB, WS_LW = 396 * MiB, WS_LA = 412 * MiB,
                 WS_PQ = 428 * MiB, WS_END = 508 * MiB;
constexpr size_t WS_CS_AR = 476 * MiB, WS_CS_BKT = 348 * MiB, WS_CS_VMT = 154 * MiB, WS_CS_AAK = 186 * MiB, WS_CS_ARBK = 190 * MiB, WS_CS_GAM = 198 * MiB, WS_CS_MM = 428 * MiB;
constexpr size_t WS_XLAST = 300 * MiB;
constexpr size_t WS_YCAT = 220 * MiB;
constexpr size_t WS_G = 284 * MiB  , WS_MERGED = 122 * MiB, WS_YOUT = 364 * MiB;
constexpr size_t WS_QX = 122 * MiB, WS_XAO = 138 * MiB, WS_A2 = 122 * MiB;
constexpr int CTL_Q0 = 4096;

constexpr int LDS_STAGE = 131072;
constexpr int LDS_CTL_OFF = LDS_STAGE;
constexpr int LDS_BYTES = LDS_STAGE + 256;

struct Params { const float* in[42]; float* out; unsigned char* ws; int ph_lo, ph_hi; };

__device__ __forceinline__ float bf2f(bf16_t b) { return __uint_as_float(((unsigned)b) << 16); }
__device__ __forceinline__ float bflo(unsigned w) { return __uint_as_float(w << 16); }
__device__ __forceinline__ float bfhi(unsigned w) { return __uint_as_float(w & 0xffff0000u); }
__device__ __forceinline__ bf16_t f2bf(float f) { unsigned u = __float_as_uint(f); u += 0x7FFFu + ((u >> 16) & 1u); return (bf16_t)(u >> 16); }
__device__ __forceinline__ unsigned pk2(float lo, float hi) { return (unsigned)f2bf(lo) | ((unsigned)f2bf(hi) << 16); }
__device__ __forceinline__ float sigmoidf_(float x) { return __builtin_amdgcn_rcpf(1.0f + __expf(-x)); }
__device__ __forceinline__ float gelu_tanh(float x) { const float u = 0.7978845608028654f * (x + 0.044715f * x * x * x); return 0.5f * x * (1.0f + tanhf(u)); }
template <int CTRL> __device__ __forceinline__ float dpp_mov(float x) { return __int_as_float(__builtin_amdgcn_update_dpp(0, __float_as_int(x), CTRL, 0xF, 0xF, false)); }
__device__ __forceinline__ float quad_sum(float x) { x += dpp_mov<0xB1>(x); x += dpp_mov<0x4E>(x); return x; }
__device__ __forceinline__ float row16_sum(float x) { x = quad_sum(x); x += dpp_mov<0x141>(x); x += dpp_mov<0x140>(x); return x; }

__device__ __forceinline__ float xmax16(float x) { const unsigned u = __float_as_uint(x); auto r = __builtin_amdgcn_permlane16_swap(u, u, false, false); return fmaxf(__uint_as_float(r[0]), __uint_as_float(r[1])); }
__device__ __forceinline__ float xmax32(float x) { const unsigned u = __float_as_uint(x); auto r = __builtin_amdgcn_permlane32_swap(u, u, false, false); return fmaxf(__uint_as_float(r[0]), __uint_as_float(r[1])); }
__device__ __forceinline__ float xsum16(float x) { const unsigned u = __float_as_uint(x); auto r = __builtin_amdgcn_permlane16_swap(u, u, false, false); return __uint_as_float(r[0]) + __uint_as_float(r[1]); }
__device__ __forceinline__ float xsum32(float x) { const unsigned u = __float_as_uint(x); auto r = __builtin_amdgcn_permlane32_swap(u, u, false, false); return __uint_as_float(r[0]) + __uint_as_float(r[1]); }

__device__ __forceinline__ float wave_sum(float v) { v = row16_sum(v); v = xsum16(v); return xsum32(v); }

#define XB_TMO      128
#define XB_XCNT(j)  (256  + 64 * (j))
#define XB_XSUB(j)  (1280 + 64 * (j))
#define XB_XGEN(j)  (2304 + 64 * (j))
#define XB_TOP      3328
#define XB_TOPGEN   3392
#define XCD_BAR_WORDS 3456
#define XB_SPIN_CAP (1u << 18)
__device__ __forceinline__ unsigned xb_ld(unsigned* p)              { return __hip_atomic_load(p, __ATOMIC_RELAXED, __HIP_MEMORY_SCOPE_AGENT); }
__device__ __forceinline__ unsigned xb_add(unsigned* p, unsigned v) { return __hip_atomic_fetch_add(p, v, __ATOMIC_RELAXED, __HIP_MEMORY_SCOPE_AGENT); }
__device__ __forceinline__ unsigned xb_xcc_id() { return (unsigned)__builtin_amdgcn_s_getreg((3 << 11) | 20) & 0xFu; }
#define XB_SPIN(cond, bar) do { unsigned _sp = 0; while (cond) { __builtin_amdgcn_s_sleep(1); \
    if ((++_sp & 255u) == 0u) { if (xb_ld(&(bar)[XB_TMO])) break; if (_sp > XB_SPIN_CAP) { atomicAdd(&(bar)[XB_TMO], 1u); break; } } } } while (0)
struct XcdBarrier { unsigned* bar; unsigned x; volatile LAS unsigned* st; };
__device__ __forceinline__ XcdBarrier xcd_barrier_post(unsigned* bar, volatile LAS unsigned* st) {
    XcdBarrier b; b.bar = bar; b.x = xb_xcc_id(); b.st = st;
    if (threadIdx.x == 0) (void)xb_add(&bar[XB_XCNT(b.x)], 1u);
    return b;
}
__device__ __forceinline__ void xcd_barrier_complete(unsigned* bar, unsigned x, unsigned& nloc, unsigned& nx) {
    const unsigned G = gridDim.x * gridDim.y * gridDim.z;
    unsigned sum, cnt, mine, sp = 0u;
    for (;;) {
        sum = 0u; cnt = 0u; mine = 0u;
#pragma unroll
        for (unsigned j = 0; j < 16; ++j) { const unsigned c = xb_ld(&bar[XB_XCNT(j)]); sum += c; cnt += (c > 0u) ? 1u : 0u; mine = (j == x) ? c : mine; }
        if (sum == G) break;
        __builtin_amdgcn_s_sleep(1);
        if ((++sp & 255u) == 0u) { if (xb_ld(&bar[XB_TMO])) break; if (sp > XB_SPIN_CAP) { atomicAdd(&bar[XB_TMO], 1u); break; } }
    }
    nloc = mine > 0u ? mine : 1u; nx = cnt > 0u ? cnt : 1u;
}
__device__ __forceinline__ void xcd_barrier(const XcdBarrier& b) {
    asm volatile("s_waitcnt vmcnt(0)" ::: "memory");
    __syncthreads();
    if (threadIdx.x == 0) {
        unsigned* bar = b.bar;
        __builtin_amdgcn_s_waitcnt(0);
        unsigned nloc = b.st[0], nx = b.st[1];
        if (nloc == 0u) { xcd_barrier_complete(bar, b.x, nloc, nx); b.st[0] = nloc; b.st[1] = nx; }
        const unsigned old = xb_add(&bar[XB_XSUB(b.x)], 1u);
        const unsigned gen = old / nloc;
        if (old + 1u == (gen + 1u) * nloc) {
            __builtin_amdgcn_fence(__ATOMIC_RELEASE, "agent");
            asm volatile("s_waitcnt vmcnt(0)" ::: "memory");
            const unsigned og = xb_add(&bar[XB_TOP], 1u);
            const unsigned tg = og / nx;
            if (og + 1u == (tg + 1u) * nx) xb_add(&bar[XB_TOPGEN], 1u);
            else XB_SPIN(xb_ld(&bar[XB_TOPGEN]) == tg, bar);
            __builtin_amdgcn_fence(__ATOMIC_ACQUIRE, "agent");
            xb_add(&bar[XB_XGEN(b.x)], 1u);
            asm volatile("s_waitcnt vmcnt(0)" ::: "memory");
        } else {
            XB_SPIN(xb_ld(&bar[XB_XGEN(b.x)]) == gen, bar);
            __builtin_amdgcn_fence(__ATOMIC_ACQUIRE, "agent");
            asm volatile("s_waitcnt vmcnt(0)" ::: "memory");
        }
    }
    __syncthreads();
}

namespace pg8 {
#define PG8_LAS __attribute__((address_space(3)))
constexpr int BM = 256, BK = 64, HALF = 128, HTB = HALF * BK * 2, STAGE_BYTES = 8 * HTB, NXCD = 8, WGM = 8;
__host__ __device__ __forceinline__ int lds_byte(int r, int c) { const int st = (r >> 4) * 2 + (c >> 5), rr = r & 15, cc = c & 31, ob = rr * 64 + cc * 2; return st * 1024 + (ob ^ (((ob >> 9) & 1) << 5)); }
__host__ __device__ __forceinline__ void stage_rc(int b, int& R, int& C) { const int st = b / 1024, sb = b % 1024, swz = sb ^ (((sb >> 9) & 1) << 5); R = (st >> 1) * 16 + swz / 64; C = (st & 1) * 32 + (swz % 64) / 2; }
__host__ __device__ __forceinline__ int perm32(int rho) { const int n = rho >> 4, i = rho & 15; return 8 * (i >> 2) + 4 * n + (i & 3); }
struct Unit { int pm, pn; };
struct Gemm { const bf16_t* A; const bf16_t* Bt; int M, N, K; };
struct StaticOrder {
    int nM, nN, nwg, G, c;
    __host__ __device__ void init(int M, int N, int G_, int c_) { nM = M / BM; nN = N / BM; nwg = nM * nN; G = G_; c = c_; }
    __host__ __device__ bool next(int i, Unit& u) const {
        const long L = (long)i * G + c; if (L >= nwg) return false;
        int wgid = (int)L; { const int q = nwg / NXCD, r = nwg % NXCD, xcd = wgid % NXCD, off = wgid / NXCD; wgid = (xcd < r ? xcd * (q + 1) : r * (q + 1) + (xcd - r) * q) + off; }
        const int nig = WGM * nN, gid = wgid / nig, fm = gid * WGM, gsz = (nM - fm) < WGM ? (nM - fm) : WGM;
        u.pm = fm + ((wgid % nig) % gsz); u.pn = (wgid % nig) / gsz; return true;
    }
    __device__ __forceinline__ void a_ready(const Unit&) const {}
    __device__ __forceinline__ void done(const Unit&) const {}
};
typedef __bf16 bf16v2_t __attribute__((ext_vector_type(2)));
typedef float f32x2_t __attribute__((ext_vector_type(2)));
typedef __bf16 bf16v4_t __attribute__((ext_vector_type(4)));
typedef __bf16 bf16v8_t __attribute__((ext_vector_type(8)));
typedef float f32x8_t __attribute__((ext_vector_type(8)));
typedef unsigned u32x2_t __attribute__((ext_vector_type(2)));
__device__ __forceinline__ unsigned cvt_pk_bf16(float lo, float hi) { const f32x2_t f = {lo, hi}; return __builtin_bit_cast(unsigned, __builtin_convertvector(f, bf16v2_t)); }
__device__ __forceinline__ u32x2_t cvt4_bf16(const f32x4 a) { return __builtin_bit_cast(u32x2_t, __builtin_convertvector(a, bf16v4_t)); }
__device__ __forceinline__ bf16x8 cvt8_bf16(const f32x4 a, const f32x4 b) { const f32x8_t f = __builtin_shufflevector(a, b, 0, 1, 2, 3, 4, 5, 6, 7); return __builtin_bit_cast(bf16x8, __builtin_convertvector(f, bf16v8_t)); }

struct NoHook { static constexpr bool ACTIVE = false; __device__ __forceinline__ void operator()(f32x4 (&)[2][2][4][2], const Unit&, int, int, int, int, int) const {} };
template <class Epi, class Sched, class Hook = NoHook>
__device__ __forceinline__ void gemm_phase(PG8_LAS unsigned char* lds, const Gemm g, const Sched& S, const Epi& E, const int tid, const Hook& H = Hook()) {
    const int wid = __builtin_amdgcn_readfirstlane(tid >> 6), lane = tid & 63, wr = wid >> 2, wc = wid & 3, fr = lane & 15, fq = lane >> 4;
    const int K = g.K, nt = K / BK;
    unsigned voffA[2], voffB[2];
#pragma unroll
    for (int i = 0; i < 2; ++i) { int R, C; stage_rc(tid * 16 + i * 8192, R, C); const int Rb = Epi::PERM ? ((R & ~31) + perm32(R & 31)) : R;
        voffA[i] = (unsigned)(R * K + C) * 2u; voffB[i] = (unsigned)(Rb * K + C) * 2u; }
    const size_t kstep = (size_t)(BK * 2);
    const size_t hstep = (size_t)HALF * K * 2;
    const size_t tstep = 2 * hstep;
    const unsigned ldsw = (unsigned)wid * 1024u;
    const int aoff = lds_byte(wr * 64 + fr, fq * 8), boff = lds_byte(wc * 32 + fr, fq * 8);
#define PG8_SA(b, h) (((b) * 2 + (h)) * HTB)
#define PG8_SB(b, h) ((4 + (b) * 2 + (h)) * HTB)
#define PG8_STAGE(bufoff, gbase, voff) do { _Pragma("unroll") for (int _i = 0; _i < 2; ++_i) \
        __builtin_amdgcn_global_load_lds((const unsigned*)((const char*)(gbase) + (voff)[_i]), (PG8_LAS unsigned*)(lds + (bufoff) + ldsw + _i * 8192), 16, 0, 0); } while (0)
#define PG8_LDA(dst, b, h) do { _Pragma("unroll") for (int m = 0; m < 4; ++m) _Pragma("unroll") for (int k = 0; k < 2; ++k) dst[m][k] = *(const PG8_LAS bf16x8*)(lds + PG8_SA(b, h) + aoff + m * 2048 + k * 1024); } while (0)
#define PG8_LDB(dst, b, h) do { _Pragma("unroll") for (int n = 0; n < 2; ++n) _Pragma("unroll") for (int k = 0; k < 2; ++k) dst[n][k] = *(const PG8_LAS bf16x8*)(lds + PG8_SB(b, h) + boff + n * 2048 + k * 1024); } while (0)
#define PG8_MMA(ai, bj, At, Bt) do { __builtin_amdgcn_s_setprio(1); _Pragma("unroll") for (int m = 0; m < 4; ++m) _Pragma("unroll") for (int n = 0; n < 2; ++n) _Pragma("unroll") for (int k = 0; k < 2; ++k) \
        acc[ai][bj][m][n] = __builtin_amdgcn_mfma_f32_16x16x32_bf16(Bt[n][k], At[m][k], acc[ai][bj][m][n], 0, 0, 0); __builtin_amdgcn_s_setprio(0); } while (0)
#define PG8_WAIT_V(n) asm volatile("s_waitcnt vmcnt(" #n ")" ::: "memory")
#define PG8_WAIT_L(n) asm volatile("s_waitcnt lgkmcnt(" #n ")" ::: "memory")
#define PG8_BAR __builtin_amdgcn_s_barrier()
#define PG8_SCHED __builtin_amdgcn_sched_barrier(0)
    Unit cur, nxt; int ui = 0;
    if (!S.next(0, cur)) return;
    f32x4 acc[2][2][4][2];
#pragma unroll
    for (int a = 0; a < 2; ++a)
#pragma unroll
        for (int b = 0; b < 2; ++b)
#pragma unroll
            for (int m = 0; m < 4; ++m)
#pragma unroll
                for (int n = 0; n < 2; ++n) acc[a][b][m][n] = (f32x4){0.f, 0.f, 0.f, 0.f};
    bf16x8 At[4][2], B0[2][2], B1[2][2];
    const char* cA = (const char*)g.A + (size_t)cur.pm * tstep; const char* cB = (const char*)g.Bt + (size_t)cur.pn * tstep;
    S.a_ready(cur);
    PG8_STAGE(PG8_SB(0, 0), cB, voffB); PG8_STAGE(PG8_SA(0, 0), cA, voffA); PG8_STAGE(PG8_SB(0, 1), cB + hstep, voffB); PG8_STAGE(PG8_SA(0, 1), cA + hstep, voffA);
    if (wr == 1) PG8_BAR;
    PG8_WAIT_V(4); PG8_BAR;
    PG8_STAGE(PG8_SB(1, 0), cB + kstep, voffB); PG8_STAGE(PG8_SA(1, 0), cA + kstep, voffA); PG8_STAGE(PG8_SB(1, 1), cB + hstep + kstep, voffB);
    PG8_WAIT_V(6); PG8_BAR;
    for (;;) {
        const bool has_next = S.next(ui + 1, nxt);
        const char* nA = has_next ? (const char*)g.A + (size_t)nxt.pm * tstep : cA; const char* nB = has_next ? (const char*)g.Bt + (size_t)nxt.pn * tstep : cB;
#pragma nounroll
        for (int t = 0; t < nt; t += 2) {
            const bool last = (t == nt - 2);
            const char* a1 = cA + (size_t)(t + 1) * kstep;
            const char* a2 = last ? nA : cA + (size_t)(t + 2) * kstep; const char* b2 = last ? nB : cB + (size_t)(t + 2) * kstep;
            const char* a3 = a2 + kstep; const char* b3 = b2 + kstep;
            if (last && has_next) S.a_ready(nxt);
            if (Hook::ACTIVE) { if (t == 8 || t == 12) H(acc, cur, t, wr, wc, fr, fq); }
            PG8_LDB(B0, 0, 0); PG8_SCHED; PG8_LDA(At, 0, 0); PG8_STAGE(PG8_SA(1, 1), a1 + hstep, voffA);
            PG8_WAIT_L(8); PG8_BAR; PG8_WAIT_L(0); PG8_MMA(0, 0, At, B0); PG8_BAR; PG8_SCHED;
            PG8_LDB(B1, 0, 1); PG8_STAGE(PG8_SB(0, 0), b2, voffB);
            PG8_BAR; PG8_WAIT_L(0); PG8_MMA(0, 1, At, B1); PG8_BAR;
            PG8_LDA(At, 0, 1); PG8_STAGE(PG8_SA(0, 0), a2, voffA);
            PG8_BAR; PG8_WAIT_L(0); PG8_MMA(1, 0, At, B0); PG8_BAR; PG8_SCHED;
            PG8_STAGE(PG8_SB(0, 1), b2 + hstep, voffB);
            PG8_WAIT_V(6); PG8_BAR; PG8_MMA(1, 1, At, B1); PG8_BAR;
            PG8_LDB(B0, 1, 0); PG8_SCHED; PG8_LDA(At, 1, 0); PG8_STAGE(PG8_SA(0, 1), a2 + hstep, voffA);
            PG8_WAIT_L(8); PG8_BAR; PG8_WAIT_L(0); PG8_MMA(0, 0, At, B0); PG8_BAR; PG8_SCHED;
            PG8_LDB(B1, 1, 1); PG8_STAGE(PG8_SB(1, 0), b3, voffB);
            PG8_BAR; PG8_WAIT_L(0); PG8_MMA(0, 1, At, B1); PG8_BAR;
            PG8_LDA(At, 1, 1); PG8_STAGE(PG8_SA(1, 0), a3, voffA);
            PG8_BAR; PG8_WAIT_L(0); PG8_MMA(1, 0, At, B0); PG8_BAR; PG8_SCHED;
            PG8_STAGE(PG8_SB(1, 1), b3 + hstep, voffB);
            PG8_WAIT_V(6); PG8_BAR; PG8_MMA(1, 1, At, B1); PG8_BAR;
        }
        E(acc, cur, wr, wc, fr, fq); S.done(cur);
        if (!has_next) break;
#pragma unroll
        for (int a = 0; a < 2; ++a)
#pragma unroll
            for (int b = 0; b < 2; ++b)
#pragma unroll
                for (int m = 0; m < 4; ++m)
#pragma unroll
                    for (int n = 0; n < 2; ++n) acc[a][b][m][n] = (f32x4){0.f, 0.f, 0.f, 0.f};
        cur = nxt; cA = nA; cB = nB; ++ui;
    }
    PG8_WAIT_V(0);
    if (wr == 0) PG8_BAR;
    PG8_BAR;
#undef PG8_SA
#undef PG8_SB
#undef PG8_STAGE
#undef PG8_LDA
#undef PG8_LDB
#undef PG8_MMA
#undef PG8_WAIT_V
#undef PG8_WAIT_L
#undef PG8_BAR
#undef PG8_SCHED
}
}

__device__ __forceinline__ int vperm(int t) { const int kq = (t >> 2) & 7, e = t & 3; return (t & ~31) | ((kq < 4 ? 2 * kq : 2 * (kq - 4) + 1) << 2) | e; }
template <class F> struct Epi8 {
    static constexpr bool PERM = true, AFTER_DRAIN = false;
    F f;
    __device__ __forceinline__ void operator()(const f32x4 (&acc)[2][2][4][2], const pg8::Unit& u, int wr, int wc, int fr, int fq) const {
        const int row0 = u.pm * 256 + wr * 64 + fr, col0 = u.pn * 256 + wc * 32 + 8 * fq;
#pragma unroll
        for (int ai = 0; ai < 2; ++ai)
#pragma unroll
            for (int m = 0; m < 4; ++m)
            {
#pragma unroll
                for (int bj = 0; bj < 2; ++bj) f(row0 + ai * 128 + m * 16, col0 + bj * 128, acc[ai][bj][m][0], acc[ai][bj][m][1], u.pn);
                asm volatile("" ::: "memory"); }
    }
};
__device__ __forceinline__ u32x4 pack8(const f32x4 a, const f32x4 b) {
    return __builtin_bit_cast(u32x4, pg8::cvt8_bf16(a, b));
}
struct FStore { bf16_t* O; int ld;
    __device__ __forceinline__ void operator()(int row, int col, f32x4 a, f32x4 b, int) const { *(u32x4*)(O + (unsigned)(row * ld + col)) = pack8(a, b); } };
__device__ __forceinline__ unsigned gate_off(int row, int col) { return (unsigned)((((row >> 4) * 96 + (col >> 5)) << 9) + ((row & 15) << 5) + (col & 31)); }
struct MergeHook { static constexpr bool ACTIVE = true; const bf16_t* G;
    __device__ __forceinline__ void operator()(f32x4 (&acc)[2][2][4][2], const pg8::Unit& u, int t, int wr, int wc, int fr, int fq) const {
        const int cn = t == 8 ? 0 : 1024;
        const int row0 = u.pm * 256 + wr * 64 + fr, col0 = u.pn * 256 + wc * 32 + 8 * fq;
#pragma unroll
        for (int ai = 0; ai < 2; ++ai)
#pragma unroll
            for (int mh = 0; mh < 2; ++mh) {
                u32x4 gn[2][2], gd[2][2];
#pragma unroll
                for (int mm = 0; mm < 2; ++mm)
#pragma unroll
                    for (int bj = 0; bj < 2; ++bj) { const int r_ = row0 + ai * 128 + (2 * mh + mm) * 16, c_ = cn + col0 + bj * 128;
                        gn[mm][bj] = *(const u32x4*)(G + gate_off(r_, c_)); gd[mm][bj] = *(const u32x4*)(G + gate_off(r_, c_ + 1024)); }
#pragma unroll
                for (int mm = 0; mm < 2; ++mm)
#pragma unroll
                    for (int bj = 0; bj < 2; ++bj) { const int m = 2 * mh + mm;
                        const unsigned nw[4] = {gn[mm][bj].x, gn[mm][bj].y, gn[mm][bj].z, gn[mm][bj].w}, dw[4] = {gd[mm][bj].x, gd[mm][bj].y, gd[mm][bj].z, gd[mm][bj].w};
#pragma unroll
                        for (int j = 0; j < 8; ++j) { const float gnj = (j & 1) ? bfhi(nw[j >> 1]) : bflo(nw[j >> 1]), gdj = (j & 1) ? bfhi(dw[j >> 1]) : bflo(dw[j >> 1]);
                            acc[ai][bj][m][j >> 2][j & 3] *= gnj * __builtin_amdgcn_rcpf(fmaxf(gdj, 1e-12f)); } }
                asm volatile("" ::: "memory"); __builtin_amdgcn_sched_barrier(0);
            }
    } };
struct FMulStore { const bf16_t* G; bf16_t* O;
    __device__ __forceinline__ void operator()(int row, int col, f32x4 a, f32x4 b, int) const {
        const u32x4 g = *(const u32x4*)(G + gate_off(row, 2048 + col));
        const f32x4 g0 = {bflo(g.x), bfhi(g.x), bflo(g.y), bfhi(g.y)}, g1 = {bflo(g.z), bfhi(g.z), bflo(g.w), bfhi(g.w)};
        *(u32x4*)(O + (unsigned)(row * 1024 + col)) = pack8(g0 * a, g1 * b); } };
struct FSigmoid { bf16_t* O; int ld;
    __device__ __forceinline__ void operator()(int row, int col, f32x4 a, f32x4 b, int) const {
#pragma unroll
        for (int j = 0; j < 4; ++j) { a[j] = sigmoidf_(a[j]); b[j] = sigmoidf_(b[j]); }
        *(u32x4*)(O + gate_off(row, col)) = pack8(a, b); } };
struct FGluMul { const bf16_t* Y; bf16_t* O; int ld, ldo;
    __device__ __forceinline__ void operator()(int row, int col, f32x4 a, f32x4 b, int) const {
        const unsigned o = (unsigned)(row * ld + col), oo = (unsigned)(row * ldo + col); const u32x4 y = *(const u32x4*)(Y + o);
        const f32x4 y0 = {bflo(y.x), bfhi(y.x), bflo(y.y), bfhi(y.y)}, y1 = {bflo(y.z), bfhi(y.z), bflo(y.w), bfhi(y.w)};
#pragma unroll
        for (int j = 0; j < 4; ++j) { a[j] = y0[j] * sigmoidf_(a[j]); b[j] = y1[j] * sigmoidf_(b[j]); }
        *(u32x4*)(O + oo) = pack8(a, b); } };
struct FSwiGLU { bf16_t* O; int ld;
    __device__ __forceinline__ void operator()(int row, int col, f32x4 a, f32x4 b, int) const {
        const float o0 = a[0] * sigmoidf_(a[0]) * a[1], o1 = a[2] * sigmoidf_(a[2]) * a[3], o2 = b[0] * sigmoidf_(b[0]) * b[1], o3 = b[2] * sigmoidf_(b[2]) * b[3];
        *(u32x2*)(O + (unsigned)(row * ld + (col >> 1))) = pg8::cvt4_bf16((f32x4){o0, o1, o2, o3}); } };
struct FLora { bf16_t *LW, *LA, *RG;
    __device__ __forceinline__ void operator()(int row, int col, f32x4 a, f32x4 b, int pn) const {
        bf16_t* O = pn == 0 ? LW : (pn == 1 ? LA : RG); *(u32x4*)(O + (unsigned)(row * 256 + (col & 255))) = pack8(a, b); } };
struct FXKV { bf16_t* Kx; bf16_t* Vxt;
    __device__ __forceinline__ void operator()(int row, int col, f32x4 a, f32x4 b, int) const {
        const int bb = row >> 8, m = row & 255;
        if (col < 256) { const int h = col >> 6, d = col & 63; *(u32x4*)(Kx + (unsigned)(((bb * 4 + h) * 256 + m) * 64 + d)) = pack8(a, b); }
        else { const int c = col - 256, h = c >> 6, d = c & 63; bf16_t* p = Vxt + (unsigned)(((bb * 4 + h) * 64 + d) * 256 + vperm(m));
#pragma unroll
            for (int j = 0; j < 4; ++j) { p[j * 256] = f2bf(a[j]); p[(j + 4) * 256] = f2bf(b[j]); } } } };
struct FIn1 { bf16_t *Q, *KC, *VC, *KS, *KW, *VSt, *VWt, *ZR, *ZS, *NG; const float* ropec; const float* ropes;
    __device__ __forceinline__ void operator()(int row, int col, f32x4 a, f32x4 b, int pn) const {
        if (pn < 2) { *(u32x4*)(Q + (unsigned)(row * 512 + col)) = pack8(a, b); }
        else if (pn < 5) {
            const int c = col - 512, which = c >> 7, g = (c >> 6) & 1, j0 = c & 63, bb = row >> 12, t = row & 4095;
            const unsigned base = (unsigned)(((bb * 2 + g) * 4096 + t) * 64);
            if (which == 0) *(u32x4*)(KC + base + j0) = pack8(a, b);
            else if (which == 1) *(u32x4*)(VC + base + j0) = pack8(a, b);
            else if (which == 2 || which == 4) {
                const int i0 = j0 >> 1; const f32x4 cs = *(const f32x4*)(ropec + t * 32 + i0), sn = *(const f32x4*)(ropes + t * 32 + i0);
                const float x1[4] = {a[0], a[2], b[0], b[2]}, x2[4] = {a[1], a[3], b[1], b[3]}; float r1[4], r2[4];
#pragma unroll
                for (int j = 0; j < 4; ++j) { r1[j] = x1[j] * cs[j] - x2[j] * sn[j]; r2[j] = x1[j] * sn[j] + x2[j] * cs[j]; }
                bf16_t* K = (which == 2 ? KS : KW) + base;
                const u32x2 w1 = pg8::cvt4_bf16((f32x4){r1[0], r1[1], r1[2], r1[3]}), w2 = pg8::cvt4_bf16((f32x4){r2[0], r2[1], r2[2], r2[3]});
                *(u32x2*)(K + i0) = w1; *(u32x2*)(K + 32 + i0) = w2;
            } else {
                bf16_t* p = (which == 3 ? VSt : VWt) + (unsigned)(((bb * 2 + g) * 64 + j0) * 4096 + vperm(t));
#pragma unroll
                for (int j = 0; j < 4; ++j) { p[j * 4096] = f2bf(a[j]); p[(j + 4) * 4096] = f2bf(b[j]); }
            }
        }
        else if (pn < 9) { *(u32x4*)(ZR + (unsigned)(row * 1024 + (col - 1280))) = pack8(a, b); }
        else if (pn == 9) { *(u32x4*)(ZS + (unsigned)(row * 256 + (col - 2304))) = pack8(a, b); }
        else { const int c = col - 2560; if (c < 32) *(u32x4*)(NG + (unsigned)(row * 32 + c)) = pack8(a, b); }
    } };

typedef const float* const __attribute__((address_space(4)))* KArgPtrs;
struct Frame {
    const __attribute__((address_space(4))) char* kp; unsigned char* ws; LAS unsigned char* lds;
    int tid, lane, wave, bid, G;
    __device__ __forceinline__ const float* in(int i) const { return (const float*)(const __attribute__((address_space(1))) float*)(((KArgPtrs)kp)[i]); }
    __device__ __forceinline__ float* out() const { return (float*)(__attribute__((address_space(1))) float*)(((KArgPtrs)kp)[42]); }
    __device__ __forceinline__ bf16_t* x16() const { return (bf16_t*)(out() + (size_t)TOK * DM / 2); }
    __device__ __forceinline__ unsigned* ctl() const { return (unsigned*)(ws + WS_CTL); }
};
#define LAUNDER(F) do { __attribute__((address_space(1))) unsigned char* _g = (__attribute__((address_space(1))) unsigned char*)(F).ws; asm volatile("" : "+s"(_g), "+s"((F).kp)); (F).ws = (unsigned char*)_g; } while (0)
#define WSP(T, off) ((T*)(F.ws + (off)))

__device__ __forceinline__ int next_job(const Frame& F, unsigned* counter) {
    volatile LAS int* slot = (volatile LAS int*)(F.lds + LDS_CTL_OFF + 16);
    __syncthreads();
    if (F.tid == 0) *slot = (int)__hip_atomic_fetch_add(counter, 1u, __ATOMIC_RELAXED, __HIP_MEMORY_SCOPE_AGENT);
    __syncthreads();
    return *slot;
}

struct ConvDesc { int N, K; size_t dst; };
__device__ __forceinline__ const float* conv_col(const Frame& F, int l, int kind, int n, int& ld, int& klo, int& khi) {
    klo = 0; khi = 1 << 30;
    switch (kind) {
    case 0: {
        int c; ld = INW;
        if (n < 512) c = n;
        else if (n < 1280) { const int cc = n - 512, which = cc >> 7, g = (cc >> 6) & 1, j = cc & 63; const int dim = (which == 2 || which == 4) ? ((j & 1) ? (j >> 1) + 32 : (j >> 1)) : j; c = 512 + which * 128 + g * 64 + dim; }
        else if (n < 2304) c = 1304 + (n - 1280);
        else if (n < 2560) c = 2328 + (n - 2304);
        else if (n < 2584) c = 1280 + (n - 2560);
        else return nullptr;
        return F.in(4) + (size_t)l * DM * INW + c; }
    case 1: ld = INW; return F.in(4) + (size_t)l * DM * INW + 2584 + n;
    case 2: ld = 1024; return F.in(31) + (size_t)l * 512 * 1024 + n;
    case 3: return nullptr;
    case 4: return nullptr;
    case 5: ld = 1024; return F.in(34) + (size_t)l * 1024 * 1024 + n;
    case 6: ld = 256; return F.in(7) + ((size_t)l * 2048 + (n < 256 ? 0 : 1024)) * 256 + (n & 255);
    case 7: ld = 256; return F.in(9) + ((size_t)l * 2048 + (n < 256 ? 0 : 1024)) * 256 + (n & 255);
    case 8: ld = 256; return F.in(35) + (size_t)l * 1024 * 256 + n;
    case 9: ld = 256; return (n < 256 ? F.in(36) : F.in(37)) + (size_t)l * 1024 * 256 + (n & 255);
    case 10: ld = 1024; return F.in(38) + (size_t)l * 256 * 1024 + n;
    case 11: ld = 256; return F.in(30) + (size_t)l * 256 * 256 + n;
    case 12: ld = DFF; return ((n & 1) ? F.in(40) : F.in(39)) + (size_t)l * 1024 * DFF + (n >> 1);
    case 13: ld = 1024; return F.in(41) + (size_t)l * DFF * 1024 + n;
    default: {
        ld = 256;
        if (n < 256) { klo = 0; khi = 64; return F.in(13) + (size_t)l * 64 * 256 + n; }
        if (n < 512) { klo = 64; khi = 128; return F.in(15) + (size_t)l * 64 * 256 + (n - 256); }
        klo = 128; khi = 256; return F.in(16) + (size_t)l * 128 * 256 + (n - 512); }
    }
}
__device__ __forceinline__ void conv_layer(const Frame& F, int l) {
    const ConvDesc D[15] = {{2816, 1024, W_IN1}, {3072, 1024, W_MG}, {1024, 1024, W_UPN}, {64, 64, WS_W + 39 * MiB}, {64, 64, WS_W + 39 * MiB + 65536}, {1024, 1024, W_OUT}, {512, 1024, W_C1K}, {512, 1024, W_C1V},
                            {256, 1024, W_XQ}, {512, 1024, W_XKV}, {1024, 256, W_XO}, {256, 256, W_GLU}, {5632, 1024, W_GU}, {1024, 2816, W_DN}, {768, 256, W_LORA}};
    LAS float* tile = (LAS float*)F.lds;
    int total = 0;
#pragma unroll
    for (int i = 0; i < 15; ++i) total += (D[i].N / 64) * (D[i].K / 64);
    for (int job = F.bid; job < total; job += F.G) {
        int kind = 0, rem = job;
#pragma unroll
        for (int i = 0; i < 15; ++i) { const int nt = (D[i].N / 64) * (D[i].K / 64); if (rem >= nt && kind == i) { rem -= nt; kind = i + 1; } }
        int K = 0; size_t dst = 0;
#pragma unroll
        for (int i = 0; i < 15; ++i) if (kind == i) { K = D[i].K; dst = D[i].dst; }
        const int ktiles = K / 64, n0 = (rem / ktiles) * 64, k0 = (rem % ktiles) * 64;
        int ld, klo, khi; const float* col = conv_col(F, l, kind, n0 + (F.tid & 63), ld, klo, khi);
        if (kind == 2) { if (k0 >= 768) { col = F.in(33) + (size_t)l * 256 * 1024 + n0 + (F.tid & 63); klo = 768; } else if (k0 >= 512) { col = F.in(32) + (size_t)l * 256 * 1024 + n0 + (F.tid & 63); klo = 512; } else khi = 512; }
        float v[8];
#pragma unroll
        for (int i = 0; i < 8; ++i) { const int k = k0 + (F.tid >> 6) + 8 * i; v[i] = (col != nullptr && k >= klo && k < khi) ? col[(size_t)(k - klo) * ld] : 0.f; }
        __syncthreads();
#pragma unroll
        for (int i = 0; i < 8; ++i) tile[((F.tid >> 6) + 8 * i) * 65 + (F.tid & 63)] = v[i];
        __syncthreads();
        bf16_t* O = WSP(bf16_t, dst);
#pragma unroll
        for (int i = 0; i < 4; ++i) { const int ny = (F.tid >> 5) + 16 * i, kp = F.tid & 31; *(unsigned*)(O + (size_t)(n0 + ny) * K + k0 + 2 * kp) = pk2(tile[(2 * kp) * 65 + ny], tile[(2 * kp + 1) * 65 + ny]); }
    }
    __syncthreads();
}

__device__ __forceinline__ void norm_rows(const Frame& F, int nrows, const float* xin32, const bf16_t* xin16, const bf16_t* Y, const float* gy, bf16_t* X16, float* X32, float* X32hi, const float* gh, bf16_t* H) {
    constexpr int NR = 8;
    const int nw = F.G * 8;
    for (int row0 = F.bid * 8 + F.wave; row0 < nrows; row0 += NR * nw) {
        f32x4 xf[NR][4]; u32x2 xr[NR][4], yr[NR][4];
#pragma unroll
        for (int q = 0; q < NR; ++q) {
            const int row = row0 + q * nw < nrows ? row0 + q * nw : row0;
#pragma unroll
            for (int i = 0; i < 4; ++i) {
                if (xin32) xf[q][i] = *(const f32x4*)(xin32 + (size_t)row * 1024 + i * 256 + F.lane * 4);
                else xr[q][i] = *(const u32x2*)(xin16 + (size_t)row * 1024 + i * 256 + F.lane * 4);
                if (Y) yr[q][i] = *(const u32x2*)(Y + (size_t)row * 1024 + i * 256 + F.lane * 4);
            }
        }
#pragma unroll
        for (int q = 0; q < NR; ++q) {
            const int row = row0 + q * nw;
            if (row < nrows) {
                f32x4 x[4];
#pragma unroll
                for (int i = 0; i < 4; ++i) x[i] = xin32 ? xf[q][i] : (f32x4){bflo(xr[q][i].x), bfhi(xr[q][i].x), bflo(xr[q][i].y), bfhi(xr[q][i].y)};
                if (Y) {
                    f32x4 y[4]; float ss = 0.f;
#pragma unroll
                    for (int i = 0; i < 4; ++i) { y[i] = (f32x4){bflo(yr[q][i].x), bfhi(yr[q][i].x), bflo(yr[q][i].y), bfhi(yr[q][i].y)}; ss += y[i][0] * y[i][0] + y[i][1] * y[i][1] + y[i][2] * y[i][2] + y[i][3] * y[i][3]; }
                    ss = wave_sum(ss); const float rs = rsqrtf(ss * (1.0f / 1024.0f) + 1e-6f);
#pragma unroll
                    for (int i = 0; i < 4; ++i) { const f32x4 g = *(const f32x4*)(gy + i * 256 + F.lane * 4); x[i] += y[i] * rs * g; }
                }
                if (X16) {
#pragma unroll
                    for (int i = 0; i < 4; ++i) *(u32x2*)(X16 + (size_t)row * 1024 + i * 256 + F.lane * 4) = pg8::cvt4_bf16(x[i]);
                }
                if (X32) {
                    float* dst = row < TOK / 2 ? X32 + (size_t)row * 1024 : X32hi + (size_t)(row - TOK / 2) * 1024;
#pragma unroll
                    for (int i = 0; i < 4; ++i) *(f32x4*)(dst + i * 256 + F.lane * 4) = x[i];
                }
                if (H) {
                    float ss = 0.f;
#pragma unroll
                    for (int i = 0; i < 4; ++i) ss += x[i][0] * x[i][0] + x[i][1] * x[i][1] + x[i][2] * x[i][2] + x[i][3] * x[i][3];
                    ss = wave_sum(ss); const float rs = rsqrtf(ss * (1.0f / 1024.0f) + 1e-6f);
#pragma unroll
                    for (int i = 0; i < 4; ++i) { const f32x4 g = *(const f32x4*)(gh + i * 256 + F.lane * 4); const f32x4 h = x[i] * rs * g;
                        *(u32x2*)(H + (size_t)row * 1024 + i * 256 + F.lane * 4) = pg8::cvt4_bf16(h); }
                }
            }
        }
    }
}

__device__ __forceinline__ void rwkv_lin_tile(const Frame& F, int l, int tile) {
    const bf16_t* ZR = WSP(const bf16_t, WS_ZR); bf16_t* LIN = WSP(bf16_t, WS_LIN);
    const float* mu = F.in(11) + (size_t)l * 1024 + 768;
    const int tk = F.tid >> 3, cg = F.tid & 7, row = tile * 64 + tk, t = row & 4095;
    u32x4 z[4], zp[4];
#pragma unroll
    for (int i = 0; i < 4; ++i) { z[i] = *(const u32x4*)(ZR + (size_t)row * 1024 + 768 + cg * 32 + i * 8); zp[i] = (u32x4){0u, 0u, 0u, 0u}; }
    if (t > 0) {
#pragma unroll
        for (int i = 0; i < 4; ++i) zp[i] = *(const u32x4*)(ZR + (size_t)(row - 1) * 1024 + 768 + cg * 32 + i * 8);
    }
#pragma unroll
    for (int i = 0; i < 4; ++i) {
        const f32x4 m0 = *(const f32x4*)(mu + cg * 32 + i * 8), m1 = *(const f32x4*)(mu + cg * 32 + i * 8 + 4);
        const unsigned zw[4] = {z[i].x, z[i].y, z[i].z, z[i].w}, pw[4] = {zp[i].x, zp[i].y, zp[i].z, zp[i].w}; float o[8];
#pragma unroll
        for (int j = 0; j < 8; ++j) { const float zz = (j & 1) ? bfhi(zw[j >> 1]) : bflo(zw[j >> 1]), pp = (j & 1) ? bfhi(pw[j >> 1]) : bflo(pw[j >> 1]); const float m = j < 4 ? m0[j & 3] : m1[j & 3];
            const float zs = zz + (pp - zz) * m; o[j] = cg < 2 ? tanhf(zs) : (cg < 4 ? zs : sigmoidf_(zs)); }
        u32x4 w; w.x = pk2(o[0], o[1]); w.y = pk2(o[2], o[3]); w.z = pk2(o[4], o[5]); w.w = pk2(o[6], o[7]);
        *(u32x4*)(LIN + (size_t)row * 256 + cg * 32 + i * 8) = w;
    }
}

__device__ __forceinline__ f32x4 mm16(const f32x4& XT, const f32x4& Y) {
    f32x4 z = {0.f, 0.f, 0.f, 0.f};
#pragma unroll
    for (int ks = 0; ks < 4; ++ks) z = __builtin_amdgcn_mfma_f32_16x16x4f32(XT[ks], Y[ks], z, 0, 0, 0);
    return z;
}
__device__ __forceinline__ void rwkv_chunk_prep(const Frame& F, int l, int ci) {
    const int bh = ci >> 8, c = ci & 255, b = bh >> 2, h = bh & 3, lane = F.lane, fr = lane & 15, fq = lane >> 4;
    LAS unsigned char* L = F.lds + F.wave * 9216;
    const bf16_t* ZR = WSP(const bf16_t, WS_ZR); const bf16_t* LW = WSP(const bf16_t, WS_LW); const bf16_t* LA = WSP(const bf16_t, WS_LA);
    const int ch = h * 64 + lane;
    const float* mu = F.in(11) + (size_t)l * 1024;
    const float mur = mu[ch], muk = mu[256 + ch], muv = mu[512 + ch], w0 = F.in(12)[l * 256 + ch], a0 = F.in(14)[l * 256 + ch], kkc = F.in(17)[l * 256 + ch], kac = F.in(18)[l * 256 + ch], rkc = F.in(19)[l * 256 + ch];
    const size_t row0 = (size_t)b * 4096 + c * 16;
    float pr = 0.f, pk = 0.f, pv = 0.f;
    if (c > 0) { pr = bf2f(ZR[(row0 - 1) * 1024 + ch]); pk = bf2f(ZR[(row0 - 1) * 1024 + 256 + ch]); pv = bf2f(ZR[(row0 - 1) * 1024 + 512 + ch]); }
    float gam = 1.0f; unsigned bT[8], kT[8], vT[8]; float* BON = WSP(float, WS_BONUS);
    float zr_[16], zk_[16], zv_[16], lw_[16], la_[16];
#pragma unroll
    for (int t = 0; t < 16; ++t) { const size_t row = row0 + t; zr_[t] = bf2f(ZR[row * 1024 + ch]); zk_[t] = bf2f(ZR[row * 1024 + 256 + ch]); zv_[t] = bf2f(ZR[row * 1024 + 512 + ch]);
        lw_[t] = bf2f(LW[row * 256 + ch]); la_[t] = bf2f(LA[row * 256 + ch]); }
    float bprev = 0.f, kprev = 0.f, vprev = 0.f;
#pragma unroll
    for (int t = 0; t < 16; ++t) {
        const float r = zr_[t] + (pr - zr_[t]) * mur, k = zk_[t] + (pk - zk_[t]) * muk, v = zv_[t] + (pv - zv_[t]) * muv; pr = zr_[t]; pk = zk_[t]; pv = zv_[t];
        const float u = w0 + lw_[t]; const float sp = fmaxf(-u, 0.f) + __logf(1.0f + __expf(-fabsf(u))); const float dec = __expf(-__expf(-sp - 0.5f));
        const float a = sigmoidf_(a0 + la_[t]);
        const float kkv = k * kkc; float n2 = row16_sum(kkv * kkv); n2 = xsum16(n2); n2 = xsum32(n2);
        const float kk = kkv * rsqrtf(fmaxf(n2, 1e-24f));
        const float kp = k * (1.0f + (a - 1.0f) * kac);
        float bon = row16_sum(r * kp * rkc); bon = xsum16(bon); bon = xsum32(bon);
        if (lane == 0) BON[(row0 + t) * 4 + h] = bon;
        const float gprev = gam; gam *= dec; const float ginv = __builtin_amdgcn_rcpf(gam);
        const float ah = -gprev * kk, bh_ = kk * a * ginv, kh = kp * ginv, rh = gam * r;
        *(LAS bf16_t*)(L + 0 * 2304 + t * 144 + lane * 2) = f2bf(ah); *(LAS bf16_t*)(L + 1 * 2304 + t * 144 + lane * 2) = f2bf(rh);
        *(LAS bf16_t*)(L + 2 * 2304 + t * 144 + lane * 2) = f2bf(bh_); *(LAS bf16_t*)(L + 3 * 2304 + t * 144 + lane * 2) = f2bf(kh);
        if (t & 1) { bT[t >> 1] = pk2(bprev, bh_); kT[t >> 1] = pk2(kprev, kh); vT[t >> 1] = pk2(vprev, v); } else { bprev = bh_; kprev = kh; vprev = v; }
    }
    {
        bf16_t* BKT = WSP(bf16_t, WS_CS_BKT) + ((size_t)ci * 64 + lane) * 32; bf16_t* VMT = WSP(bf16_t, WS_CS_VMT) + ((size_t)ci * 64 + lane) * 16;
        *(u32x4*)(BKT) = (u32x4){bT[0], bT[1], bT[2], bT[3]}; *(u32x4*)(BKT + 8) = (u32x4){bT[4], bT[5], bT[6], bT[7]};
        *(u32x4*)(BKT + 16) = (u32x4){kT[0], kT[1], kT[2], kT[3]}; *(u32x4*)(BKT + 24) = (u32x4){kT[4], kT[5], kT[6], kT[7]};
        *(u32x4*)(VMT) = (u32x4){vT[0], vT[1], vT[2], vT[3]}; *(u32x4*)(VMT + 8) = (u32x4){vT[4], vT[5], vT[6], vT[7]};
        WSP(float, WS_CS_GAM)[(size_t)ci * 64 + lane] = gam;
    }
    asm volatile("s_waitcnt lgkmcnt(0)" ::: "memory");
    {
        bf16_t* AR = WSP(bf16_t, WS_CS_AR) + (size_t)ci * 2048;
#pragma unroll
        for (int j = 0; j < 4; ++j) { const int e = lane + 64 * j, which = e >> 7, row = (e >> 3) & 15, c16 = e & 7;
            *(u32x4*)(AR + e * 8) = *(const LAS u32x4*)(L + which * 2304 + row * 144 + c16 * 16); }
    }
    bf16x8 Af[2], Rf[2], Bf[2], Kf[2];
#pragma unroll
    for (int ks = 0; ks < 2; ++ks) { Af[ks] = *(const LAS bf16x8*)(L + 0 * 2304 + fr * 144 + ks * 64 + fq * 16); Rf[ks] = *(const LAS bf16x8*)(L + 1 * 2304 + fr * 144 + ks * 64 + fq * 16);
        Bf[ks] = *(const LAS bf16x8*)(L + 2 * 2304 + fr * 144 + ks * 64 + fq * 16); Kf[ks] = *(const LAS bf16x8*)(L + 3 * 2304 + fr * 144 + ks * 64 + fq * 16); }
    f32x4 Pab = {0.f, 0.f, 0.f, 0.f}, PabT = Pab, Pak = Pab, Prb = Pab, Prk = Pab;
#pragma unroll
    for (int ks = 0; ks < 2; ++ks) { Pab = __builtin_amdgcn_mfma_f32_16x16x32_bf16(Af[ks], Bf[ks], Pab, 0, 0, 0); PabT = __builtin_amdgcn_mfma_f32_16x16x32_bf16(Bf[ks], Af[ks], PabT, 0, 0, 0);
        Pak = __builtin_amdgcn_mfma_f32_16x16x32_bf16(Af[ks], Kf[ks], Pak, 0, 0, 0); Prb = __builtin_amdgcn_mfma_f32_16x16x32_bf16(Rf[ks], Bf[ks], Prb, 0, 0, 0); Prk = __builtin_amdgcn_mfma_f32_16x16x32_bf16(Rf[ks], Kf[ks], Prk, 0, 0, 0); }
    f32x4 One = {0.f, 0.f, 0.f, 0.f};
#pragma unroll
    for (int r = 0; r < 4; ++r) { const int rho = 4 * fq + r;
        Pab[r] = fr < rho ? Pab[r] : 0.f; Pak[r] = fr < rho ? Pak[r] : 0.f; PabT[r] = rho < fr ? PabT[r] : 0.f; Prb[r] = fr <= rho ? Prb[r] : 0.f; Prk[r] = fr <= rho ? Prk[r] : 0.f; One[r] = fr == rho ? 1.f : 0.f; }
    {
        bf16_t* AAK = WSP(bf16_t, WS_CS_AAK) + (size_t)ci * 256; bf16_t* ARBK = WSP(bf16_t, WS_CS_ARBK) + (size_t)ci * 512;
#pragma unroll
        for (int r = 0; r < 4; ++r) { const int rho = 4 * fq + r; AAK[rho * 16 + fr] = f2bf(Pak[r]); ARBK[rho * 32 + fr] = f2bf(Prb[r]); ARBK[rho * 32 + 16 + fr] = f2bf(Prk[r]); }
    }
    const f32x4 A2 = mm16(PabT, Pab), A2T = mm16(Pab, PabT), A4 = mm16(A2T, A2), A4T = mm16(A2, A2T), A8 = mm16(A4T, A4);
    const f32x4 G1 = mm16(One + PabT, One + A2), G1T = mm16(One + A2, One + PabT), G2 = mm16(One + A4T, One + A8);
    const f32x4 Mm = mm16(G1T, G2);
    { float* MM = WSP(float, WS_CS_MM) + (size_t)ci * 256;
#pragma unroll
      for (int r = 0; r < 4; ++r) MM[(4 * fq + r) * 16 + fr] = Mm[r]; }
    asm volatile("s_waitcnt lgkmcnt(0)" ::: "memory");
}
constexpr int CS_AH = 0, CS_RH = 2304, CS_BKT = 4608, CS_VMT = 9728, CS_AAK = 11776, CS_ARBK = 12288, CS_MM = 13568, CS_GAM = 14848, CS_REC = 15360;
__device__ __forceinline__ void rwkv_chunk_scan(const Frame& F, int bh) {
    const int b = bh >> 2, h = bh & 3, lane = F.lane, fr = lane & 15, fq = lane >> 4, tid = F.tid;
    const bf16_t* AR = WSP(const bf16_t, WS_CS_AR) + (size_t)bh * 256 * 2048; const bf16_t* BKT = WSP(const bf16_t, WS_CS_BKT) + (size_t)bh * 256 * 2048;
    const bf16_t* VMT = WSP(const bf16_t, WS_CS_VMT) + (size_t)bh * 256 * 1024; const bf16_t* AAK = WSP(const bf16_t, WS_CS_AAK) + (size_t)bh * 256 * 256;
    const bf16_t* ARBK = WSP(const bf16_t, WS_CS_ARBK) + (size_t)bh * 256 * 512; const float* MMg = WSP(const float, WS_CS_MM) + (size_t)bh * 256 * 256; const float* GAM = WSP(const float, WS_CS_GAM) + (size_t)bh * 256 * 64;
    float* YS = WSP(float, WS_YSCAN);
    const unsigned char* g1; int l1, s1;
    if (tid < 256) { g1 = (const unsigned char*)AR + tid * 16; l1 = (tid >> 7) * 2304 + ((tid >> 3) & 15) * 144 + (tid & 7) * 16; s1 = 4096; }
    else { const int e = tid - 256; g1 = (const unsigned char*)BKT + e * 16; l1 = CS_BKT + (e >> 2) * 80 + (e & 3) * 16; s1 = 4096; }
    const unsigned char* g2 = (const unsigned char*)VMT; int l2 = 0, s2 = 0; const bool has2 = tid < 304;
    if (tid < 128) { g2 = (const unsigned char*)VMT + tid * 16; l2 = CS_VMT + (tid >> 1) * 32 + (tid & 1) * 16; s2 = 2048; }
    else if (tid < 160) { const int e = tid - 128; g2 = (const unsigned char*)AAK + e * 16; l2 = CS_AAK + (e >> 1) * 32 + (e & 1) * 16; s2 = 512; }
    else if (tid < 224) { const int e = tid - 160; g2 = (const unsigned char*)ARBK + e * 16; l2 = CS_ARBK + (e >> 2) * 80 + (e & 3) * 16; s2 = 1024; }
    else if (tid < 288) { const int e = tid - 224; g2 = (const unsigned char*)MMg + e * 16; l2 = CS_MM + (e >> 2) * 80 + (e & 3) * 16; s2 = 1024; }
    else if (tid < 304) { const int e = tid - 288; g2 = (const unsigned char*)GAM + e * 16; l2 = CS_GAM + e * 16; s2 = 256; }
    f32x4 S[4];
#pragma unroll
    for (int kt = 0; kt < 4; ++kt) S[kt] = (f32x4){0.f, 0.f, 0.f, 0.f};
    const int v0 = 16 * F.wave;
    u32x4 R0a, R0b = {0u, 0u, 0u, 0u}, R1a, R1b = {0u, 0u, 0u, 0u};
#define CS_LOAD(R, c) do { R##a = *(const u32x4*)(g1 + (size_t)(c) * s1); if (has2) R##b = *(const u32x4*)(g2 + (size_t)(c) * s2); } while (0)
#define CS_WRITE(R, buf) do { *(LAS u32x4*)(F.lds + (buf) * CS_REC + l1) = R##a; if (has2) *(LAS u32x4*)(F.lds + (buf) * CS_REC + l2) = R##b; } while (0)
#define CS_COMPUTE(buf, c) do { if (F.wave < 4) { const LAS unsigned char* B = F.lds + (buf) * CS_REC; \
        bf16x8 sp[2]; \
        _Pragma("unroll") for (int ks = 0; ks < 2; ++ks) sp[ks] = pg8::cvt8_bf16(S[2 * ks], S[2 * ks + 1]); \
        const u32x2 vmf = *(const LAS u32x2*)(B + CS_VMT + (v0 + fr) * 32 + fq * 8); \
        f32x4 wt = {0.f, 0.f, 0.f, 0.f}, yt = {0.f, 0.f, 0.f, 0.f}; \
        _Pragma("unroll") for (int ks = 0; ks < 2; ++ks) { \
            const u32x2 a0_ = *(const LAS u32x2*)(B + CS_AH + fr * 144 + (32 * ks + 4 * fq) * 2), a1_ = *(const LAS u32x2*)(B + CS_AH + fr * 144 + (32 * ks + 16 + 4 * fq) * 2); \
            const u32x2 r0_ = *(const LAS u32x2*)(B + CS_RH + fr * 144 + (32 * ks + 4 * fq) * 2), r1_ = *(const LAS u32x2*)(B + CS_RH + fr * 144 + (32 * ks + 16 + 4 * fq) * 2); \
            wt = __builtin_amdgcn_mfma_f32_16x16x32_bf16(__builtin_bit_cast(bf16x8, ((u32x4){a0_.x, a0_.y, a1_.x, a1_.y})), sp[ks], wt, 0, 0, 0); \
            yt = __builtin_amdgcn_mfma_f32_16x16x32_bf16(__builtin_bit_cast(bf16x8, ((u32x4){r0_.x, r0_.y, r1_.x, r1_.y})), sp[ks], yt, 0, 0, 0); } \
        { const u32x2 ak = *(const LAS u32x2*)(B + CS_AAK + fr * 32 + fq * 8); \
          wt = __builtin_amdgcn_mfma_f32_16x16x32_bf16(__builtin_bit_cast(bf16x8, ((u32x4){ak.x, ak.y, 0u, 0u})), __builtin_bit_cast(bf16x8, ((u32x4){vmf.x, vmf.y, 0u, 0u})), wt, 0, 0, 0); } \
        const f32x4 mrow = *(const LAS f32x4*)(B + CS_MM + fr * 80 + fq * 16); \
        f32x4 ut = {0.f, 0.f, 0.f, 0.f}; \
        _Pragma("unroll") for (int ks = 0; ks < 4; ++ks) ut = __builtin_amdgcn_mfma_f32_16x16x4f32(mrow[ks], wt[ks], ut, 0, 0, 0); \
        const u32x2 utp = pg8::cvt4_bf16(ut); const bf16x8 uv = __builtin_bit_cast(bf16x8, ((u32x4){utp.x, utp.y, vmf.x, vmf.y})); \
        { const u32x2 q0_ = *(const LAS u32x2*)(B + CS_ARBK + fr * 80 + fq * 8), q1_ = *(const LAS u32x2*)(B + CS_ARBK + fr * 80 + 32 + fq * 8); \
          yt = __builtin_amdgcn_mfma_f32_16x16x32_bf16(__builtin_bit_cast(bf16x8, ((u32x4){q0_.x, q0_.y, q1_.x, q1_.y})), uv, yt, 0, 0, 0); } \
        _Pragma("unroll") for (int r = 0; r < 4; ++r) YS[((size_t)b * 4096 + (c) * 16 + 4 * fq + r) * 256 + h * 64 + v0 + fr] = yt[r]; \
        _Pragma("unroll") for (int kt = 0; kt < 4; ++kt) { \
            const u32x2 b0_ = *(const LAS u32x2*)(B + CS_BKT + (16 * kt + fr) * 80 + fq * 8), b1_ = *(const LAS u32x2*)(B + CS_BKT + (16 * kt + fr) * 80 + 32 + fq * 8); \
            const f32x4 gm = *(const LAS f32x4*)(B + CS_GAM + (16 * kt + 4 * fq) * 4); \
            S[kt] = __builtin_amdgcn_mfma_f32_16x16x32_bf16(__builtin_bit_cast(bf16x8, ((u32x4){b0_.x, b0_.y, b1_.x, b1_.y})), uv, S[kt], 0, 0, 0) * gm; } } } while (0)
    CS_LOAD(R0, 0); CS_LOAD(R1, 1);
    __syncthreads();
    CS_WRITE(R0, 0); CS_LOAD(R0, 2);
    __syncthreads();
    for (int c = 0; c < 256; c += 2) {
        CS_COMPUTE(0, c);
        CS_WRITE(R1, 1); if (c + 3 < 256) CS_LOAD(R1, c + 3);
        __syncthreads();
        CS_COMPUTE(1, c + 1);
        if (c + 2 < 256) { CS_WRITE(R0, 0); if (c + 4 < 256) CS_LOAD(R0, c + 4); }
        __syncthreads();
    }
#undef CS_LOAD
#undef CS_WRITE
#undef CS_COMPUTE
}

__device__ __forceinline__ void rwkv_post(const Frame& F, int l) {
    const float* YS = WSP(const float, WS_YSCAN); const bf16_t* VMT = WSP(const bf16_t, WS_CS_VMT); const bf16_t* RG = WSP(const bf16_t, WS_RG); const float* BON = WSP(const float, WS_BONUS);
    bf16_t* YR = WSP(bf16_t, WS_YCAT) + 512;
    for (int ci = F.bid * 8 + F.wave; ci < 32 * 256; ci += F.G * 8) {
        const int bh = ci >> 8, c = ci & 255, b = bh >> 2, h = bh & 3, ch = h * 64 + F.lane;
        const float lnw = F.in(20)[l * 256 + ch], lnb = F.in(21)[l * 256 + ch];
        const u32x4 v0 = *(const u32x4*)(VMT + ((size_t)ci * 64 + F.lane) * 16), v1 = *(const u32x4*)(VMT + ((size_t)ci * 64 + F.lane) * 16 + 8);
        const unsigned vw[8] = {v0.x, v0.y, v0.z, v0.w, v1.x, v1.y, v1.z, v1.w};
        const size_t row0 = (size_t)b * 4096 + c * 16;
        float y[16], g[16], bo[16];
#pragma unroll
        for (int t = 0; t < 16; ++t) { y[t] = YS[(row0 + t) * 256 + ch]; g[t] = bf2f(RG[(row0 + t) * 256 + ch]); bo[t] = BON[(row0 + t) * 4 + h]; }
#pragma unroll
        for (int t = 0; t < 16; ++t) {
            const float mean = wave_sum(y[t]) * (1.0f / 64.0f); const float d = y[t] - mean; const float var = wave_sum(d * d) * (1.0f / 64.0f);
            const float yn = d * rsqrtf(var + 64e-5f) * lnw + lnb; const float v = (t & 1) ? bfhi(vw[t >> 1]) : bflo(vw[t >> 1]);
            YR[(row0 + t) * 1024 + ch] = f2bf((yn + bo[t] * v) * g[t]);
        }
    }
}

struct S5Coef { float are, aim; bf16x8 Bf[8]; };
__device__ __forceinline__ void s5_abar(const Frame& F, int l, int g, int p, float& are, float& aim, float& cre, float& cim) {
    const float lr = F.in(22)[(l * 16 + g) * 64 + p], li = F.in(23)[(l * 16 + g) * 64 + p], dt = expf(F.in(24)[l * 16 + g]);
    const float mag = expf(lr * dt); float sn, cs; sincosf(li * dt, &sn, &cs);
    are = mag * cs; aim = mag * sn;
    const float den = lr * lr + li * li; cre = ((are - 1.0f) * lr + aim * li) / den; cim = (aim * lr - (are - 1.0f) * li) / den;
}
__device__ __forceinline__ void s5_setup(const Frame& F, int l, int g, int lane, S5Coef& C) {
    float cre, cim; s5_abar(F, l, g, lane, C.are, C.aim, cre, cim);
    const int fr = lane & 15, fq = lane >> 4;
#pragma unroll
    for (int pt = 0; pt < 4; ++pt) {
        const int p = 16 * pt + fr; float are, aim, c_re, c_im; s5_abar(F, l, g, p, are, aim, c_re, c_im);
        u32x4 wr = {0u, 0u, 0u, 0u}, wi = {0u, 0u, 0u, 0u};
        if (fq < 2) {
            const float* bre = F.in(25) + ((size_t)(l * 16 + g) * 64 + p) * 16 + 8 * fq; const float* bim = F.in(26) + ((size_t)(l * 16 + g) * 64 + p) * 16 + 8 * fq;
            float re[8], im[8];
#pragma unroll
            for (int j = 0; j < 8; ++j) { re[j] = c_re * bre[j] - c_im * bim[j]; im[j] = c_re * bim[j] + c_im * bre[j]; }
            wr = (u32x4){pk2(re[0], re[1]), pk2(re[2], re[3]), pk2(re[4], re[5]), pk2(re[6], re[7])}; wi = (u32x4){pk2(im[0], im[1]), pk2(im[2], im[3]), pk2(im[4], im[5]), pk2(im[6], im[7])};
        }
        C.Bf[pt] = __builtin_bit_cast(bf16x8, wr); C.Bf[pt + 4] = __builtin_bit_cast(bf16x8, wi);
    }
}
template <int NSTEPS>
__device__ __forceinline__ void s5_stage_u(const bf16_t* ZS, int b, int g, int t0, LAS unsigned char* us, int lane) {
#pragma unroll
    for (int i = 0; i < NSTEPS / 32; ++i) { const int id = lane + 64 * i, step = id >> 1, hf = id & 1;
        const u32x4 v = *(const u32x4*)(ZS + ((size_t)(b * 4096 + t0 + step) * 256 + g * 16 + hf * 8));
        *(LAS u32x4*)(us + id * 16) = v; }
    asm volatile("s_waitcnt vmcnt(0) lgkmcnt(0)" ::: "memory");
}
__device__ __forceinline__ void s5_project16(const S5Coef& C, const LAS unsigned char* us16, LAS unsigned* bu, int fr, int fq) {
    u32x4 a = {0u, 0u, 0u, 0u};
    if (fq < 2) a = *(const LAS u32x4*)(us16 + fr * 32 + fq * 16);
    const bf16x8 af = __builtin_bit_cast(bf16x8, a);
    f32x4 c[8];
#pragma unroll
    for (int i = 0; i < 8; ++i) { const int nt = (i >> 1) + 4 * (i & 1);
        c[nt] = __builtin_amdgcn_mfma_f32_16x16x32_bf16(af, C.Bf[nt], (f32x4){0.f, 0.f, 0.f, 0.f}, 0, 0, 0); }
    asm volatile("s_nop 15\n\ts_nop 15\n\ts_nop 15\n\ts_nop 15\n\ts_nop 15\n\ts_nop 15\n\ts_nop 15\n\ts_nop 15\n\ts_nop 15\n\ts_nop 15" : "+v"(c[0]), "+v"(c[1]), "+v"(c[2]), "+v"(c[3]), "+v"(c[4]), "+v"(c[5]), "+v"(c[6]), "+v"(c[7]));
    unsigned w[16];
#pragma unroll
    for (int pt = 0; pt < 4; ++pt)
#pragma unroll
        for (int r = 0; r < 4; ++r) w[pt * 4 + r] = pg8::cvt_pk_bf16(c[pt][r], c[pt + 4][r]);
    asm volatile("" : "+v"(w[0]), "+v"(w[1]), "+v"(w[2]), "+v"(w[3]), "+v"(w[4]), "+v"(w[5]), "+v"(w[6]), "+v"(w[7]), "+v"(w[8]), "+v"(w[9]), "+v"(w[10]), "+v"(w[11]), "+v"(w[12]), "+v"(w[13]), "+v"(w[14]), "+v"(w[15]));
#pragma unroll
    for (int pt = 0; pt < 4; ++pt)
#pragma unroll
        for (int r = 0; r < 4; ++r) bu[(4 * fq + r) * 64 + 16 * pt + fr] = w[pt * 4 + r];
    asm volatile("s_waitcnt lgkmcnt(0)" : "+v"(w[0]), "+v"(w[1]), "+v"(w[2]), "+v"(w[3]), "+v"(w[4]), "+v"(w[5]), "+v"(w[6]), "+v"(w[7]), "+v"(w[8]), "+v"(w[9]), "+v"(w[10]), "+v"(w[11]), "+v"(w[12]), "+v"(w[13]), "+v"(w[14]), "+v"(w[15]) :: "memory");
}
__device__ __forceinline__ void s5_pass1(const Frame& F, int l, int item) {
    const int b = item >> 8, g = (item >> 4) & 15, ch = item & 15, p = F.lane, fr = F.lane & 15, fq = F.lane >> 4;
    LAS unsigned char* us = F.lds + F.wave * 12288;
    LAS unsigned* bu = (LAS unsigned*)(us + 8192);
    S5Coef C; s5_setup(F, l, g, F.lane, C);
    s5_stage_u<256>(WSP(const bf16_t, WS_ZS), b, g, ch * 256, us, F.lane);
    float xr = 0.f, xi = 0.f;
    for (int t16 = 0; t16 < 16; ++t16) {
        s5_project16(C, us + t16 * 512, bu, fr, fq);
#pragma unroll
        for (int q = 0; q < 16; ++q) { const unsigned v = bu[q * 64 + p]; const float nr = C.are * xr - C.aim * xi + bflo(v), ni = C.are * xi + C.aim * xr + bfhi(v); xr = nr; xi = ni; }
        asm volatile("s_waitcnt lgkmcnt(0)" ::: "memory");
    }
    *(f32x2*)(WSP(float, WS_XEND) + ((size_t)((b * 16 + g) * 16 + ch) * 64 + p) * 2) = (f32x2){xr, xi};
}
__device__ __forceinline__ void s5_pass2(const Frame& F, int l, int item) {
    const int b = item >> 8, g = (item >> 4) & 15, ch = item & 15, p = F.lane, fr = F.lane & 15, fq = F.lane >> 4;
    LAS unsigned char* us = F.lds + F.wave * 12544;
    LAS unsigned* bu = (LAS unsigned*)(us + 4096); LAS unsigned char* xs = us + 8192;
    S5Coef C; s5_setup(F, l, g, F.lane, C);
    bf16x8 cb[4];
    {
        const float* cre = F.in(27) + ((size_t)(l * 16 + g) * 16 + fr) * 64; const float* cim = F.in(28) + ((size_t)(l * 16 + g) * 16 + fr) * 64;
#pragma unroll
        for (int ks = 0; ks < 4; ++ks) { const float* src = (ks < 2 ? cre : cim) + (ks & 1) * 32 + 8 * fq; const f32x4 a0 = *(const f32x4*)src, a1 = *(const f32x4*)(src + 4); const float sg = ks < 2 ? 1.f : -1.f;
            u32x4 w; w.x = pk2(sg * a0[0], sg * a0[1]); w.y = pk2(sg * a0[2], sg * a0[3]); w.z = pk2(sg * a1[0], sg * a1[1]); w.w = pk2(sg * a1[2], sg * a1[3]); cb[ks] = __builtin_bit_cast(bf16x8, w); }
    }
    float ar = C.are, ai = C.aim;
#pragma unroll
    for (int i = 0; i < 8; ++i) { const float nr = ar * ar - ai * ai, ni = 2.f * ar * ai; ar = nr; ai = ni; }
    float xr = 0.f, xi = 0.f;
    const float* XE = WSP(const float, WS_XEND) + ((size_t)((b * 16 + g) * 16) * 64 + p) * 2;
    for (int c2 = 0; c2 < ch; ++c2) { const f32x2 e = *(const f32x2*)(XE + (size_t)c2 * 128); const float nr = ar * xr - ai * xi + e[0], ni = ar * xi + ai * xr + e[1]; xr = nr; xi = ni; }
    bf16_t* YG = WSP(bf16_t, WS_YS5G);
    const float dcoef = F.in(29)[(l * 16 + g) * 16 + fr];
    for (int t16 = 0; t16 < 16; ++t16) {
        if ((t16 & 7) == 0) s5_stage_u<128>(WSP(const bf16_t, WS_ZS), b, g, ch * 256 + t16 * 16, us, F.lane);
        const LAS unsigned char* us16 = us + (t16 & 7) * 512;
        s5_project16(C, us16, bu, fr, fq);
#pragma unroll
        for (int q = 0; q < 16; ++q) { const unsigned v = bu[q * 64 + p]; const float nr = C.are * xr - C.aim * xi + bflo(v), ni = C.are * xi + C.aim * xr + bfhi(v); xr = nr; xi = ni;
            *(LAS bf16_t*)(xs + q * 272 + p * 2) = f2bf(xr); *(LAS bf16_t*)(xs + q * 272 + 128 + p * 2) = f2bf(xi); }
        asm volatile("s_waitcnt lgkmcnt(0)" ::: "memory");
        f32x4 acc = {0.f, 0.f, 0.f, 0.f};
#pragma unroll
        for (int ks = 0; ks < 4; ++ks) { const bf16x8 af = *(const LAS bf16x8*)(xs + fr * 272 + ks * 64 + fq * 16); acc = __builtin_amdgcn_mfma_f32_16x16x32_bf16(af, cb[ks], acc, 0, 0, 0); }
#pragma unroll
        for (int r = 0; r < 4; ++r) { const int st = 4 * fq + r; const float u = bf2f(*(const LAS bf16_t*)(us16 + st * 32 + fr * 2));
            YG[(size_t)(b * 4096 + ch * 256 + t16 * 16 + st) * 256 + g * 16 + fr] = f2bf(gelu_tanh(acc[r] + dcoef * u)); }
        asm volatile("s_waitcnt lgkmcnt(0)" ::: "memory");
    }
}

__device__ __forceinline__ void cmp_bias(const Frame& F, int l, int w) {
    const int kv = w >> 5, part = w & 31;
    const float* pos = F.in(kv ? 6 : 5) + (size_t)l * 2048; const float* w1 = F.in(kv ? 9 : 7) + (size_t)l * 2048 * 256;
    LAS float* red = (LAS float*)F.lds;
    __syncthreads();
    const int j = F.tid & 255, hf = F.tid >> 8; float s = 0.f;
#pragma unroll 8
    for (int ii = 0; ii < 32; ++ii) { const int i = part * 64 + hf * 32 + ii; s += pos[i] * w1[(size_t)i * 256 + j]; }
    red[F.tid] = s;
    __syncthreads();
    if (F.tid < 256) WSP(float, WS_CBIAS)[(size_t)w * 256 + F.tid] = red[F.tid] + red[F.tid + 256];
    __syncthreads();
}
__device__ __forceinline__ void cmp_finalize(const Frame& F, int l) {
    LAS float* hid = (LAS float*)F.lds + F.wave * 256; LAS float* biasL = (LAS float*)F.lds + 2048;
    __syncthreads();
    { const float* part = WSP(const float, WS_CBIAS) + (size_t)(F.tid >> 8) * 32 * 256 + (F.tid & 255); float sb = 0.f;
#pragma unroll 8
      for (int q = 0; q < 32; ++q) sb += part[q * 256];
      biasL[F.tid] = sb; }
    __syncthreads();
    for (int idx = F.bid * 8 + F.wave; idx < 2 * 4096; idx += F.G * 8) {
        const int kv = idx >> 12, bg = (idx >> 8) & 15, n = idx & 255;
        const bf16_t* PQ = WSP(const bf16_t, WS_PQ + (size_t)kv * 4 * MiB); const LAS float* bias = biasL + kv * 256;
        const float* w2 = F.in(kv ? 10 : 8) + (size_t)l * 256 * 64;
        float o = 0.f;
        if (n < 255) {
            asm volatile("s_waitcnt lgkmcnt(0)" ::: "memory");
#pragma unroll
            for (int i = 0; i < 4; ++i) { const int j = F.lane + 64 * i; hid[j] = gelu_tanh(bf2f(PQ[(size_t)(bg * 256 + n) * 512 + j]) + bf2f(PQ[(size_t)(bg * 256 + n + 1) * 512 + 256 + j]) + bias[j]); }
            asm volatile("s_waitcnt lgkmcnt(0)" ::: "memory");
#pragma unroll 8
            for (int j = 0; j < 256; ++j) o += hid[j] * w2[j * 64 + F.lane];
        }
        if (kv == 0) WSP(bf16_t, WS_KCC)[(size_t)(bg * 256 + n) * 64 + F.lane] = f2bf(o);
        else WSP(bf16_t, WS_VCCT)[(size_t)(bg * 64 + F.lane) * 256 + vperm(n)] = f2bf(o);
    }
}

struct AttnAcc { float m[2], l[2]; f32x4 o[2][4]; };
__device__ __forceinline__ void attn_init(AttnAcc& a) {
#pragma unroll
    for (int mt = 0; mt < 2; ++mt) { a.m[mt] = -1e30f; a.l[mt] = 0.f;
#pragma unroll
        for (int dt = 0; dt < 4; ++dt) a.o[mt][dt] = (f32x4){0.f, 0.f, 0.f, 0.f}; }
}
constexpr int KP = 160, VP = 160;
constexpr int TB_K0 = 0, TB_V0 = 10240, TB_K1 = 20480, TB_V1 = 30720, TB_END = 40960;
struct MaskInfo { int qb; int tq[2]; int nmax[2]; u64 selm[2]; };
template <int KIND> __device__ __forceinline__ bool mask_el(const MaskInfo& M, int mt, int tile, int kl) {
    if (KIND == 0) return tile * 64 + kl <= M.nmax[mt];
    if (KIND == 1) return kl <= M.tq[mt];
    if (KIND == 2) return tile == M.qb ? (kl <= M.tq[mt]) : (kl > M.tq[mt]);
    return true;
}
template <int MODE, int KIND, bool MASKED, int MT0 = 0, int MT1 = 2>
__device__ __forceinline__ void attn_tile(const LAS unsigned char* Kt, const LAS unsigned char* Vt, const bf16x8 (&qf)[2][2], AttnAcc& a, const MaskInfo& M, int tile, float cexp,
                                          int fr, int fq, LAS float* impA, LAS float* impB, int qbase) {
    f32x4 s[2][4];
#pragma unroll
    for (int nt = 0; nt < 4; ++nt) {
        const bf16x8 k0 = *(const LAS bf16x8*)(Kt + (16 * nt + fr) * KP + fq * 16), k1 = *(const LAS bf16x8*)(Kt + (16 * nt + fr) * KP + 64 + fq * 16);
#pragma unroll
        for (int mt = MT0; mt < MT1; ++mt) { f32x4 z = {0.f, 0.f, 0.f, 0.f}; z = __builtin_amdgcn_mfma_f32_16x16x32_bf16(k0, qf[mt][0], z, 0, 0, 0); z = __builtin_amdgcn_mfma_f32_16x16x32_bf16(k1, qf[mt][1], z, 0, 0, 0); s[mt][nt] = z;
#if PROBE_MFMA2X
            if (MODE == 0) { f32x4 z2 = {1.f, 0.f, 0.f, 0.f}; z2 = __builtin_amdgcn_mfma_f32_16x16x32_bf16(k1, qf[mt][0], z2, 0, 0, 0); z2 = __builtin_amdgcn_mfma_f32_16x16x32_bf16(k0, qf[mt][1], z2, 0, 0, 0); asm volatile("" :: "v"(z2)); }
#endif
        }
    }
#pragma unroll
    for (int mt = MT0; mt < MT1; ++mt) {
        bool flag = true;
        if (KIND == 1) flag = ((M.selm[mt] >> tile) & 1ull) != 0ull;
        float mx = -1e30f;
#pragma unroll
        for (int nt = 0; nt < 4; ++nt)
#pragma unroll
            for (int r = 0; r < 4; ++r) { float v = s[mt][nt][r]; if (MASKED) { v = mask_el<KIND>(M, mt, tile, 16 * nt + 4 * fq + r) ? v : -1e30f; s[mt][nt][r] = v; } mx = fmaxf(mx, v); }
        if (MODE != 2) {
            mx = xmax16(mx); mx = xmax32(mx);
            mx = flag ? mx : -1e30f;
            const float mnew = fmaxf(a.m[mt], mx), alpha = __builtin_amdgcn_exp2f((a.m[mt] - mnew) * cexp); a.m[mt] = mnew;
            const float mc = (flag && mnew > -1e29f) ? mnew * cexp : 1e30f;
            float ps = 0.f;
#pragma unroll
            for (int nt = 0; nt < 4; ++nt)
#pragma unroll
                for (int r = 0; r < 4; ++r) { const float pv = __builtin_amdgcn_exp2f(__builtin_fmaf(s[mt][nt][r], cexp, -mc));
#if PROBE_EXP2X
                    { float dummy = __builtin_amdgcn_exp2f(__builtin_fmaf(s[mt][nt][r], cexp * 0.5f, -mc)); asm volatile("" :: "v"(dummy)); }
#endif
                    s[mt][nt][r] = pv; ps += pv; }
            a.l[mt] = a.l[mt] * alpha + ps;
            if (MODE == 0) {
                if (__ballot(alpha != 1.0f) != 0ull) {
#pragma unroll
                    for (int dt = 0; dt < 4; ++dt) a.o[mt][dt] *= alpha;
                }
            }
        } else {
            const float mc = a.m[mt] > -1e29f ? a.m[mt] * cexp : 1e30f;
#pragma unroll
            for (int nt = 0; nt < 4; ++nt) {
#pragma unroll
                for (int r = 0; r < 4; ++r) s[mt][nt][r] = __builtin_amdgcn_exp2f(__builtin_fmaf(s[mt][nt][r], cexp, -mc)) * a.l[mt];
                float A4 = (s[mt][nt][0] + s[mt][nt][1]) + (s[mt][nt][2] + s[mt][nt][3]), B1 = s[mt][nt][3];
                A4 = quad_sum(A4); B1 = quad_sum(B1);
                if ((fr & 3) == 0) { const int ql = qbase + ((fr + 16 * mt) >> 2), J = 16 * tile + 4 * nt + fq; impA[ql * 64 + J] = A4; impB[ql * 64 + J] = B1; }
            }
        }
    }
    if (MODE != 1) {
#pragma unroll
        for (int ks = 0; ks < 2; ++ks) {
            bf16x8 pb[2];
#pragma unroll
            for (int mt = MT0; mt < MT1; ++mt) {
                const f32x4 p0 = s[mt][2 * ks], p1 = s[mt][2 * ks + 1];
                pb[mt] = pg8::cvt8_bf16(p0, p1);
            }
#pragma unroll
            for (int dt = 0; dt < 4; ++dt) {
                const bf16x8 vf = *(const LAS bf16x8*)(Vt + (16 * dt + fr) * VP + (32 * ks + 8 * fq) * 2);
#pragma unroll
                for (int mt = MT0; mt < MT1; ++mt) a.o[mt][dt] = __builtin_amdgcn_mfma_f32_16x16x32_bf16(vf, pb[mt], a.o[mt][dt], 0, 0, 0);
            }
        }
    }
}
template <int KIND> __device__ __forceinline__ bool tile_masked(int qb, int tile) {
    if (KIND == 0) { const int t0 = qb * 64; const int nmin = t0 >= 31 ? ((t0 - 31) >> 4) : -1; return tile * 64 + 63 > nmin; }
    if (KIND == 1) return tile == qb;
    if (KIND == 2) return tile == qb || tile == qb - 8;
    return false;
}
__device__ __forceinline__ int pop_tile(u64& m) { if (m == 0ull) return -1; const int t = __builtin_ctzll(m); m &= m - 1ull; return t; }
template <int MODE, int KIND>
__device__ __forceinline__ void attn_run(const Frame& F, u64 tmask, const bf16_t* Kb, const bf16_t* Vb, int vstride, const bf16x8 (&qf)[2][2], AttnAcc& a, const MaskInfo& M,
                                         LAS float* impA, LAS float* impB, int qbase) {
    const int fr = F.lane & 15, fq = F.lane >> 4, lr = F.tid >> 3, lc = F.tid & 7;
    const float cexp = 0.125f * 1.4426950408889634f;
    if (tmask == 0ull) return;
    const unsigned kofs = (unsigned)(lr * 64 + lc * 8), vofs = (unsigned)(lr * vstride + lc * 8);
    const int kl = lr * KP + lc * 16, vl = lr * VP + lc * 16;
#define AT_LOAD(R, t) do { R##k = *(const u32x4*)(Kb + (kofs + (unsigned)(t) * 4096u)); if (MODE != 1) R##v = *(const u32x4*)(Vb + (vofs + (unsigned)(t) * 64u)); } while (0)
#define AT_WRITE(R, kb, vb) do { *(LAS u32x4*)(F.lds + (kb) + kl) = R##k; if (MODE != 1) *(LAS u32x4*)(F.lds + (vb) + vl) = R##v; } while (0)
#define AT_CALL(MSK, A0, A1) attn_tile<MODE, KIND, MSK, A0, A1>(F.lds + (kb_), F.lds + (vb_), qf, a, M, (t_), cexp, fr, fq, impA, impB, qbase)
#define AT_COMPUTE(kb, vb, t) do { const int kb_ = (kb), vb_ = (vb), t_ = (t); bool n0 = true, n1 = true; \
        if (KIND == 1) { n0 = __ballot(((M.selm[0] >> t_) & 1ull) != 0ull) != 0ull; n1 = __ballot(((M.selm[1] >> t_) & 1ull) != 0ull) != 0ull; } \
        if (tile_masked<KIND>(M.qb, t_)) { if (n0 || n1) AT_CALL(true, 0, 2); }                        \
        else if (KIND != 1 || (n0 && n1)) AT_CALL(false, 0, 2); \
        else if (n0) AT_CALL(false, 0, 1); \
        else if (n1) AT_CALL(false, 1, 2); } while (0)
    u32x4 R0k = {0u, 0u, 0u, 0u}, R0v = {0u, 0u, 0u, 0u}, R1k = {0u, 0u, 0u, 0u}, R1v = {0u, 0u, 0u, 0u};
    int t0 = pop_tile(tmask), t1 = pop_tile(tmask), t2 = pop_tile(tmask), t3 = pop_tile(tmask);
    AT_LOAD(R0, t0);
    if (t1 >= 0) AT_LOAD(R1, t1);
    __syncthreads();
    AT_WRITE(R0, TB_K0, TB_V0);
    if (t2 >= 0) AT_LOAD(R0, t2);
    __syncthreads();
    for (;;) {
        AT_COMPUTE(TB_K0, TB_V0, t0);
        if (t1 < 0) break;
        AT_WRITE(R1, TB_K1, TB_V1);
        if (t3 >= 0) AT_LOAD(R1, t3);
        __syncthreads();
        t0 = t1; t1 = t2; t2 = t3; t3 = pop_tile(tmask);
        AT_COMPUTE(TB_K1, TB_V1, t0);
        if (t1 < 0) break;
        AT_WRITE(R0, TB_K0, TB_V0);
        if (t3 >= 0) AT_LOAD(R0, t3);
        __syncthreads();
        t0 = t1; t1 = t2; t2 = t3; t3 = pop_tile(tmask);
    }
    if (MODE != 1) asm volatile("s_nop 15\n\ts_nop 15\n\ts_nop 15\n\ts_nop 15\n\ts_nop 15\n\ts_nop 15\n\ts_nop 15\n\ts_nop 15"
                                : "+v"(a.o[0][0]), "+v"(a.o[0][1]), "+v"(a.o[0][2]), "+v"(a.o[0][3]), "+v"(a.o[1][0]), "+v"(a.o[1][1]), "+v"(a.o[1][2]), "+v"(a.o[1][3]));
#undef AT_LOAD
#undef AT_WRITE
#undef AT_COMPUTE
#undef AT_CALL
}

__device__ __forceinline__ void nsa_item(const Frame& F, int b, int g, int qb) {
    const int fr = F.lane & 15, fq = F.lane >> 4, t0 = qb * 64, qbase = 8 * F.wave;
    LAS float* impA = (LAS float*)(F.lds + 40960); LAS float* impB = (LAS float*)(F.lds + 40960 + 16384);
    LAS u64* selL = (LAS u64*)(F.lds + 106496); LAS u64* worL = (LAS u64*)(F.lds + 106496 + 512);
    const bf16_t* Q = WSP(const bf16_t, WS_Q); const bf16_t* NG = WSP(const bf16_t, WS_NG);
    const float* ropec = WSP(const float, WS_ROPE); const float* ropes = ropec + 4096 * 32;
    int ql[2]; const int r = fr & 3, head = g * 4 + r;
    bf16x8 qf[2][2];
    MaskInfo M; M.qb = qb;
#pragma unroll
    for (int mt = 0; mt < 2; ++mt) {
        ql[mt] = qbase + ((fr + 16 * mt) >> 2); M.tq[mt] = ql[mt]; const int t = t0 + ql[mt]; M.nmax[mt] = t >= 31 ? ((t - 31) >> 4) : -1; M.selm[mt] = 0ull;
#pragma unroll
        for (int ks = 0; ks < 2; ++ks) qf[mt][ks] = *(const bf16x8*)(Q + ((size_t)(b * 4096 + t) * 512 + head * 64 + ks * 32 + fq * 8));
    }
    LAS float* ysl = (LAS float*)(F.lds + 40960) + F.tid;
    const int ntc = (4 * qb + 2) / 64 + 1; const u64 cmask = (ntc >= 64) ? ~0ull : ((1ull << ntc) - 1ull);
    const bf16_t* KCc = WSP(const bf16_t, WS_KCC) + (size_t)((b * 2 + g) * 256) * 64; const bf16_t* VCt = WSP(const bf16_t, WS_VCCT) + (size_t)((b * 2 + g) * 64) * 256;
    AttnAcc a; attn_init(a);
    attn_run<1, 0>(F, cmask, KCc, VCt, 256, qf, a, M, impA, impB, qbase);
#pragma unroll
    for (int mt = 0; mt < 2; ++mt) { float L = a.l[mt]; L = xsum16(L); L = xsum32(L); a.l[mt] = L > 0.f ? 1.0f / L : 0.f; }
    attn_run<2, 0>(F, cmask, KCc, VCt, 256, qf, a, M, impA, impB, qbase);
    __syncthreads();
    {
        u64 wor = 0ull;
        for (int qi = 0; qi < 8; ++qi) {
            const int q = qbase + qi, J = F.lane; u64 m;
            if (qb < 16) m = (2ull << qb) - 1ull;
            else {
                const float val = impA[q * 64 + J] + (J > 0 ? impB[q * 64 + (J > 0 ? J - 1 : 0)] : 0.f);
                const bool forced = (J == 0) || (J == qb) || (J == qb - 1);
                const unsigned key = (J <= qb) ? (forced ? 0x7f000000u : (val > 0.f ? __float_as_uint(val) : 0u)) : 0u;
                const u64 valid = (2ull << qb) - 1ull;
                unsigned thr = 0u;
                for (int bit = 30; bit >= 0; --bit) { const unsigned cand = thr | (1u << bit); if (__builtin_popcountll(__ballot(key >= cand) & valid) >= 16) thr = cand; }
                const u64 gt = __ballot(key > thr) & valid, eq = __ballot(key == thr) & valid; const int need = 16 - __builtin_popcountll(gt);
                const bool sel = (key > thr) || (key == thr && __builtin_popcountll(eq & ((1ull << J) - 1ull)) < need);
                m = __ballot(sel && J <= qb);
            }
            if (F.lane == 0) selL[q] = m;
            wor |= m;
        }
        if (F.lane == 0) worL[F.wave] = wor;
    }
    __syncthreads();
    u64 umask = 0ull;
#pragma unroll
    for (int w = 0; w < 8; ++w) umask |= worL[w];
    M.selm[0] = selL[ql[0]]; M.selm[1] = selL[ql[1]];
#pragma unroll
    for (int mt = 0; mt < 2; ++mt) { const float gt = sigmoidf_(bf2f(NG[(size_t)(b * 4096 + t0 + ql[mt]) * 32 + head * 3 + 0]));
#pragma unroll
        for (int dt = 0; dt < 4; ++dt)
#pragma unroll
            for (int r4 = 0; r4 < 4; ++r4) ysl[((mt * 4 + dt) * 4 + r4) * 512] = a.o[mt][dt][r4] * gt; }
#pragma unroll
    for (int mt = 0; mt < 2; ++mt) {
        const int t = t0 + ql[mt]; const f32x4 c0 = *(const f32x4*)(ropec + t * 32 + 8 * fq), c1 = *(const f32x4*)(ropec + t * 32 + 8 * fq + 4), s0 = *(const f32x4*)(ropes + t * 32 + 8 * fq), s1 = *(const f32x4*)(ropes + t * 32 + 8 * fq + 4);
        bf16x8 r1, r2;
#pragma unroll
        for (int j = 0; j < 8; ++j) { const float x1 = bf2f((bf16_t)qf[mt][0][j]), x2 = bf2f((bf16_t)qf[mt][1][j]); const float cs = j < 4 ? c0[j & 3] : c1[j & 3], sn = j < 4 ? s0[j & 3] : s1[j & 3];
            r1[j] = (short)f2bf(x1 * cs - x2 * sn); r2[j] = (short)f2bf(x1 * sn + x2 * cs); }
        qf[mt][0] = r1; qf[mt][1] = r2;
    }
    const size_t kvoff = (size_t)((b * 2 + g) * 4096) * 64, vtoff = (size_t)((b * 2 + g) * 64) * 4096;
    attn_init(a);
    attn_run<0, 1>(F, umask, WSP(const bf16_t, WS_KS) + kvoff, WSP(const bf16_t, WS_VST) + vtoff, 4096, qf, a, M, impA, impB, qbase);
#pragma unroll
    for (int mt = 0; mt < 2; ++mt) { float L = a.l[mt]; L = xsum16(L); L = xsum32(L);
        const float sc = (L > 0.f ? 1.0f / L : 0.f) * sigmoidf_(bf2f(NG[(size_t)(b * 4096 + t0 + ql[mt]) * 32 + head * 3 + 1]));
#pragma unroll
        for (int dt = 0; dt < 4; ++dt)
#pragma unroll
            for (int r4 = 0; r4 < 4; ++r4) ysl[((mt * 4 + dt) * 4 + r4) * 512] += a.o[mt][dt][r4] * sc; }
    const int wlo = qb >= 8 ? qb - 8 : 0; const u64 wmask = ((2ull << qb) - 1ull) & ~((1ull << wlo) - 1ull);
    attn_init(a);
    attn_run<0, 2>(F, wmask, WSP(const bf16_t, WS_KW) + kvoff, WSP(const bf16_t, WS_VWT) + vtoff, 4096, qf, a, M, impA, impB, qbase);
#pragma unroll
    for (int mt = 0; mt < 2; ++mt) { float L = a.l[mt]; L = xsum16(L); L = xsum32(L);
        const float sc = (L > 0.f ? 1.0f / L : 0.f) * sigmoidf_(bf2f(NG[(size_t)(b * 4096 + t0 + ql[mt]) * 32 + head * 3 + 2]));
#pragma unroll
        for (int dt = 0; dt < 4; ++dt)
#pragma unroll
            for (int r4 = 0; r4 < 4; ++r4) a.o[mt][dt][r4] = ysl[((mt * 4 + dt) * 4 + r4) * 512] + a.o[mt][dt][r4] * sc; }
    bf16_t* Y = WSP(bf16_t, WS_YCAT);
#pragma unroll
    for (int mt = 0; mt < 2; ++mt)
#pragma unroll
        for (int dt = 0; dt < 4; ++dt) *(u32x2*)(Y + ((size_t)(b * 4096 + t0 + ql[mt]) * 1024 + head * 64 + 16 * dt + 4 * fq)) = pg8::cvt4_bf16(a.o[mt][dt]);
    __syncthreads();
}

__device__ __forceinline__ void xa_item(const Frame& F, int item) {
    const int b = item >> 6, head = (item >> 4) & 3, qt = item & 15, fr = F.lane & 15, fq = F.lane >> 4, t0 = qt * 256 + 32 * F.wave;
    const bf16_t* QX = WSP(const bf16_t, WS_QX);
    bf16x8 qf[2][2];
#pragma unroll
    for (int mt = 0; mt < 2; ++mt)
#pragma unroll
        for (int ks = 0; ks < 2; ++ks) qf[mt][ks] = *(const bf16x8*)(QX + ((size_t)(b * 4096 + t0 + fr + 16 * mt) * 256 + head * 64 + ks * 32 + fq * 8));
    MaskInfo M; M.qb = 0; M.tq[0] = M.tq[1] = 0; M.nmax[0] = M.nmax[1] = 0; M.selm[0] = M.selm[1] = 0ull;
    AttnAcc a; attn_init(a);
    attn_run<0, 3>(F, 0xFull, WSP(const bf16_t, WS_KX) + (size_t)((b * 4 + head) * 256) * 64, WSP(const bf16_t, WS_VXT) + (size_t)((b * 4 + head) * 64) * 256, 256, qf, a, M, nullptr, nullptr, 0);
    bf16_t* O = WSP(bf16_t, WS_XAO);
#pragma unroll
    for (int mt = 0; mt < 2; ++mt) { float L = a.l[mt]; L = xsum16(L); L = xsum32(L); const float sc = L > 0.f ? 1.0f / L : 0.f;
#pragma unroll
        for (int dt = 0; dt < 4; ++dt) *(u32x2*)(O + ((size_t)(b * 4096 + t0 + fr + 16 * mt) * 256 + head * 64 + 16 * dt + 4 * fq)) = pg8::cvt4_bf16(a.o[mt][dt] * sc); }
    __syncthreads();
}

template <class Fn> __device__ __forceinline__ void run_gemm(const Frame& F, const bf16_t* A, const bf16_t* Bt, int M, int N, int K, int G, int c, const Fn& fn) {
    pg8::Gemm g{A, Bt, M, N, K}; pg8::StaticOrder S; S.init(M, N, G, c); Epi8<Fn> E{fn};
    pg8::gemm_phase<Epi8<Fn>, pg8::StaticOrder>((PG8_LAS unsigned char*)F.lds, g, S, E, F.tid);
}

__global__ void __launch_bounds__(NTHR, 2) trunk_fwd(Params prm) {
    extern __shared__ __attribute__((aligned(16))) unsigned char lds_raw[];
    Frame F0; F0.kp = (const __attribute__((address_space(4))) char*)__builtin_amdgcn_kernarg_segment_ptr(); F0.ws = prm.ws; F0.lds = (LAS unsigned char*)lds_raw;
    F0.tid = threadIdx.x; F0.lane = F0.tid & 63; F0.wave = __builtin_amdgcn_readfirstlane(F0.tid >> 6); F0.bid = blockIdx.x; F0.G = gridDim.x;
    const int lo = prm.ph_lo, hi = prm.ph_hi;
    if (F0.tid < 8) ((LAS unsigned*)(F0.lds + LDS_CTL_OFF))[F0.tid] = 0u;
    __syncthreads();
    XcdBarrier bar; bar.bar = F0.ctl(); bar.x = 0; bar.st = nullptr;
    if (hi - lo > 1) bar = xcd_barrier_post(F0.ctl(), (volatile LAS unsigned*)(F0.lds + LDS_CTL_OFF));
#define IN(k) (lo <= (k) && (k) < hi)
#define SEAM(k) do { if (IN(k) && IN((k) + 1)) xcd_barrier(bar); } while (0)
#define PHASE_FRAME Frame F = F0; LAUNDER(F); asm volatile("" : "+v"(F.tid), "+s"(F.bid), "+s"(F.G), "+s"(F.wave)); F.lane = F.tid & 63
    if (PON(0) && IN(0)) {
        PHASE_FRAME;
        float* rc = WSP(float, WS_ROPE); float* rs = rc + 4096 * 32;
        for (int i = F.bid * NTHR + F.tid; i < 4096 * 32; i += F.G * NTHR) { const int t = i >> 5, j = i & 31; const float inv = 1.0f / powf(10000.0f, (float)j / 32.0f); const float ang = (float)t * inv;
            float sn, cs; sincosf(ang, &sn, &cs); rc[i] = cs; rs[i] = sn; }
        conv_layer(F, 0);
        norm_rows(F, TOK, F.in(0), nullptr, nullptr, nullptr, F.x16(), nullptr, nullptr, F.in(2), WSP(bf16_t, WS_H));
    }
    SEAM(0);
    for (int l = 0; l < DEPTH; ++l) {
        const int g0 = 1 + l * PH_PER_LAYER;
        if (PON(1) && IN(g0 + 0)) for (int rep = 0; rep < REPS[1]; ++rep) {
            PHASE_FRAME;
            FIn1 fn{WSP(bf16_t, WS_Q), WSP(bf16_t, WS_KC), WSP(bf16_t, WS_VC), WSP(bf16_t, WS_KS), WSP(bf16_t, WS_KW), WSP(bf16_t, WS_VST), WSP(bf16_t, WS_VWT), WSP(bf16_t, WS_ZR), WSP(bf16_t, WS_ZS), WSP(bf16_t, WS_NG),
                    WSP(const float, WS_ROPE), WSP(const float, WS_ROPE) + 4096 * 32};
            run_gemm(F, WSP(const bf16_t, WS_H), WSP(const bf16_t, W_IN1), TOK, 2816, 1024, F.G, F.bid, fn);
        }
        SEAM(g0 + 0);
        if (PON(2) && IN(g0 + 1)) for (int rep = 0; rep < REPS[2]; ++rep) {
            { PHASE_FRAME;
              if (F.bid < 32) run_gemm(F, WSP(const bf16_t, WS_KC), WSP(const bf16_t, W_C1K), 4096, 512, 1024, 32, F.bid, FStore{WSP(bf16_t, WS_PQ), 512});
              else if (F.bid < 64) run_gemm(F, WSP(const bf16_t, WS_VC), WSP(const bf16_t, W_C1V), 4096, 512, 1024, 32, F.bid - 32, FStore{WSP(bf16_t, WS_PQ + 4 * MiB), 512});
              else if (F.bid < 128) cmp_bias(F, l, F.bid - 64); }
            for (;;) {
                PHASE_FRAME;
                const int job = next_job(F, F.ctl() + CTL_Q0 + 64 * ((l * 4 + 0) * 4 + rep));
                if (job >= 256 + 512) break;
                if (job < 256) s5_pass1(F, l, job * 8 + F.wave);
                else rwkv_lin_tile(F, l, job - 256);
            }
        }
        SEAM(g0 + 1);
        if (PON(3) && IN(g0 + 2)) for (int rep = 0; rep < REPS[3]; ++rep) {
            { PHASE_FRAME; run_gemm(F, WSP(const bf16_t, WS_LIN), WSP(const bf16_t, W_LORA), TOK, 768, 256, F.G, F.bid, FLora{WSP(bf16_t, WS_LW), WSP(bf16_t, WS_LA), WSP(bf16_t, WS_RG)}); }
            { PHASE_FRAME; cmp_finalize(F, l); }
        }
        SEAM(g0 + 2);
        if (PON(4) && IN(g0 + 3)) for (int rep = 0; rep < REPS[4]; ++rep) { PHASE_FRAME; __syncthreads(); for (int it = F.bid * 8 + F.wave; it < 32 * 256; it += F.G * 8) rwkv_chunk_prep(F, l, it); }
        SEAM(g0 + 3);
        if (PON(5) && IN(g0 + 4)) for (int rep = 0; rep < REPS[5]; ++rep) {
#if !defined(SUB) || SUB == 1
            if (F0.bid < 32) for (int ra = 0; ra < REP_P4A; ++ra) { PHASE_FRAME; rwkv_chunk_scan(F, F.bid); }
#endif
            for (int rq = 0; rq < REP_P4B; ++rq)
            for (;;) {
                PHASE_FRAME;
                const int job = next_job(F, F.ctl() + CTL_Q0 + 64 * ((l * 4 + 1) * 4 + rep * 2 + rq));
                if (job >= 1024 + 256) break;
#if !defined(SUB) || SUB == 2
                if (job < 1024) { const int qb = 63 - (job >> 4), bg = job & 15; for (int rr = 0; rr < REP_NSA; ++rr) nsa_item(F, bg >> 1, bg & 1, qb); }
#endif
#if !defined(SUB) || SUB == 3
                if (job >= 1024) { __syncthreads(); for (int rr = 0; rr < REP_S5P2; ++rr) s5_pass2(F, l, (job - 1024) * 8 + F.wave); }
#endif
            }
        }
        SEAM(g0 + 4);
        if (PON(6) && IN(g0 + 5)) for (int rep = 0; rep < REPS[6]; ++rep) {
#if !defined(SUB) || SUB == 1
            if (F0.bid < 128) { PHASE_FRAME; run_gemm(F, WSP(const bf16_t, WS_YS5G), WSP(const bf16_t, W_GLU), TOK, 256, 256, 128, F.bid, FGluMul{WSP(const bf16_t, WS_YS5G), WSP(bf16_t, WS_YCAT) + 768, 256, 1024}); }
#endif
#if !defined(SUB) || SUB == 2
            { PHASE_FRAME; rwkv_post(F, l); }
#endif
        }
        SEAM(g0 + 5);
        if (PON(7) && IN(g0 + 6)) for (int rep = 0; rep < REPS[7]; ++rep) {
            { PHASE_FRAME; run_gemm(F, WSP(const bf16_t, WS_H), WSP(const bf16_t, W_MG), TOK, 3072, 1024, F.G, F.bid, FSigmoid{WSP(bf16_t, WS_G), 3072}); }
        }
        SEAM(g0 + 6);
        if (PON(8) && IN(g0 + 7)) for (int rep = 0; rep < REPS[8]; ++rep) {
            { PHASE_FRAME;
              pg8::Gemm g{WSP(const bf16_t, WS_YCAT), WSP(const bf16_t, W_UPN), TOK, 1024, 1024}; pg8::StaticOrder S; S.init(TOK, 1024, F.G, F.bid);
              Epi8<FMulStore> E{FMulStore{WSP(const bf16_t, WS_G), WSP(bf16_t, WS_MERGED)}};
              MergeHook H{WSP(const bf16_t, WS_G)};
              pg8::gemm_phase<Epi8<FMulStore>, pg8::StaticOrder, MergeHook>((PG8_LAS unsigned char*)F.lds, g, S, E, F.tid, H); }
        }
        SEAM(g0 + 7);
        if (PON(9) && IN(g0 + 8)) for (int rep = 0; rep < REPS[9]; ++rep) { PHASE_FRAME; run_gemm(F, WSP(const bf16_t, WS_MERGED), WSP(const bf16_t, W_OUT), TOK, 1024, 1024, F.G, F.bid, FStore{WSP(bf16_t, WS_YOUT), 1024}); }
        SEAM(g0 + 8);
        if (PON(10) && IN(g0 + 9)) {
            PHASE_FRAME; const float* gains = F.in(2) + (size_t)l * 6 * 1024;
            norm_rows(F, TOK, nullptr, F.x16(), WSP(const bf16_t, WS_YOUT), gains + 1024, F.x16(), nullptr, nullptr, gains + 2048, WSP(bf16_t, WS_H));
            norm_rows(F, NB * 256, F.in(1), nullptr, nullptr, nullptr, nullptr, nullptr, nullptr, F.in(3) + (size_t)l * 1024, WSP(bf16_t, WS_MEMN));
        }
        SEAM(g0 + 9);
        if (PON(11) && IN(g0 + 10)) for (int rep = 0; rep < REPS[11]; ++rep) {
            PHASE_FRAME;
            if (F.bid < 128) run_gemm(F, WSP(const bf16_t, WS_H), WSP(const bf16_t, W_XQ), TOK, 256, 1024, 128, F.bid, FStore{WSP(bf16_t, WS_QX), 256});
            else if (F.bid < 144) run_gemm(F, WSP(const bf16_t, WS_MEMN), WSP(const bf16_t, W_XKV), NB * 256, 512, 1024, 16, F.bid - 128, FXKV{WSP(bf16_t, WS_KX), WSP(bf16_t, WS_VXT)});
        }
        SEAM(g0 + 10);
        if (PON(12) && IN(g0 + 11)) for (int rep = 0; rep < REPS[12]; ++rep) { PHASE_FRAME; for (int it = F.bid; it < 512; it += F.G) xa_item(F, it); }
        SEAM(g0 + 11);
        if (PON(13) && IN(g0 + 12)) for (int rep = 0; rep < REPS[13]; ++rep) { PHASE_FRAME; run_gemm(F, WSP(const bf16_t, WS_XAO), WSP(const bf16_t, W_XO), TOK, 1024, 256, F.G, F.bid, FStore{WSP(bf16_t, WS_YOUT), 1024}); }
        SEAM(g0 + 12);
        if (PON(14) && IN(g0 + 13)) { PHASE_FRAME; const float* gains = F.in(2) + (size_t)l * 6 * 1024;
            norm_rows(F, TOK, nullptr, F.x16(), WSP(const bf16_t, WS_YOUT), gains + 3 * 1024, l + 1 < DEPTH ? F.x16() : WSP(bf16_t, WS_XLAST), nullptr, nullptr, gains + 4 * 1024, WSP(bf16_t, WS_H)); }
        SEAM(g0 + 13);
        if (PON(15) && IN(g0 + 14)) for (int rep = 0; rep < REPS[15]; ++rep) { PHASE_FRAME; run_gemm(F, WSP(const bf16_t, WS_H), WSP(const bf16_t, W_GU), TOK, 2 * DFF, 1024, F.G, F.bid, FSwiGLU{WSP(bf16_t, WS_A2), DFF}); }
        SEAM(g0 + 14);
        if (PON(16) && IN(g0 + 15)) for (int rep = 0; rep < REPS[16]; ++rep) { PHASE_FRAME; run_gemm(F, WSP(const bf16_t, WS_A2), WSP(const bf16_t, W_DN), TOK, 1024, DFF, F.G, F.bid, FStore{WSP(bf16_t, WS_YOUT), 1024}); }
        SEAM(g0 + 15);
        if (PON(17) && IN(g0 + 16)) {
            PHASE_FRAME; const float* gains = F.in(2) + (size_t)l * 6 * 1024;
            for (int rep = 1; rep < REPS[17]; ++rep) conv_layer(F, l);
            if (l + 1 < DEPTH) { norm_rows(F, TOK, nullptr, F.x16(), WSP(const bf16_t, WS_YOUT), gains + 5 * 1024, F.x16(), nullptr, nullptr, gains + 6 * 1024, WSP(bf16_t, WS_H)); conv_layer(F, l + 1); }
            else norm_rows(F, TOK, nullptr, WSP(const bf16_t, WS_XLAST), WSP(const bf16_t, WS_YOUT), gains + 5 * 1024, nullptr, F.out(), F.out() + (size_t)TOK * DM / 2, nullptr, nullptr);
        }
        SEAM(g0 + 16);
    }
#undef IN
#undef SEAM
}

extern "C" void kernel_launch(void* const* d_in, const int* in_sizes, int n_in, void* d_out, int out_size, void* d_ws, size_t ws_size, hipStream_t stream) {
    static int grid = 0;
    if (grid == 0) {
        if (n_in != 42 || out_size != TOK * DM || ws_size < WS_END) { fprintf(stderr, "kernel_launch: unexpected shapes (n_in %d out %d ws %zu)\n", n_in, out_size, ws_size); grid = -1; return; }
        int dev = 0, cus = 0, per_cu = 0;
        if (hipGetDevice(&dev) != hipSuccess || hipDeviceGetAttribute(&cus, hipDeviceAttributeMultiprocessorCount, dev) != hipSuccess) { grid = -1; return; }
        if (hipFuncSetAttribute((const void*)trunk_fwd, hipFuncAttributeMaxDynamicSharedMemorySize, LDS_BYTES) != hipSuccess) { fprintf(stderr, "kernel_launch: hipFuncSetAttribute failed\n"); grid = -1; return; }
        if (hipOccupancyMaxActiveBlocksPerMultiprocessor(&per_cu, (const void*)trunk_fwd, NTHR, LDS_BYTES) != hipSuccess || per_cu < 1) fprintf(stderr, "kernel_launch: occupancy query reports %d\n", per_cu);
        (void)hipGetLastError();
        grid = cus;
    }
    if (grid < 0) return;
    (void)hipMemsetAsync((char*)d_ws + WS_CTL, 0, CTL_BYTES, stream);
    Params p{};
    for (int i = 0; i < 42; ++i) p.in[i] = (const float*)d_in[i];
    p.out = (float*)d_out; p.ws = (unsigned char*)d_ws;
#if MK_N_LAUNCHES == 1
    p.ph_lo = 0; p.ph_hi = N_PHASES;
    hipLaunchKernelGGL(trunk_fwd, dim3(grid), dim3(NTHR), LDS_BYTES, stream, p);
#else
    for (int ph = 0; ph < N_PHASES; ++ph) { p.ph_lo = ph; p.ph_hi = ph + 1; hipLaunchKernelGGL(trunk_fwd, dim3(grid), dim3(NTHR), LDS_BYTES, stream, p); }
#endif
}
```

```cpp
#include <hip/hip_runtime.h>
#include <stdint.h>
#include <cstdio>

#ifndef MK_N_LAUNCHES
#define MK_N_LAUNCHES 1
#endif

#ifndef ONLY_PHASE
#define ONLY_PHASE -1
#endif
#define PON(k) (ONLY_PHASE < 0 || ONLY_PHASE == (k))
#define LAS __attribute__((address_space(3)))
typedef unsigned short bf16_t;
typedef short bf16x8 __attribute__((ext_vector_type(8)));
typedef short bf16x4 __attribute__((ext_vector_type(4)));
typedef float f32x4 __attribute__((ext_vector_type(4)));
typedef float f32x2 __attribute__((ext_vector_type(2)));
typedef unsigned u32x4 __attribute__((ext_vector_type(4)));
typedef unsigned u32x2 __attribute__((ext_vector_type(2)));
typedef unsigned long long u64;

constexpr int NB = 8, SEQ = 4096, DM = 1024, TOK = NB * SEQ, DEPTH = 4;
constexpr int INW = 5656, DFF = 2816;
constexpr int NTHR = 512;
constexpr int PH_PER_LAYER = 17, N_PHASES = 1 + DEPTH * PH_PER_LAYER;
constexpr int REPS[18] = {1, 1, 1, 1, 1, 1, 1, 1, 1, 1, 1, 1, 1, 1, 1, 1, 1, 1};
constexpr int REP_P4A = 1, REP_P4B = 1;
#define PROBE_EXP2X 0
#define PROBE_MFMA2X 0
constexpr int REP_NSA = 1, REP_S5P2 = 1, REP_PREP = 1, REP_S5P1 = 1, REP_CMPG = 1;

constexpr size_t MiB = 1ull << 20;
constexpr size_t WS_CTL = 0;
constexpr size_t CTL_BYTES = 32768;
constexpr size_t WS_ROPE = 1 * MiB;
constexpr size_t WS_MISC = 2 * MiB;
constexpr size_t WS_KCC = WS_MISC;
constexpr size_t WS_VCCT = WS_MISC + 512 * 1024;
constexpr size_t WS_XEND = WS_MISC + 1 * MiB;
constexpr size_t WS_KX = WS_MISC + 2 * MiB;
constexpr size_t WS_VXT = WS_MISC + 3 * MiB;
constexpr size_t WS_MEMN = WS_MISC + 4 * MiB;
constexpr size_t WS_BONUS = WS_MISC + 8 * MiB;
constexpr size_t WS_CBIAS = WS_MISC + 9 * MiB;
constexpr size_t WS_W = 18 * MiB;
constexpr size_t W_IN1 = WS_W + 0, W_MG = WS_W + 6 * MiB, W_UPN = WS_W + 12 * MiB, W_UPR = WS_W + 13 * MiB, W_UPS = WS_W + 13 * MiB + 512 * 1024,
                 W_OUT = WS_W + 14 * MiB, W_C1K = WS_W + 16 * MiB, W_C1V = WS_W + 17 * MiB, W_XQ = WS_W + 18 * MiB, W_XKV = WS_W + 19 * MiB,
                 W_XO = WS_W + 20 * MiB, W_GLU = WS_W + 21 * MiB, W_LORA = WS_W + 21 * MiB + 512 * 1024, W_GU = WS_W + 22 * MiB, W_DN = WS_W + 33 * MiB;
constexpr size_t WS_H = 58 * MiB;
constexpr size_t WS_Q = 122 * MiB, WS_KC = 154 * MiB, WS_VC = 162 * MiB, WS_KS = 170 * MiB, WS_KW = 178 * MiB, WS_YS5 = 186 * MiB,
                 WS_VST = 202 * MiB, WS_VWT = 210 * MiB, WS_NG = 218 * MiB, WS_ZR = 220 * MiB, WS_ZS = 284 * MiB,
                 WS_YSCAN = 300 * MiB, WS_YS5G = 332 * MiB, WS_LIN = 364 * MiB, WS_RG = 380 * MiB, WS_LW = 396 * MiB, WS_LA = 412 * MiB,
                 WS_PQ = 428 * MiB, WS_END = 508 * MiB;
constexpr size_t WS_CS_AR = 476 * MiB, WS_CS_BKT = 348 * MiB, WS_CS_VMT = 154 * MiB, WS_CS_AAK = 186 * MiB, WS_CS_ARBK = 190 * MiB, WS_CS_GAM = 198 * MiB, WS_CS_MM = 428 * MiB;
constexpr size_t WS_XLAST = 300 * MiB;
constexpr size_t WS_YCAT = 220 * MiB;
constexpr size_t WS_G = 284 * MiB  , WS_MERGED = 122 * MiB, WS_YOUT = 364 * MiB;
constexpr size_t WS_QX = 122 * MiB, WS_XAO = 138 * MiB, WS_A2 = 122 * MiB;
constexpr int CTL_Q0 = 4096;

constexpr int LDS_STAGE = 131072;
constexpr int LDS_CTL_OFF = LDS_STAGE;
constexpr int LDS_BYTES = LDS_STAGE + 256;

struct Params { const float* in[42]; float* out; unsigned char* ws; int ph_lo, ph_hi; };

__device__ __forceinline__ float bf2f(bf16_t b) { return __uint_as_float(((unsigned)b) << 16); }
__device__ __forceinline__ float bflo(unsigned w) { return __uint_as_float(w << 16); }
__device__ __forceinline__ float bfhi(unsigned w) { return __uint_as_float(w & 0xffff0000u); }
__device__ __forceinline__ bf16_t f2bf(float f) { unsigned u = __float_as_uint(f); u += 0x7FFFu + ((u >> 16) & 1u); return (bf16_t)(u >> 16); }
__device__ __forceinline__ unsigned pk2(float lo, float hi) { return (unsigned)f2bf(lo) | ((unsigned)f2bf(hi) << 16); }
__device__ __forceinline__ float sigmoidf_(float x) { return __builtin_amdgcn_rcpf(1.0f + __expf(-x)); }
__device__ __forceinline__ float gelu_tanh(float x) { const float u = 0.7978845608028654f * (x + 0.044715f * x * x * x); return 0.5f * x * (1.0f + tanhf(u)); }
template <int CTRL> __device__ __forceinline__ float dpp_mov(float x) { return __int_as_float(__builtin_amdgcn_update_dpp(0, __float_as_int(x), CTRL, 0xF, 0xF, false)); }
__device__ __forceinline__ float quad_sum(float x) { x += dpp_mov<0xB1>(x); x += dpp_mov<0x4E>(x); return x; }
__device__ __forceinline__ float row16_sum(float x) { x = quad_sum(x); x += dpp_mov<0x141>(x); x += dpp_mov<0x140>(x); return x; }

__device__ __forceinline__ float xmax16(float x) { const unsigned u = __float_as_uint(x); auto r = __builtin_amdgcn_permlane16_swap(u, u, false, false); return fmaxf(__uint_as_float(r[0]), __uint_as_float(r[1])); }
__device__ __forceinline__ float xmax32(float x) { const unsigned u = __float_as_uint(x); auto r = __builtin_amdgcn_permlane32_swap(u, u, false, false); return fmaxf(__uint_as_float(r[0]), __uint_as_float(r[1])); }
__device__ __forceinline__ float xsum16(float x) { const unsigned u = __float_as_uint(x); auto r = __builtin_amdgcn_permlane16_swap(u, u, false, false); return __uint_as_float(r[0]) + __uint_as_float(r[1]); }
__device__ __forceinline__ float xsum32(float x) { const unsigned u = __float_as_uint(x); auto r = __builtin_amdgcn_permlane32_swap(u, u, false, false); return __uint_as_float(r[0]) + __uint_as_float(r[1]); }

__device__ __forceinline__ float wave_sum(float v) { v = row16_sum(v); v = xsum16(v); return xsum32(v); }

#define XB_TMO      128
#define XB_XCNT(j)  (256  + 64 * (j))
#define XB_XSUB(j)  (1280 + 64 * (j))
#define XB_XGEN(j)  (2304 + 64 * (j))
#define XB_TOP      3328
#define XB_TOPGEN   3392
#define XCD_BAR_WORDS 3456
#define XB_SPIN_CAP (1u << 18)
__device__ __forceinline__ unsigned xb_ld(unsigned* p)              { return __hip_atomic_load(p, __ATOMIC_RELAXED, __HIP_MEMORY_SCOPE_AGENT); }
__device__ __forceinline__ unsigned xb_add(unsigned* p, unsigned v) { return __hip_atomic_fetch_add(p, v, __ATOMIC_RELAXED, __HIP_MEMORY_SCOPE_AGENT); }
__device__ __forceinline__ unsigned xb_xcc_id() { return (unsigned)__builtin_amdgcn_s_getreg((3 << 11) | 20) & 0xFu; }
#define XB_SPIN(cond, bar) do { unsigned _sp = 0; while (cond) { __builtin_amdgcn_s_sleep(1); \
    if ((++_sp & 255u) == 0u) { if (xb_ld(&(bar)[XB_TMO])) break; if (_sp > XB_SPIN_CAP) { atomicAdd(&(bar)[XB_TMO], 1u); break; } } } } while (0)
struct XcdBarrier { unsigned* bar; unsigned x; volatile LAS unsigned* st; };
__device__ __forceinline__ XcdBarrier xcd_barrier_post(unsigned* bar, volatile LAS unsigned* st) {
    XcdBarrier b; b.bar = bar; b.x = xb_xcc_id(); b.st = st;
    if (threadIdx.x == 0) (void)xb_add(&bar[XB_XCNT(b.x)], 1u);
    return b;
}
__device__ __forceinline__ void xcd_barrier_complete(unsigned* bar, unsigned x, unsigned& nloc, unsigned& nx) {
    const unsigned G = gridDim.x * gridDim.y * gridDim.z;
    unsigned sum, cnt, mine, sp = 0u;
    for (;;) {
        sum = 0u; cnt = 0u; mine = 0u;
#pragma unroll
        for (unsigned j = 0; j < 16; ++j) { const unsigned c = xb_ld(&bar[XB_XCNT(j)]); sum += c; cnt += (c > 0u) ? 1u : 0u; mine = (j == x) ? c : mine; }
        if (sum == G) break;
        __builtin_amdgcn_s_sleep(1);
        if ((++sp & 255u) == 0u) { if (xb_ld(&bar[XB_TMO])) break; if (sp > XB_SPIN_CAP) { atomicAdd(&bar[XB_TMO], 1u); break; } }
    }
    nloc = mine > 0u ? mine : 1u; nx = cnt > 0u ? cnt : 1u;
}
__device__ __forceinline__ void xcd_barrier(const XcdBarrier& b) {
    asm volatile("s_waitcnt vmcnt(0)" ::: "memory");
    __syncthreads();
    if (threadIdx.x == 0) {
        unsigned* bar = b.bar;
        __builtin_amdgcn_s_waitcnt(0);
        unsigned nloc = b.st[0], nx = b.st[1];
        if (nloc == 0u) { xcd_barrier_complete(bar, b.x, nloc, nx); b.st[0] = nloc; b.st[1] = nx; }
        const unsigned old = xb_add(&bar[XB_XSUB(b.x)], 1u);
        const unsigned gen = old / nloc;
        if (old + 1u == (gen + 1u) * nloc) {
            __builtin_amdgcn_fence(__ATOMIC_RELEASE, "agent");
            asm volatile("s_waitcnt vmcnt(0)" ::: "memory");
            const unsigned og = xb_add(&bar[XB_TOP], 1u);
            const unsigned tg = og / nx;
            if (og + 1u == (tg + 1u) * nx) xb_add(&bar[XB_TOPGEN], 1u);
            else XB_SPIN(xb_ld(&bar[XB_TOPGEN]) == tg, bar);
            __builtin_amdgcn_fence(__ATOMIC_ACQUIRE, "agent");
            xb_add(&bar[XB_XGEN(b.x)], 1u);
            asm volatile("s_waitcnt vmcnt(0)" ::: "memory");
        } else {
            XB_SPIN(xb_ld(&bar[XB_XGEN(b.x)]) == gen, bar);
            __builtin_amdgcn_fence(__ATOMIC_ACQUIRE, "agent");
            asm volatile("s_waitcnt vmcnt(0)" ::: "memory");
        }
    }
    __syncthreads();
}

namespace pg8 {
#define PG8_LAS __attribute__((address_space(3)))
constexpr int BM = 256, BK = 64, HALF = 128, HTB = HALF * BK * 2, STAGE_BYTES = 8 * HTB, NXCD = 8, WGM = 8;
__host__ __device__ __forceinline__ int lds_byte(int r, int c) { const int st = (r >> 4) * 2 + (c >> 5), rr = r & 15, cc = c & 31, ob = rr * 64 + cc * 2; return st * 1024 + (ob ^ (((ob >> 9) & 1) << 5)); }
__host__ __device__ __forceinline__ void stage_rc(int b, int& R, int& C) { const int st = b / 1024, sb = b % 1024, swz = sb ^ (((sb >> 9) & 1) << 5); R = (st >> 1) * 16 + swz / 64; C = (st & 1) * 32 + (swz % 64) / 2; }
__host__ __device__ __forceinline__ int perm32(int rho) { const int n = rho >> 4, i = rho & 15; return 8 * (i >> 2) + 4 * n + (i & 3); }
struct Unit { int pm, pn; };
struct Gemm { const bf16_t* A; const bf16_t* Bt; int M, N, K; };
struct StaticOrder {
    int nM, nN, nwg, G, c;
    __host__ __device__ void init(int M, int N, int G_, int c_) { nM = M / BM; nN = N / BM; nwg = nM * nN; G = G_; c = c_; }
    __host__ __device__ bool next(int i, Unit& u) const {
        const long L = (long)i * G + c; if (L >= nwg) return false;
        int wgid = (int)L; { const int q = nwg / NXCD, r = nwg % NXCD, xcd = wgid % NXCD, off = wgid / NXCD; wgid = (xcd < r ? xcd * (q + 1) : r * (q + 1) + (xcd - r) * q) + off; }
        const int nig = WGM * nN, gid = wgid / nig, fm = gid * WGM, gsz = (nM - fm) < WGM ? (nM - fm) : WGM;
        u.pm = fm + ((wgid % nig) % gsz); u.pn = (wgid % nig) / gsz; return true;
    }
    __device__ __forceinline__ void a_ready(const Unit&) const {}
    __device__ __forceinline__ void done(const Unit&) const {}
};
typedef __bf16 bf16v2_t __attribute__((ext_vector_type(2)));
typedef float f32x2_t __attribute__((ext_vector_type(2)));
typedef __bf16 bf16v4_t __attribute__((ext_vector_type(4)));
typedef __bf16 bf16v8_t __attribute__((ext_vector_type(8)));
typedef float f32x8_t __attribute__((ext_vector_type(8)));
typedef unsigned u32x2_t __attribute__((ext_vector_type(2)));
__device__ __forceinline__ unsigned cvt_pk_bf16(float lo, float hi) { const f32x2_t f = {lo, hi}; return __builtin_bit_cast(unsigned, __builtin_convertvector(f, bf16v2_t)); }
__device__ __forceinline__ u32x2_t cvt4_bf16(const f32x4 a) { return __builtin_bit_cast(u32x2_t, __builtin_convertvector(a, bf16v4_t)); }
__device__ __forceinline__ bf16x8 cvt8_bf16(const f32x4 a, const f32x4 b) { const f32x8_t f = __builtin_shufflevector(a, b, 0, 1, 2, 3, 4, 5, 6, 7); return __builtin_bit_cast(bf16x8, __builtin_convertvector(f, bf16v8_t)); }

struct NoHook { static constexpr bool ACTIVE = false; __device__ __forceinline__ void operator()(f32x4 (&)[2][2][4][2], const Unit&, int, int, int, int, int) const {} };
template <class Epi, class Sched, class Hook = NoHook>
__device__ __forceinline__ void gemm_phase(PG8_LAS unsigned char* lds, const Gemm g, const Sched& S, const Epi& E, const int tid, const Hook& H = Hook()) {
    const int wid = __builtin_amdgcn_readfirstlane(tid >> 6), lane = tid & 63, wr = wid >> 2, wc = wid & 3, fr = lane & 15, fq = lane >> 4;
    const int K = g.K, nt = K / BK;
    unsigned voffA[2], voffB[2];
#pragma unroll
    for (int i = 0; i < 2; ++i) { int R, C; stage_rc(tid * 16 + i * 8192, R, C); const int Rb = Epi::PERM ? ((R & ~31) + perm32(R & 31)) : R;
        voffA[i] = (unsigned)(R * K + C) * 2u; voffB[i] = (unsigned)(Rb * K + C) * 2u; }
    const size_t kstep = (size_t)(BK * 2);
    const size_t hstep = (size_t)HALF * K * 2;
    const size_t tstep = 2 * hstep;
    const unsigned ldsw = (unsigned)wid * 1024u;
    const int aoff = lds_byte(wr * 64 + fr, fq * 8), boff = lds_byte(wc * 32 + fr, fq * 8);
#define PG8_SA(b, h) (((b) * 2 + (h)) * HTB)
#define PG8_SB(b, h) ((4 + (b) * 2 + (h)) * HTB)
#define PG8_STAGE(bufoff, gbase, voff) do { _Pragma("unroll") for (int _i = 0; _i < 2; ++_i) \
        __builtin_amdgcn_global_load_lds((const unsigned*)((const char*)(gbase) + (voff)[_i]), (PG8_LAS unsigned*)(lds + (bufoff) + ldsw + _i * 8192), 16, 0, 0); } while (0)
#define PG8_LDA(dst, b, h) do { _Pragma("unroll") for (int m = 0; m < 4; ++m) _Pragma("unroll") for (int k = 0; k < 2; ++k) dst[m][k] = *(const PG8_LAS bf16x8*)(lds + PG8_SA(b, h) + aoff + m * 2048 + k * 1024); } while (0)
#define PG8_LDB(dst, b, h) do { _Pragma("unroll") for (int n = 0; n < 2; ++n) _Pragma("unroll") for (int k = 0; k < 2; ++k) dst[n][k] = *(const PG8_LAS bf16x8*)(lds + PG8_SB(b, h) + boff + n * 2048 + k * 1024); } while (0)
#define PG8_MMA(ai, bj, At, Bt) do { __builtin_amdgcn_s_setprio(1); _Pragma("unroll") for (int m = 0; m < 4; ++m) _Pragma("unroll") for (int n = 0; n < 2; ++n) _Pragma("unroll") for (int k = 0; k < 2; ++k) \
        acc[ai][bj][m][n] = __builtin_amdgcn_mfma_f32_16x16x32_bf16(Bt[n][k], At[m][k], acc[ai][bj][m][n], 0, 0, 0); __builtin_amdgcn_s_setprio(0); } while (0)
#define PG8_WAIT_V(n) asm volatile("s_waitcnt vmcnt(" #n ")" ::: "memory")
#define PG8_WAIT_L(n) asm volatile("s_waitcnt lgkmcnt(" #n ")" ::: "memory")
#define PG8_BAR __builtin_amdgcn_s_barrier()
#define PG8_SCHED __builtin_amdgcn_sched_barrier(0)
    Unit cur, nxt; int ui = 0;
    if (!S.next(0, cur)) return;
    f32x4 acc[2][2][4][2];
#pragma unroll
    for (int a = 0; a < 2; ++a)
#pragma unroll
        for (int b = 0; b < 2; ++b)
#pragma unroll
            for (int m = 0; m < 4; ++m)
#pragma unroll
                for (int n = 0; n < 2; ++n) acc[a][b][m][n] = (f32x4){0.f, 0.f, 0.f, 0.f};
    bf16x8 At[4][2], B0[2][2], B1[2][2];
    const char* cA = (const char*)g.A + (size_t)cur.pm * tstep; const char* cB = (const char*)g.Bt + (size_t)cur.pn * tstep;
    S.a_ready(cur);
    PG8_STAGE(PG8_SB(0, 0), cB, voffB); PG8_STAGE(PG8_SA(0, 0), cA, voffA); PG8_STAGE(PG8_SB(0, 1), cB + hstep, voffB); PG8_STAGE(PG8_SA(0, 1), cA + hstep, voffA);
    if (wr == 1) PG8_BAR;
    PG8_WAIT_V(4); PG8_BAR;
    PG8_STAGE(PG8_SB(1, 0), cB + kstep, voffB); PG8_STAGE(PG8_SA(1, 0), cA + kstep, voffA); PG8_STAGE(PG8_SB(1, 1), cB + hstep + kstep, voffB);
    PG8_WAIT_V(6); PG8_BAR;
    for (;;) {
        const bool has_next = S.next(ui + 1, nxt);
        const char* nA = has_next ? (const char*)g.A + (size_t)nxt.pm * tstep : cA; const char* nB = has_next ? (const char*)g.Bt + (size_t)nxt.pn * tstep : cB;
#pragma nounroll
        for (int t = 0; t < nt; t += 2) {
            const bool last = (t == nt - 2);
            const char* a1 = cA + (size_t)(t + 1) * kstep;
            const char* a2 = last ? nA : cA + (size_t)(t + 2) * kstep; const char* b2 = last ? nB : cB + (size_t)(t + 2) * kstep;
            const char* a3 = a2 + kstep; const char* b3 = b2 + kstep;
            if (last && has_next) S.a_ready(nxt);
            if (Hook::ACTIVE) { if (t == 8 || t == 12) H(acc, cur, t, wr, wc, fr, fq); }
            PG8_LDB(B0, 0, 0); PG8_SCHED; PG8_LDA(At, 0, 0); PG8_STAGE(PG8_SA(1, 1), a1 + hstep, voffA);
            PG8_WAIT_L(8); PG8_BAR; PG8_WAIT_L(0); PG8_MMA(0, 0, At, B0); PG8_BAR; PG8_SCHED;
            PG8_LDB(B1, 0, 1); PG8_STAGE(PG8_SB(0, 0), b2, voffB);
            PG8_BAR; PG8_WAIT_L(0); PG8_MMA(0, 1, At, B1); PG8_BAR;
            PG8_LDA(At, 0, 1); PG8_STAGE(PG8_SA(0, 0), a2, voffA);
            PG8_BAR; PG8_WAIT_L(0); PG8_MMA(1, 0, At, B0); PG8_BAR; PG8_SCHED;
            PG8_STAGE(PG8_SB(0, 1), b2 + hstep, voffB);
            PG8_WAIT_V(6); PG8_BAR; PG8_MMA(1, 1, At, B1); PG8_BAR;
            PG8_LDB(B0, 1, 0); PG8_SCHED; PG8_LDA(At, 1, 0); PG8_STAGE(PG8_SA(0, 1), a2 + hstep, voffA);
            PG8_WAIT_L(8); PG8_BAR; PG8_WAIT_L(0); PG8_MMA(0, 0, At, B0); PG8_BAR; PG8_SCHED;
            PG8_LDB(B1, 1, 1); PG8_STAGE(PG8_SB(1, 0), b3, voffB);
            PG8_BAR; PG8_WAIT_L(0); PG8_MMA(0, 1, At, B1); PG8_BAR;
            PG8_LDA(At, 1, 1); PG8_STAGE(PG8_SA(1, 0), a3, voffA);
            PG8_BAR; PG8_WAIT_L(0); PG8_MMA(1, 0, At, B0); PG8_BAR; PG8_SCHED;
            PG8_STAGE(PG8_SB(1, 1), b3 + hstep, voffB);
            PG8_WAIT_V(6); PG8_BAR; PG8_MMA(1, 1, At, B1); PG8_BAR;
        }
        E(acc, cur, wr, wc, fr, fq); S.done(cur);
        if (!has_next) break;
#pragma unroll
        for (int a = 0; a < 2; ++a)
#pragma unroll
            for (int b = 0; b < 2; ++b)
#pragma unroll
                for (int m = 0; m < 4; ++m)
#pragma unroll
                    for (int n = 0; n < 2; ++n) acc[a][b][m][n] = (f32x4){0.f, 0.f, 0.f, 0.f};
        cur = nxt; cA = nA; cB = nB; ++ui;
    }
    PG8_WAIT_V(0);
    if (wr == 0) PG8_BAR;
    PG8_BAR;
#undef PG8_SA
#undef PG8_SB
#undef PG8_STAGE
#undef PG8_LDA
#undef PG8_LDB
#undef PG8_MMA
#undef PG8_WAIT_V
#undef PG8_WAIT_L
#undef PG8_BAR
#undef PG8_SCHED
}
}

__device__ __forceinline__ int vperm(int t) { const int kq = (t >> 2) & 7, e = t & 3; return (t & ~31) | ((kq < 4 ? 2 * kq : 2 * (kq - 4) + 1) << 2) | e; }
template <class F> struct Epi8 {
    static constexpr bool PERM = true, AFTER_DRAIN = false;
    F f;
    __device__ __forceinline__ void operator()(const f32x4 (&acc)[2][2][4][2], const pg8::Unit& u, int wr, int wc, int fr, int fq) const {
        const int row0 = u.pm * 256 + wr * 64 + fr, col0 = u.pn * 256 + wc * 32 + 8 * fq;
#pragma unroll
        for (int ai = 0; ai < 2; ++ai)
#pragma unroll
            for (int m = 0; m < 4; ++m)
            {
#pragma unroll
                for (int bj = 0; bj < 2; ++bj) f(row0 + ai * 128 + m * 16, col0 + bj * 128, acc[ai][bj][m][0], acc[ai][bj][m][1], u.pn);
                asm volatile("" ::: "memory"); }
    }
};
__device__ __forceinline__ u32x4 pack8(const f32x4 a, const f32x4 b) {
    return __builtin_bit_cast(u32x4, pg8::cvt8_bf16(a, b));
}
struct FStore { bf16_t* O; int ld;
    __device__ __forceinline__ void operator()(int row, int col, f32x4 a, f32x4 b, int) const { *(u32x4*)(O + (unsigned)(row * ld + col)) = pack8(a, b); } };
__device__ __forceinline__ unsigned gate_off(int row, int col) { return (unsigned)((((row >> 4) * 96 + (col >> 5)) << 9) + ((row & 15) << 5) + (col & 31)); }
struct MergeHook { static constexpr bool ACTIVE = true; const bf16_t* G;
    __device__ __forceinline__ void operator()(f32x4 (&acc)[2][2][4][2], const pg8::Unit& u, int t, int wr, int wc, int fr, int fq) const {
        const int cn = t == 8 ? 0 : 1024;
        const int row0 = u.pm * 256 + wr * 64 + fr, col0 = u.pn * 256 + wc * 32 + 8 * fq;
        u32x4 gn[2][2][2], gd[2][2][2];
#define MH_LOAD(buf, k) do { const int ai_ = (k) >> 1, mh_ = (k) & 1; _Pragma("unroll") for (int mm = 0; mm < 2; ++mm) _Pragma("unroll") for (int bj = 0; bj < 2; ++bj) { \
            const int r_ = row0 + ai_ * 128 + (2 * mh_ + mm) * 16, c_ = cn + col0 + bj * 128; gn[buf][mm][bj] = *(const u32x4*)(G + gate_off(r_, c_)); gd[buf][mm][bj] = *(const u32x4*)(G + gate_off(r_, c_ + 1024)); } } while (0)
#define MH_APPLY(buf, k) do { const int ai_ = (k) >> 1, mh_ = (k) & 1; _Pragma("unroll") for (int mm = 0; mm < 2; ++mm) _Pragma("unroll") for (int bj = 0; bj < 2; ++bj) { const int m = 2 * mh_ + mm; \
            const unsigned nw[4] = {gn[buf][mm][bj].x, gn[buf][mm][bj].y, gn[buf][mm][bj].z, gn[buf][mm][bj].w}, dw[4] = {gd[buf][mm][bj].x, gd[buf][mm][bj].y, gd[buf][mm][bj].z, gd[buf][mm][bj].w}; \
            _Pragma("unroll") for (int j = 0; j < 8; ++j) { const float gnj = (j & 1) ? bfhi(nw[j >> 1]) : bflo(nw[j >> 1]), gdj = (j & 1) ? bfhi(dw[j >> 1]) : bflo(dw[j >> 1]); \
                acc[ai_][bj][m][j >> 2][j & 3] *= gnj * __builtin_amdgcn_rcpf(fmaxf(gdj, 1e-12f)); } } } while (0)
        MH_LOAD(0, 0);
        MH_LOAD(1, 1); asm volatile("" ::: "memory"); MH_APPLY(0, 0); asm volatile("" ::: "memory"); __builtin_amdgcn_sched_barrier(0);
        MH_LOAD(0, 2); asm volatile("" ::: "memory"); MH_APPLY(1, 1); asm volatile("" ::: "memory"); __builtin_amdgcn_sched_barrier(0);
        MH_LOAD(1, 3); asm volatile("" ::: "memory"); MH_APPLY(0, 2); asm volatile("" ::: "memory"); __builtin_amdgcn_sched_barrier(0);
        MH_APPLY(1, 3); asm volatile("" ::: "memory"); __builtin_amdgcn_sched_barrier(0);
#undef MH_LOAD
#undef MH_APPLY
    } };
struct FMulStore { const bf16_t* G; bf16_t* O;
    __device__ __forceinline__ void operator()(int row, int col, f32x4 a, f32x4 b, int) const {
        const u32x4 g = *(const u32x4*)(G + gate_off(row, 2048 + col));
        const f32x4 g0 = {bflo(g.x), bfhi(g.x), bflo(g.y), bfhi(g.y)}, g1 = {bflo(g.z), bfhi(g.z), bflo(g.w), bfhi(g.w)};
        *(u32x4*)(O + (unsigned)(row * 1024 + col)) = pack8(g0 * a, g1 * b); } };
struct FSigmoid { bf16_t* O; int ld;
    __device__ __forceinline__ void operator()(int row, int col, f32x4 a, f32x4 b, int) const {
#pragma unroll
        for (int j = 0; j < 4; ++j) { a[j] = sigmoidf_(a[j]); b[j] = sigmoidf_(b[j]); }
        *(u32x4*)(O + gate_off(row, col)) = pack8(a, b); } };
struct FGluMul { const bf16_t* Y; bf16_t* O; int ld, ldo;
    __device__ __forceinline__ void operator()(int row, int col, f32x4 a, f32x4 b, int) const {
        const unsigned o = (unsigned)(row * ld + col), oo = (unsigned)(row * ldo + col); const u32x4 y = *(const u32x4*)(Y + o);
        const f32x4 y0 = {bflo(y.x), bfhi(y.x), bflo(y.y), bfhi(y.y)}, y1 = {bflo(y.z), bfhi(y.z), bflo(y.w), bfhi(y.w)};
#pragma unroll
        for (int j = 0; j < 4; ++j) { a[j] = y0[j] * sigmoidf_(a[j]); b[j] = y1[j] * sigmoidf_(b[j]); }
        *(u32x4*)(O + oo) = pack8(a, b); } };
struct FSwiGLU { bf16_t* O; int ld;
    __device__ __forceinline__ void operator()(int row, int col, f32x4 a, f32x4 b, int) const {
        const float o0 = a[0] * sigmoidf_(a[0]) * a[1], o1 = a[2] * sigmoidf_(a[2]) * a[3], o2 = b[0] * sigmoidf_(b[0]) * b[1], o3 = b[2] * sigmoidf_(b[2]) * b[3];
        *(u32x2*)(O + (unsigned)(row * ld + (col >> 1))) = pg8::cvt4_bf16((f32x4){o0, o1, o2, o3}); } };
struct FLora { bf16_t *LW, *LA, *RG;
    __device__ __forceinline__ void operator()(int row, int col, f32x4 a, f32x4 b, int pn) const {
        bf16_t* O = pn == 0 ? LW : (pn == 1 ? LA : RG); *(u32x4*)(O + (unsigned)(row * 256 + (col & 255))) = pack8(a, b); } };
struct FXKV { bf16_t* Kx; bf16_t* Vxt;
    __device__ __forceinline__ void operator()(int row, int col, f32x4 a, f32x4 b, int) const {
        const int bb = row >> 8, m = row & 255;
        if (col < 256) { const int h = col >> 6, d = col & 63; *(u32x4*)(Kx + (unsigned)(((bb * 4 + h) * 256 + m) * 64 + d)) = pack8(a, b); }
        else { const int c = col - 256, h = c >> 6, d = c & 63; bf16_t* p = Vxt + (unsigned)(((bb * 4 + h) * 64 + d) * 256 + vperm(m));
#pragma unroll
            for (int j = 0; j < 4; ++j) { p[j * 256] = f2bf(a[j]); p[(j + 4) * 256] = f2bf(b[j]); } } } };
struct FIn1 { bf16_t *Q, *KC, *VC, *KS, *KW, *VSt, *VWt, *ZR, *ZS, *NG; const float* ropec; const float* ropes;
    __device__ __forceinline__ void operator()(int row, int col, f32x4 a, f32x4 b, int pn) const {
        if (pn < 2) { *(u32x4*)(Q + (unsigned)(row * 512 + col)) = pack8(a, b); }
        else if (pn < 5) {
            const int c = col - 512, which = c >> 7, g = (c >> 6) & 1, j0 = c & 63, bb = row >> 12, t = row & 4095;
            const unsigned base = (unsigned)(((bb * 2 + g) * 4096 + t) * 64);
            if (which == 0) *(u32x4*)(KC + base + j0) = pack8(a, b);
            else if (which == 1) *(u32x4*)(VC + base + j0) = pack8(a, b);
            else if (which == 2 || which == 4) {
                const int i0 = j0 >> 1; const f32x4 cs = *(const f32x4*)(ropec + t * 32 + i0), sn = *(const f32x4*)(ropes + t * 32 + i0);
                const float x1[4] = {a[0], a[2], b[0], b[2]}, x2[4] = {a[1], a[3], b[1], b[3]}; float r1[4], r2[4];
#pragma unroll
                for (int j = 0; j < 4; ++j) { r1[j] = x1[j] * cs[j] - x2[j] * sn[j]; r2[j] = x1[j] * sn[j] + x2[j] * cs[j]; }
                bf16_t* K = (which == 2 ? KS : KW) + base;
                const u32x2 w1 = pg8::cvt4_bf16((f32x4){r1[0], r1[1], r1[2], r1[3]}), w2 = pg8::cvt4_bf16((f32x4){r2[0], r2[1], r2[2], r2[3]});
                *(u32x2*)(K + i0) = w1; *(u32x2*)(K + 32 + i0) = w2;
            } else {
                bf16_t* p = (which == 3 ? VSt : VWt) + (unsigned)(((bb * 2 + g) * 64 + j0) * 4096 + vperm(t));
#pragma unroll
                for (int j = 0; j < 4; ++j) { p[j * 4096] = f2bf(a[j]); p[(j + 4) * 4096] = f2bf(b[j]); }
            }
        }
        else if (pn < 9) { *(u32x4*)(ZR + (unsigned)(row * 1024 + (col - 1280))) = pack8(a, b); }
        else if (pn == 9) { *(u32x4*)(ZS + (unsigned)(row * 256 + (col - 2304))) = pack8(a, b); }
        else { const int c = col - 2560; if (c < 32) *(u32x4*)(NG + (unsigned)(row * 32 + c)) = pack8(a, b); }
    } };

typedef const float* const __attribute__((address_space(4)))* KArgPtrs;
struct Frame {
    const __attribute__((address_space(4))) char* kp; unsigned char* ws; LAS unsigned char* lds;
    int tid, lane, wave, bid, G;
    __device__ __forceinline__ const float* in(int i) const { return (const float*)(const __attribute__((address_space(1))) float*)(((KArgPtrs)kp)[i]); }
    __device__ __forceinline__ float* out() const { return (float*)(__attribute__((address_space(1))) float*)(((KArgPtrs)kp)[42]); }
    __device__ __forceinline__ bf16_t* x16() const { return (bf16_t*)(out() + (size_t)TOK * DM / 2); }
    __device__ __forceinline__ unsigned* ctl() const { return (unsigned*)(ws + WS_CTL); }
};
#define LAUNDER(F) do { __attribute__((address_space(1))) unsigned char* _g = (__attribute__((address_space(1))) unsigned char*)(F).ws; asm volatile("" : "+s"(_g), "+s"((F).kp)); (F).ws = (unsigned char*)_g; } while (0)
#define WSP(T, off) ((T*)(F.ws + (off)))

__device__ __forceinline__ int next_job(const Frame& F, unsigned* counter) {
    volatile LAS int* slot = (volatile LAS int*)(F.lds + LDS_CTL_OFF + 16);
    __syncthreads();
    if (F.tid == 0) *slot = (int)__hip_atomic_fetch_add(counter, 1u, __ATOMIC_RELAXED, __HIP_MEMORY_SCOPE_AGENT);
    __syncthreads();
    return *slot;
}

struct ConvDesc { int N, K; size_t dst; };
__device__ __forceinline__ const float* conv_col(const Frame& F, int l, int kind, int n, int& ld, int& klo, int& khi) {
    klo = 0; khi = 1 << 30;
    switch (kind) {
    case 0: {
        int c; ld = INW;
        if (n < 512) c = n;
        else if (n < 1280) { const int cc = n - 512, which = cc >> 7, g = (cc >> 6) & 1, j = cc & 63; const int dim = (which == 2 || which == 4) ? ((j & 1) ? (j >> 1) + 32 : (j >> 1)) : j; c = 512 + which * 128 + g * 64 + dim; }
        else if (n < 2304) c = 1304 + (n - 1280);
        else if (n < 2560) c = 2328 + (n - 2304);
        else if (n < 2584) c = 1280 + (n - 2560);
        else return nullptr;
        return F.in(4) + (size_t)l * DM * INW + c; }
    case 1: ld = INW; return F.in(4) + (size_t)l * DM * INW + 2584 + n;
    case 2: ld = 1024; return F.in(31) + (size_t)l * 512 * 1024 + n;
    case 3: return nullptr;
    case 4: return nullptr;
    case 5: ld = 1024; return F.in(34) + (size_t)l * 1024 * 1024 + n;
    case 6: ld = 256; return F.in(7) + ((size_t)l * 2048 + (n < 256 ? 0 : 1024)) * 256 + (n & 255);
    case 7: ld = 256; return F.in(9) + ((size_t)l * 2048 + (n < 256 ? 0 : 1024)) * 256 + (n & 255);
    case 8: ld = 256; return F.in(35) + (size_t)l * 1024 * 256 + n;
    case 9: ld = 256; return (n < 256 ? F.in(36) : F.in(37)) + (size_t)l * 1024 * 256 + (n & 255);
    case 10: ld = 1024; return F.in(38) + (size_t)l * 256 * 1024 + n;
    case 11: ld = 256; return F.in(30) + (size_t)l * 256 * 256 + n;
    case 12: ld = DFF; return ((n & 1) ? F.in(40) : F.in(39)) + (size_t)l * 1024 * DFF + (n >> 1);
    case 13: ld = 1024; return F.in(41) + (size_t)l * DFF * 1024 + n;
    default: {
        ld = 256;
        if (n < 256) { klo = 0; khi = 64; return F.in(13) + (size_t)l * 64 * 256 + n; }
        if (n < 512) { klo = 64; khi = 128; return F.in(15) + (size_t)l * 64 * 256 + (n - 256); }
        klo = 128; khi = 256; return F.in(16) + (size_t)l * 128 * 256 + (n - 512); }
    }
}
__device__ __forceinline__ void conv_layer(const Frame& F, int l) {
    const ConvDesc D[15] = {{2816, 1024, W_IN1}, {3072, 1024, W_MG}, {1024, 1024, W_UPN}, {64, 64, WS_W + 39 * MiB}, {64, 64, WS_W + 39 * MiB + 65536}, {1024, 1024, W_OUT}, {512, 1024, W_C1K}, {512, 1024, W_C1V},
                            {256, 1024, W_XQ}, {512, 1024, W_XKV}, {1024, 256, W_XO}, {256, 256, W_GLU}, {5632, 1024, W_GU}, {1024, 2816, W_DN}, {768, 256, W_LORA}};
    LAS float* tile = (LAS float*)F.lds;
    int total = 0;
#pragma unroll
    for (int i = 0; i < 15; ++i) total += (D[i].N / 64) * (D[i].K / 64);
    for (int job = F.bid; job < total; job += F.G) {
        int kind = 0, rem = job;
#pragma unroll
        for (int i = 0; i < 15; ++i) { const int nt = (D[i].N / 64) * (D[i].K / 64); if (rem >= nt && kind == i) { rem -= nt; kind = i + 1; } }
        int K = 0; size_t dst = 0;
#pragma unroll
        for (int i = 0; i < 15; ++i) if (kind == i) { K = D[i].K; dst = D[i].dst; }
        const int ktiles = K / 64, n0 = (rem / ktiles) * 64, k0 = (rem % ktiles) * 64;
        int ld, klo, khi; const float* col = conv_col(F, l, kind, n0 + (F.tid & 63), ld, klo, khi);
        if (kind == 2) { if (k0 >= 768) { col = F.in(33) + (size_t)l * 256 * 1024 + n0 + (F.tid & 63); klo = 768; } else if (k0 >= 512) { col = F.in(32) + (size_t)l * 256 * 1024 + n0 + (F.tid & 63); klo = 512; } else khi = 512; }
        float v[8];
#pragma unroll
        for (int i = 0; i < 8; ++i) { const int k = k0 + (F.tid >> 6) + 8 * i; v[i] = (col != nullptr && k >= klo && k < khi) ? col[(size_t)(k - klo) * ld] : 0.f; }
        __syncthreads();
#pragma unroll
        for (int i = 0; i < 8; ++i) tile[((F.tid >> 6) + 8 * i) * 65 + (F.tid & 63)] = v[i];
        __syncthreads();
        bf16_t* O = WSP(bf16_t, dst);
#pragma unroll
        for (int i = 0; i < 4; ++i) { const int ny = (F.tid >> 5) + 16 * i, kp = F.tid & 31; *(unsigned*)(O + (size_t)(n0 + ny) * K + k0 + 2 * kp) = pk2(tile[(2 * kp) * 65 + ny], tile[(2 * kp + 1) * 65 + ny]); }
    }
    __syncthreads();
}

__device__ __forceinline__ void norm_rows(const Frame& F, int nrows, const float* xin32, const bf16_t* xin16, const bf16_t* Y, const float* gy, bf16_t* X16, float* X32, float* X32hi, const float* gh, bf16_t* H) {
    constexpr int NR = 8;
    const int nw = F.G * 8;
    for (int row0 = F.bid * 8 + F.wave; row0 < nrows; row0 += NR * nw) {
        f32x4 xf[NR][4]; u32x2 xr[NR][4], yr[NR][4];
#pragma unroll
        for (int q = 0; q < NR; ++q) {
            const int row = row0 + q * nw < nrows ? row0 + q * nw : row0;
#pragma unroll
            for (int i = 0; i < 4; ++i) {
                if (xin32) xf[q][i] = *(const f32x4*)(xin32 + (size_t)row * 1024 + i * 256 + F.lane * 4);
                else xr[q][i] = *(const u32x2*)(xin16 + (size_t)row * 1024 + i * 256 + F.lane * 4);
                if (Y) yr[q][i] = *(const u32x2*)(Y + (size_t)row * 1024 + i * 256 + F.lane * 4);
            }
        }
#pragma unroll
        for (int q = 0; q < NR; ++q) {
            const int row = row0 + q * nw;
            if (row < nrows) {
                f32x4 x[4];
#pragma unroll
                for (int i = 0; i < 4; ++i) x[i] = xin32 ? xf[q][i] : (f32x4){bflo(xr[q][i].x), bfhi(xr[q][i].x), bflo(xr[q][i].y), bfhi(xr[q][i].y)};
                if (Y) {
                    f32x4 y[4]; float ss = 0.f;
#pragma unroll
                    for (int i = 0; i < 4; ++i) { y[i] = (f32x4){bflo(yr[q][i].x), bfhi(yr[q][i].x), bflo(yr[q][i].y), bfhi(yr[q][i].y)}; ss += y[i][0] * y[i][0] + y[i][1] * y[i][1] + y[i][2] * y[i][2] + y[i][3] * y[i][3]; }
                    ss = wave_sum(ss); const float rs = rsqrtf(ss * (1.0f / 1024.0f) + 1e-6f);
#pragma unroll
                    for (int i = 0; i < 4; ++i) { const f32x4 g = *(const f32x4*)(gy + i * 256 + F.lane * 4); x[i] += y[i] * rs * g; }
                }
                if (X16) {
#pragma unroll
                    for (int i = 0; i < 4; ++i) *(u32x2*)(X16 + (size_t)row * 1024 + i * 256 + F.lane * 4) = pg8::cvt4_bf16(x[i]);
                }
                if (X32) {
                    float* dst = row < TOK / 2 ? X32 + (size_t)row * 1024 : X32hi + (size_t)(row - TOK / 2) * 1024;
#pragma unroll
                    for (int i = 0; i < 4; ++i) *(f32x4*)(dst + i * 256 + F.lane * 4) = x[i];
                }
                if (H) {
                    float ss = 0.f;
#pragma unroll
                    for (int i = 0; i < 4; ++i) ss += x[i][0] * x[i][0] + x[i][1] * x[i][1] + x[i][2] * x[i][2] + x[i][3] * x[i][3];
                    ss = wave_sum(ss); const float rs = rsqrtf(ss * (1.0f / 1024.0f) + 1e-6f);
#pragma unroll
                    for (int i = 0; i < 4; ++i) { const f32x4 g = *(const f32x4*)(gh + i * 256 + F.lane * 4); const f32x4 h = x[i] * rs * g;
                        *(u32x2*)(H + (size_t)row * 1024 + i * 256 + F.lane * 4) = pg8::cvt4_bf16(h); }
                }
            }
        }
    }
}

__device__ __forceinline__ void rwkv_lin_tile(const Frame& F, int l, int tile) {
    const bf16_t* ZR = WSP(const bf16_t, WS_ZR); bf16_t* LIN = WSP(bf16_t, WS_LIN);
    const float* mu = F.in(11) + (size_t)l * 1024 + 768;
    const int tk = F.tid >> 3, cg = F.tid & 7, row = tile * 64 + tk, t = row & 4095;
    u32x4 z[4], zp[4];
#pragma unroll
    for (int i = 0; i < 4; ++i) { z[i] = *(const u32x4*)(ZR + (size_t)row * 1024 + 768 + cg * 32 + i * 8); zp[i] = (u32x4){0u, 0u, 0u, 0u}; }
    if (t > 0) {
#pragma unroll
        for (int i = 0; i < 4; ++i) zp[i] = *(const u32x4*)(ZR + (size_t)(row - 1) * 1024 + 768 + cg * 32 + i * 8);
    }
#pragma unroll
    for (int i = 0; i < 4; ++i) {
        const f32x4 m0 = *(const f32x4*)(mu + cg * 32 + i * 8), m1 = *(const f32x4*)(mu + cg * 32 + i * 8 + 4);
        const unsigned zw[4] = {z[i].x, z[i].y, z[i].z, z[i].w}, pw[4] = {zp[i].x, zp[i].y, zp[i].z, zp[i].w}; float o[8];
#pragma unroll
        for (int j = 0; j < 8; ++j) { const float zz = (j & 1) ? bfhi(zw[j >> 1]) : bflo(zw[j >> 1]), pp = (j & 1) ? bfhi(pw[j >> 1]) : bflo(pw[j >> 1]); const float m = j < 4 ? m0[j & 3] : m1[j & 3];
            const float zs = zz + (pp - zz) * m; o[j] = cg < 2 ? tanhf(zs) : (cg < 4 ? zs : sigmoidf_(zs)); }
        u32x4 w; w.x = pk2(o[0], o[1]); w.y = pk2(o[2], o[3]); w.z = pk2(o[4], o[5]); w.w = pk2(o[6], o[7]);
        *(u32x4*)(LIN + (size_t)row * 256 + cg * 32 + i * 8) = w;
    }
}

__device__ __forceinline__ f32x4 mm16(const f32x4& XT, const f32x4& Y) {
    f32x4 z = {0.f, 0.f, 0.f, 0.f};
#pragma unroll
    for (int ks = 0; ks < 4; ++ks) z = __builtin_amdgcn_mfma_f32_16x16x4f32(XT[ks], Y[ks], z, 0, 0, 0);
    return z;
}
__device__ __forceinline__ void rwkv_chunk_prep(const Frame& F, int l, int ci) {
    const int bh = ci >> 8, c = ci & 255, b = bh >> 2, h = bh & 3, lane = F.lane, fr = lane & 15, fq = lane >> 4;
    LAS unsigned char* L = F.lds + F.wave * 9216;
    const bf16_t* ZR = WSP(const bf16_t, WS_ZR); const bf16_t* LW = WSP(const bf16_t, WS_LW); const bf16_t* LA = WSP(const bf16_t, WS_LA);
    const int ch = h * 64 + lane;
    const float* mu = F.in(11) + (size_t)l * 1024;
    const float mur = mu[ch], muk = mu[256 + ch], muv = mu[512 + ch], w0 = F.in(12)[l * 256 + ch], a0 = F.in(14)[l * 256 + ch], kkc = F.in(17)[l * 256 + ch], kac = F.in(18)[l * 256 + ch], rkc = F.in(19)[l * 256 + ch];
    const size_t row0 = (size_t)b * 4096 + c * 16;
    float pr = 0.f, pk = 0.f, pv = 0.f;
    if (c > 0) { pr = bf2f(ZR[(row0 - 1) * 1024 + ch]); pk = bf2f(ZR[(row0 - 1) * 1024 + 256 + ch]); pv = bf2f(ZR[(row0 - 1) * 1024 + 512 + ch]); }
    float gam = 1.0f; unsigned bT[8], kT[8], vT[8]; float* BON = WSP(float, WS_BONUS);
    float zr_[16], zk_[16], zv_[16], lw_[16], la_[16];
#pragma unroll
    for (int t = 0; t < 16; ++t) { const size_t row = row0 + t; zr_[t] = bf2f(ZR[row * 1024 + ch]); zk_[t] = bf2f(ZR[row * 1024 + 256 + ch]); zv_[t] = bf2f(ZR[row * 1024 + 512 + ch]);
        lw_[t] = bf2f(LW[row * 256 + ch]); la_[t] = bf2f(LA[row * 256 + ch]); }
    float bprev = 0.f, kprev = 0.f, vprev = 0.f;
#pragma unroll
    for (int t = 0; t < 16; ++t) {
        const float r = zr_[t] + (pr - zr_[t]) * mur, k = zk_[t] + (pk - zk_[t]) * muk, v = zv_[t] + (pv - zv_[t]) * muv; pr = zr_[t]; pk = zk_[t]; pv = zv_[t];
        const float u = w0 + lw_[t]; const float sp = fmaxf(-u, 0.f) + __logf(1.0f + __expf(-fabsf(u))); const float dec = __expf(-__expf(-sp - 0.5f));
        const float a = sigmoidf_(a0 + la_[t]);
        const float kkv = k * kkc; float n2 = row16_sum(kkv * kkv); n2 = xsum16(n2); n2 = xsum32(n2);
        const float kk = kkv * rsqrtf(fmaxf(n2, 1e-24f));
        const float kp = k * (1.0f + (a - 1.0f) * kac);
        float bon = row16_sum(r * kp * rkc); bon = xsum16(bon); bon = xsum32(bon);
        if (lane == 0) BON[(row0 + t) * 4 + h] = bon;
        const float gprev = gam; gam *= dec; const float ginv = __builtin_amdgcn_rcpf(gam);
        const float ah = -gprev * kk, bh_ = kk * a * ginv, kh = kp * ginv, rh = gam * r;
        *(LAS bf16_t*)(L + 0 * 2304 + t * 144 + lane * 2) = f2bf(ah); *(LAS bf16_t*)(L + 1 * 2304 + t * 144 + lane * 2) = f2bf(rh);
        *(LAS bf16_t*)(L + 2 * 2304 + t * 144 + lane * 2) = f2bf(bh_); *(LAS bf16_t*)(L + 3 * 2304 + t * 144 + lane * 2) = f2bf(kh);
        if (t & 1) { bT[t >> 1] = pk2(bprev, bh_); kT[t >> 1] = pk2(kprev, kh); vT[t >> 1] = pk2(vprev, v); } else { bprev = bh_; kprev = kh; vprev = v; }
    }
    {
        bf16_t* BKT = WSP(bf16_t, WS_CS_BKT) + ((size_t)ci * 64 + lane) * 32; bf16_t* VMT = WSP(bf16_t, WS_CS_VMT) + ((size_t)ci * 64 + lane) * 16;
        *(u32x4*)(BKT) = (u32x4){bT[0], bT[1], bT[2], bT[3]}; *(u32x4*)(BKT + 8) = (u32x4){bT[4], bT[5], bT[6], bT[7]};
        *(u32x4*)(BKT + 16) = (u32x4){kT[0], kT[1], kT[2], kT[3]}; *(u32x4*)(BKT + 24) = (u32x4){kT[4], kT[5], kT[6], kT[7]};
        *(u32x4*)(VMT) = (u32x4){vT[0], vT[1], vT[2], vT[3]}; *(u32x4*)(VMT + 8) = (u32x4){vT[4], vT[5], vT[6], vT[7]};
        WSP(float, WS_CS_GAM)[(size_t)ci * 64 + lane] = gam;
    }
    asm volatile("s_waitcnt lgkmcnt(0)" ::: "memory");
    {
        bf16_t* AR = WSP(bf16_t, WS_CS_AR) + (size_t)ci * 2048;
#pragma unroll
        for (int j = 0; j < 4; ++j) { const int e = lane + 64 * j, which = e >> 7, row = (e >> 3) & 15, c16 = e & 7;
            *(u32x4*)(AR + e * 8) = *(const LAS u32x4*)(L + which * 2304 + row * 144 + c16 * 16); }
    }
    bf16x8 Af[2], Rf[2], Bf[2], Kf[2];
#pragma unroll
    for (int ks = 0; ks < 2; ++ks) { Af[ks] = *(const LAS bf16x8*)(L + 0 * 2304 + fr * 144 + ks * 64 + fq * 16); Rf[ks] = *(const LAS bf16x8*)(L + 1 * 2304 + fr * 144 + ks * 64 + fq * 16);
        Bf[ks] = *(const LAS bf16x8*)(L + 2 * 2304 + fr * 144 + ks * 64 + fq * 16); Kf[ks] = *(const LAS bf16x8*)(L + 3 * 2304 + fr * 144 + ks * 64 + fq * 16); }
    f32x4 Pab = {0.f, 0.f, 0.f, 0.f}, PabT = Pab, Pak = Pab, Prb = Pab, Prk = Pab;
#pragma unroll
    for (int ks = 0; ks < 2; ++ks) { Pab = __builtin_amdgcn_mfma_f32_16x16x32_bf16(Af[ks], Bf[ks], Pab, 0, 0, 0); PabT = __builtin_amdgcn_mfma_f32_16x16x32_bf16(Bf[ks], Af[ks], PabT, 0, 0, 0);
        Pak = __builtin_amdgcn_mfma_f32_16x16x32_bf16(Af[ks], Kf[ks], Pak, 0, 0, 0); Prb = __builtin_amdgcn_mfma_f32_16x16x32_bf16(Rf[ks], Bf[ks], Prb, 0, 0, 0); Prk = __builtin_amdgcn_mfma_f32_16x16x32_bf16(Rf[ks], Kf[ks], Prk, 0, 0, 0); }
    f32x4 One = {0.f, 0.f, 0.f, 0.f};
#pragma unroll
    for (int r = 0; r < 4; ++r) { const int rho = 4 * fq + r;
        Pab[r] = fr < rho ? Pab[r] : 0.f; Pak[r] = fr < rho ? Pak[r] : 0.f; PabT[r] = rho < fr ? PabT[r] : 0.f; Prb[r] = fr <= rho ? Prb[r] : 0.f; Prk[r] = fr <= rho ? Prk[r] : 0.f; One[r] = fr == rho ? 1.f : 0.f; }
    {
        bf16_t* AAK = WSP(bf16_t, WS_CS_AAK) + (size_t)ci * 256; bf16_t* ARBK = WSP(bf16_t, WS_CS_ARBK) + (size_t)ci * 512;
#pragma unroll
        for (int r = 0; r < 4; ++r) { const int rho = 4 * fq + r; AAK[rho * 16 + fr] = f2bf(Pak[r]); ARBK[rho * 32 + fr] = f2bf(Prb[r]); ARBK[rho * 32 + 16 + fr] = f2bf(Prk[r]); }
    }
    const f32x4 A2 = mm16(PabT, Pab), A2T = mm16(Pab, PabT), A4 = mm16(A2T, A2), A4T = mm16(A2, A2T), A8 = mm16(A4T, A4);
    const f32x4 G1 = mm16(One + PabT, One + A2), G1T = mm16(One + A2, One + PabT), G2 = mm16(One + A4T, One + A8);
    const f32x4 Mm = mm16(G1T, G2);
    { float* MM = WSP(float, WS_CS_MM) + (size_t)ci * 256;
#pragma unroll
      for (int r = 0; r < 4; ++r) MM[(4 * fq + r) * 16 + fr] = Mm[r]; }
    asm volatile("s_waitcnt lgkmcnt(0)" ::: "memory");
}
constexpr int CS_AH = 0, CS_RH = 2304, CS_BKT = 4608, CS_VMT = 9728, CS_AAK = 11776, CS_ARBK = 12288, CS_MM = 13568, CS_GAM = 14848, CS_REC = 15360;
__device__ __forceinline__ void rwkv_chunk_scan(const Frame& F, int bh) {
    const int b = bh >> 2, h = bh & 3, lane = F.lane, fr = lane & 15, fq = lane >> 4, tid = F.tid;
    const bf16_t* AR = WSP(const bf16_t, WS_CS_AR) + (size_t)bh * 256 * 2048; const bf16_t* BKT = WSP(const bf16_t, WS_CS_BKT) + (size_t)bh * 256 * 2048;
    const bf16_t* VMT = WSP(const bf16_t, WS_CS_VMT) + (size_t)bh * 256 * 1024; const bf16_t* AAK = WSP(const bf16_t, WS_CS_AAK) + (size_t)bh * 256 * 256;
    const bf16_t* ARBK = WSP(const bf16_t, WS_CS_ARBK) + (size_t)bh * 256 * 512; const float* MMg = WSP(const float, WS_CS_MM) + (size_t)bh * 256 * 256; const float* GAM = WSP(const float, WS_CS_GAM) + (size_t)bh * 256 * 64;
    float* YS = WSP(float, WS_YSCAN);
    const unsigned char* g1; int l1, s1;
    if (tid < 256) { g1 = (const unsigned char*)AR + tid * 16; l1 = (tid >> 7) * 2304 + ((tid >> 3) & 15) * 144 + (tid & 7) * 16; s1 = 4096; }
    else { const int e = tid - 256; g1 = (const unsigned char*)BKT + e * 16; l1 = CS_BKT + (e >> 2) * 80 + (e & 3) * 16; s1 = 4096; }
    const unsigned char* g2 = (const unsigned char*)VMT; int l2 = 0, s2 = 0; const bool has2 = tid < 304;
    if (tid < 128) { g2 = (const unsigned char*)VMT + tid * 16; l2 = CS_VMT + (tid >> 1) * 32 + (tid & 1) * 16; s2 = 2048; }
    else if (tid < 160) { const int e = tid - 128; g2 = (const unsigned char*)AAK + e * 16; l2 = CS_AAK + (e >> 1) * 32 + (e & 1) * 16; s2 = 512; }
    else if (tid < 224) { const int e = tid - 160; g2 = (const unsigned char*)ARBK + e * 16; l2 = CS_ARBK + (e >> 2) * 80 + (e & 3) * 16; s2 = 1024; }
    else if (tid < 288) { const int e = tid - 224; g2 = (const unsigned char*)MMg + e * 16; l2 = CS_MM + (e >> 2) * 80 + (e & 3) * 16; s2 = 1024; }
    else if (tid < 304) { const int e = tid - 288; g2 = (const unsigned char*)GAM + e * 16; l2 = CS_GAM + e * 16; s2 = 256; }
    f32x4 S[4];
#pragma unroll
    for (int kt = 0; kt < 4; ++kt) S[kt] = (f32x4){0.f, 0.f, 0.f, 0.f};
    const int v0 = 16 * F.wave;
    u32x4 R0a, R0b = {0u, 0u, 0u, 0u}, R1a, R1b = {0u, 0u, 0u, 0u};
#define CS_LOAD(R, c) do { R##a = *(const u32x4*)(g1 + (size_t)(c) * s1); if (has2) R##b = *(const u32x4*)(g2 + (size_t)(c) * s2); } while (0)
#define CS_WRITE(R, buf) do { *(LAS u32x4*)(F.lds + (buf) * CS_REC + l1) = R##a; if (has2) *(LAS u32x4*)(F.lds + (buf) * CS_REC + l2) = R##b; } while (0)
#define CS_COMPUTE(buf, c) do { if (F.wave < 4) { const LAS unsigned char* B = F.lds + (buf) * CS_REC; \
        bf16x8 sp[2]; \
        _Pragma("unroll") for (int ks = 0; ks < 2; ++ks) sp[ks] = pg8::cvt8_bf16(S[2 * ks], S[2 * ks + 1]); \
        const u32x2 vmf = *(const LAS u32x2*)(B + CS_VMT + (v0 + fr) * 32 + fq * 8); \
        f32x4 wt = {0.f, 0.f, 0.f, 0.f}, yt = {0.f, 0.f, 0.f, 0.f}; \
        _Pragma("unroll") for (int ks = 0; ks < 2; ++ks) { \
            const u32x2 a0_ = *(const LAS u32x2*)(B + CS_AH + fr * 144 + (32 * ks + 4 * fq) * 2), a1_ = *(const LAS u32x2*)(B + CS_AH + fr * 144 + (32 * ks + 16 + 4 * fq) * 2); \
            const u32x2 r0_ = *(const LAS u32x2*)(B + CS_RH + fr * 144 + (32 * ks + 4 * fq) * 2), r1_ = *(const LAS u32x2*)(B + CS_RH + fr * 144 + (32 * ks + 16 + 4 * fq) * 2); \
            wt = __builtin_amdgcn_mfma_f32_16x16x32_bf16(__builtin_bit_cast(bf16x8, ((u32x4){a0_.x, a0_.y, a1_.x, a1_.y})), sp[ks], wt, 0, 0, 0); \
            yt = __builtin_amdgcn_mfma_f32_16x16x32_bf16(__builtin_bit_cast(bf16x8, ((u32x4){r0_.x, r0_.y, r1_.x, r1_.y})), sp[ks], yt, 0, 0, 0); } \
        { const u32x2 ak = *(const LAS u32x2*)(B + CS_AAK + fr * 32 + fq * 8); \
          wt = __builtin_amdgcn_mfma_f32_16x16x32_bf16(__builtin_bit_cast(bf16x8, ((u32x4){ak.x, ak.y, 0u, 0u})), __builtin_bit_cast(bf16x8, ((u32x4){vmf.x, vmf.y, 0u, 0u})), wt, 0, 0, 0); } \
        const f32x4 mrow = *(const LAS f32x4*)(B + CS_MM + fr * 80 + fq * 16); \
        f32x4 ut = {0.f, 0.f, 0.f, 0.f}; \
        _Pragma("unroll") for (int ks = 0; ks < 4; ++ks) ut = __builtin_amdgcn_mfma_f32_16x16x4f32(mrow[ks], wt[ks], ut, 0, 0, 0); \
        const u32x2 utp = pg8::cvt4_bf16(ut); const bf16x8 uv = __builtin_bit_cast(bf16x8, ((u32x4){utp.x, utp.y, vmf.x, vmf.y})); \
        { const u32x2 q0_ = *(const LAS u32x2*)(B + CS_ARBK + fr * 80 + fq * 8), q1_ = *(const LAS u32x2*)(B + CS_ARBK + fr * 80 + 32 + fq * 8); \
          yt = __builtin_amdgcn_mfma_f32_16x16x32_bf16(__builtin_bit_cast(bf16x8, ((u32x4){q0_.x, q0_.y, q1_.x, q1_.y})), uv, yt, 0, 0, 0); } \
        _Pragma("unroll") for (int r = 0; r < 4; ++r) YS[((size_t)b * 4096 + (c) * 16 + 4 * fq + r) * 256 + h * 64 + v0 + fr] = yt[r]; \
        _Pragma("unroll") for (int kt = 0; kt < 4; ++kt) { \
            const u32x2 b0_ = *(const LAS u32x2*)(B + CS_BKT + (16 * kt + fr) * 80 + fq * 8), b1_ = *(const LAS u32x2*)(B + CS_BKT + (16 * kt + fr) * 80 + 32 + fq * 8); \
            const f32x4 gm = *(const LAS f32x4*)(B + CS_GAM + (16 * kt + 4 * fq) * 4); \
            S[kt] = __builtin_amdgcn_mfma_f32_16x16x32_bf16(__builtin_bit_cast(bf16x8, ((u32x4){b0_.x, b0_.y, b1_.x, b1_.y})), uv, S[kt], 0, 0, 0) * gm; } } } while (0)
    CS_LOAD(R0, 0); CS_LOAD(R1, 1);
    __syncthreads();
    CS_WRITE(R0, 0); CS_LOAD(R0, 2);
    __syncthreads();
    for (int c = 0; c < 256; c += 2) {
        CS_COMPUTE(0, c);
        CS_WRITE(R1, 1); if (c + 3 < 256) CS_LOAD(R1, c + 3);
        __syncthreads();
        CS_COMPUTE(1, c + 1);
        if (c + 2 < 256) { CS_WRITE(R0, 0); if (c + 4 < 256) CS_LOAD(R0, c + 4); }
        __syncthreads();
    }
#undef CS_LOAD
#undef CS_WRITE
#undef CS_COMPUTE
}

__device__ __forceinline__ void rwkv_post(const Frame& F, int l) {
    const float* YS = WSP(const float, WS_YSCAN); const bf16_t* VMT = WSP(const bf16_t, WS_CS_VMT); const bf16_t* RG = WSP(const bf16_t, WS_RG); const float* BON = WSP(const float, WS_BONUS);
    bf16_t* YR = WSP(bf16_t, WS_YCAT) + 512;
    for (int ci = F.bid * 8 + F.wave; ci < 32 * 256; ci += F.G * 8) {
        const int bh = ci >> 8, c = ci & 255, b = bh >> 2, h = bh & 3, ch = h * 64 + F.lane;
        const float lnw = F.in(20)[l * 256 + ch], lnb = F.in(21)[l * 256 + ch];
        const u32x4 v0 = *(const u32x4*)(VMT + ((size_t)ci * 64 + F.lane) * 16), v1 = *(const u32x4*)(VMT + ((size_t)ci * 64 + F.lane) * 16 + 8);
        const unsigned vw[8] = {v0.x, v0.y, v0.z, v0.w, v1.x, v1.y, v1.z, v1.w};
        const size_t row0 = (size_t)b * 4096 + c * 16;
        float y[16], g[16], bo[16];
#pragma unroll
        for (int t = 0; t < 16; ++t) { y[t] = YS[(row0 + t) * 256 + ch]; g[t] = bf2f(RG[(row0 + t) * 256 + ch]); bo[t] = BON[(row0 + t) * 4 + h]; }
#pragma unroll
        for (int t = 0; t < 16; ++t) {
            const float mean = wave_sum(y[t]) * (1.0f / 64.0f); const float d = y[t] - mean; const float var = wave_sum(d * d) * (1.0f / 64.0f);
            const float yn = d * rsqrtf(var + 64e-5f) * lnw + lnb; const float v = (t & 1) ? bfhi(vw[t >> 1]) : bflo(vw[t >> 1]);
            YR[(row0 + t) * 1024 + ch] = f2bf((yn + bo[t] * v) * g[t]);
        }
    }
}

struct S5Coef { float are, aim; bf16x8 Bf[8]; };
__device__ __forceinline__ void s5_abar(const Frame& F, int l, int g, int p, float& are, float& aim, float& cre, float& cim) {
    const float lr = F.in(22)[(l * 16 + g) * 64 + p], li = F.in(23)[(l * 16 + g) * 64 + p], dt = expf(F.in(24)[l * 16 + g]);
    const float mag = expf(lr * dt); float sn, cs; sincosf(li * dt, &sn, &cs);
    are = mag * cs; aim = mag * sn;
    const float den = lr * lr + li * li; cre = ((are - 1.0f) * lr + aim * li) / den; cim = (aim * lr - (are - 1.0f) * li) / den;
}
__device__ __forceinline__ void s5_setup(const Frame& F, int l, int g, int lane, S5Coef& C) {
    float cre, cim; s5_abar(F, l, g, lane, C.are, C.aim, cre, cim);
    const int fr = lane & 15, fq = lane >> 4;
#pragma unroll
    for (int pt = 0; pt < 4; ++pt) {
        const int p = 16 * pt + fr; float are, aim, c_re, c_im; s5_abar(F, l, g, p, are, aim, c_re, c_im);
        u32x4 wr = {0u, 0u, 0u, 0u}, wi = {0u, 0u, 0u, 0u};
        if (fq < 2) {
            const float* bre = F.in(25) + ((size_t)(l * 16 + g) * 64 + p) * 16 + 8 * fq; const float* bim = F.in(26) + ((size_t)(l * 16 + g) * 64 + p) * 16 + 8 * fq;
            float re[8], im[8];
#pragma unroll
            for (int j = 0; j < 8; ++j) { re[j] = c_re * bre[j] - c_im * bim[j]; im[j] = c_re * bim[j] + c_im * bre[j]; }
            wr = (u32x4){pk2(re[0], re[1]), pk2(re[2], re[3]), pk2(re[4], re[5]), pk2(re[6], re[7])}; wi = (u32x4){pk2(im[0], im[1]), pk2(im[2], im[3]), pk2(im[4], im[5]), pk2(im[6], im[7])};
        }
        C.Bf[pt] = __builtin_bit_cast(bf16x8, wr); C.Bf[pt + 4] = __builtin_bit_cast(bf16x8, wi);
    }
}
template <int NSTEPS>
__device__ __forceinline__ void s5_stage_u(const bf16_t* ZS, int b, int g, int t0, LAS unsigned char* us, int lane) {
#pragma unroll
    for (int i = 0; i < NSTEPS / 32; ++i) { const int id = lane + 64 * i, step = id >> 1, hf = id & 1;
        const u32x4 v = *(const u32x4*)(ZS + ((size_t)(b * 4096 + t0 + step) * 256 + g * 16 + hf * 8));
        *(LAS u32x4*)(us + id * 16) = v; }
    asm volatile("s_waitcnt vmcnt(0) lgkmcnt(0)" ::: "memory");
}
__device__ __forceinline__ void s5_project16(const S5Coef& C, const LAS unsigned char* us16, LAS unsigned* bu, int fr, int fq) {
    u32x4 a = {0u, 0u, 0u, 0u};
    if (fq < 2) a = *(const LAS u32x4*)(us16 + fr * 32 + fq * 16);
    const bf16x8 af = __builtin_bit_cast(bf16x8, a);
    f32x4 c[8];
#pragma unroll
    for (int i = 0; i < 8; ++i) { const int nt = (i >> 1) + 4 * (i & 1);
        c[nt] = __builtin_amdgcn_mfma_f32_16x16x32_bf16(af, C.Bf[nt], (f32x4){0.f, 0.f, 0.f, 0.f}, 0, 0, 0); }
    asm volatile("s_nop 15\n\ts_nop 15\n\ts_nop 15\n\ts_nop 15\n\ts_nop 15\n\ts_nop 15\n\ts_nop 15\n\ts_nop 15\n\ts_nop 15\n\ts_nop 15" : "+v"(c[0]), "+v"(c[1]), "+v"(c[2]), "+v"(c[3]), "+v"(c[4]), "+v"(c[5]), "+v"(c[6]), "+v"(c[7]));
    unsigned w[16];
#pragma unroll
    for (int pt = 0; pt < 4; ++pt)
#pragma unroll
        for (int r = 0; r < 4; ++r) w[pt * 4 + r] = pg8::cvt_pk_bf16(c[pt][r], c[pt + 4][r]);
    asm volatile("" : "+v"(w[0]), "+v"(w[1]), "+v"(w[2]), "+v"(w[3]), "+v"(w[4]), "+v"(w[5]), "+v"(w[6]), "+v"(w[7]), "+v"(w[8]), "+v"(w[9]), "+v"(w[10]), "+v"(w[11]), "+v"(w[12]), "+v"(w[13]), "+v"(w[14]), "+v"(w[15]));
#pragma unroll
    for (int pt = 0; pt < 4; ++pt)
#pragma unroll
        for (int r = 0; r < 4; ++r) bu[(4 * fq + r) * 64 + 16 * pt + fr] = w[pt * 4 + r];
    asm volatile("s_waitcnt lgkmcnt(0)" : "+v"(w[0]), "+v"(w[1]), "+v"(w[2]), "+v"(w[3]), "+v"(w[4]), "+v"(w[5]), "+v"(w[6]), "+v"(w[7]), "+v"(w[8]), "+v"(w[9]), "+v"(w[10]), "+v"(w[11]), "+v"(w[12]), "+v"(w[13]), "+v"(w[14]), "+v"(w[15]) :: "memory");
}
__device__ __forceinline__ void s5_pass1(const Frame& F, int l, int item) {
    const int b = item >> 8, g = (item >> 4) & 15, ch = item & 15, p = F.lane, fr = F.lane & 15, fq = F.lane >> 4;
    LAS unsigned char* us = F.lds + F.wave * 12288;
    LAS unsigned* bu = (LAS unsigned*)(us + 8192);
    S5Coef C; s5_setup(F, l, g, F.lane, C);
    s5_stage_u<256>(WSP(const bf16_t, WS_ZS), b, g, ch * 256, us, F.lane);
    float xr = 0.f, xi = 0.f;
    for (int t16 = 0; t16 < 16; ++t16) {
        s5_project16(C, us + t16 * 512, bu, fr, fq);
#pragma unroll
        for (int q = 0; q < 16; ++q) { const unsigned v = bu[q * 64 + p]; const float nr = C.are * xr - C.aim * xi + bflo(v), ni = C.are * xi + C.aim * xr + bfhi(v); xr = nr; xi = ni; }
        asm volatile("s_waitcnt lgkmcnt(0)" ::: "memory");
    }
    *(f32x2*)(WSP(float, WS_XEND) + ((size_t)((b * 16 + g) * 16 + ch) * 64 + p) * 2) = (f32x2){xr, xi};
}
__device__ __forceinline__ void s5_pass2(const Frame& F, int l, int item) {
    const int b = item >> 8, g = (item >> 4) & 15, ch = item & 15, p = F.lane, fr = F.lane & 15, fq = F.lane >> 4;
    LAS unsigned char* us = F.lds + F.wave * 12544;
    LAS unsigned* bu = (LAS unsigned*)(us + 4096); LAS unsigned char* xs = us + 8192;
    S5Coef C; s5_setup(F, l, g, F.lane, C);
    bf16x8 cb[4];
    {
        const float* cre = F.in(27) + ((size_t)(l * 16 + g) * 16 + fr) * 64; const float* cim = F.in(28) + ((size_t)(l * 16 + g) * 16 + fr) * 64;
#pragma unroll
        for (int ks = 0; ks < 4; ++ks) { const float* src = (ks < 2 ? cre : cim) + (ks & 1) * 32 + 8 * fq; const f32x4 a0 = *(const f32x4*)src, a1 = *(const f32x4*)(src + 4); const float sg = ks < 2 ? 1.f : -1.f;
            u32x4 w; w.x = pk2(sg * a0[0], sg * a0[1]); w.y = pk2(sg * a0[2], sg * a0[3]); w.z = pk2(sg * a1[0], sg * a1[1]); w.w = pk2(sg * a1[2], sg * a1[3]); cb[ks] = __builtin_bit_cast(bf16x8, w); }
    }
    float ar = C.are, ai = C.aim;
#pragma unroll
    for (int i = 0; i < 8; ++i) { const float nr = ar * ar - ai * ai, ni = 2.f * ar * ai; ar = nr; ai = ni; }
    float xr = 0.f, xi = 0.f;
    const float* XE = WSP(const float, WS_XEND) + ((size_t)((b * 16 + g) * 16) * 64 + p) * 2;
    for (int c2 = 0; c2 < ch; ++c2) { const f32x2 e = *(const f32x2*)(XE + (size_t)c2 * 128); const float nr = ar * xr - ai * xi + e[0], ni = ar * xi + ai * xr + e[1]; xr = nr; xi = ni; }
    bf16_t* YG = WSP(bf16_t, WS_YS5G);
    const float dcoef = F.in(29)[(l * 16 + g) * 16 + fr];
    for (int t16 = 0; t16 < 16; ++t16) {
        if ((t16 & 7) == 0) s5_stage_u<128>(WSP(const bf16_t, WS_ZS), b, g, ch * 256 + t16 * 16, us, F.lane);
        const LAS unsigned char* us16 = us + (t16 & 7) * 512;
        s5_project16(C, us16, bu, fr, fq);
#pragma unroll
        for (int q = 0; q < 16; ++q) { const unsigned v = bu[q * 64 + p]; const float nr = C.are * xr - C.aim * xi + bflo(v), ni = C.are * xi + C.aim * xr + bfhi(v); xr = nr; xi = ni;
            *(LAS bf16_t*)(xs + q * 272 + p * 2) = f2bf(xr); *(LAS bf16_t*)(xs + q * 272 + 128 + p * 2) = f2bf(xi); }
        asm volatile("s_waitcnt lgkmcnt(0)" ::: "memory");
        f32x4 acc = {0.f, 0.f, 0.f, 0.f};
#pragma unroll
        for (int ks = 0; ks < 4; ++ks) { const bf16x8 af = *(const LAS bf16x8*)(xs + fr * 272 + ks * 64 + fq * 16); acc = __builtin_amdgcn_mfma_f32_16x16x32_bf16(af, cb[ks], acc, 0, 0, 0); }
#pragma unroll
        for (int r = 0; r < 4; ++r) { const int st = 4 * fq + r; const float u = bf2f(*(const LAS bf16_t*)(us16 + st * 32 + fr * 2));
            YG[(size_t)(b * 4096 + ch * 256 + t16 * 16 + st) * 256 + g * 16 + fr] = f2bf(gelu_tanh(acc[r] + dcoef * u)); }
        asm volatile("s_waitcnt lgkmcnt(0)" ::: "memory");
    }
}

__device__ __forceinline__ void cmp_bias(const Frame& F, int l, int w) {
    const int kv = w >> 5, part = w & 31;
    const float* pos = F.in(kv ? 6 : 5) + (size_t)l * 2048; const float* w1 = F.in(kv ? 9 : 7) + (size_t)l * 2048 * 256;
    LAS float* red = (LAS float*)F.lds;
    __syncthreads();
    const int j = F.tid & 255, hf = F.tid >> 8; float s = 0.f;
#pragma unroll 8
    for (int ii = 0; ii < 32; ++ii) { const int i = part * 64 + hf * 32 + ii; s += pos[i] * w1[(size_t)i * 256 + j]; }
    red[F.tid] = s;
    __syncthreads();
    if (F.tid < 256) WSP(float, WS_CBIAS)[(size_t)w * 256 + F.tid] = red[F.tid] + red[F.tid + 256];
    __syncthreads();
}
__device__ __forceinline__ void cmp_finalize(const Frame& F, int l) {
    LAS float* hid = (LAS float*)F.lds + F.wave * 256; LAS float* biasL = (LAS float*)F.lds + 2048;
    __syncthreads();
    { const float* part = WSP(const float, WS_CBIAS) + (size_t)(F.tid >> 8) * 32 * 256 + (F.tid & 255); float sb = 0.f;
#pragma unroll 8
      for (int q = 0; q < 32; ++q) sb += part[q * 256];
      biasL[F.tid] = sb; }
    __syncthreads();
    for (int idx = F.bid * 8 + F.wave; idx < 2 * 4096; idx += F.G * 8) {
        const int kv = idx >> 12, bg = (idx >> 8) & 15, n = idx & 255;
        const bf16_t* PQ = WSP(const bf16_t, WS_PQ + (size_t)kv * 4 * MiB); const LAS float* bias = biasL + kv * 256;
        const float* w2 = F.in(kv ? 10 : 8) + (size_t)l * 256 * 64;
        float o = 0.f;
        if (n < 255) {
            asm volatile("s_waitcnt lgkmcnt(0)" ::: "memory");
#pragma unroll
            for (int i = 0; i < 4; ++i) { const int j = F.lane + 64 * i; hid[j] = gelu_tanh(bf2f(PQ[(size_t)(bg * 256 + n) * 512 + j]) + bf2f(PQ[(size_t)(bg * 256 + n + 1) * 512 + 256 + j]) + bias[j]); }
            asm volatile("s_waitcnt lgkmcnt(0)" ::: "memory");
#pragma unroll 8
            for (int j = 0; j < 256; ++j) o += hid[j] * w2[j * 64 + F.lane];
        }
        if (kv == 0) WSP(bf16_t, WS_KCC)[(size_t)(bg * 256 + n) * 64 + F.lane] = f2bf(o);
        else WSP(bf16_t, WS_VCCT)[(size_t)(bg * 64 + F.lane) * 256 + vperm(n)] = f2bf(o);
    }
}

struct AttnAcc { float m[2], l[2]; f32x4 o[2][4]; };
__device__ __forceinline__ void attn_init(AttnAcc& a) {
#pragma unroll
    for (int mt = 0; mt < 2; ++mt) { a.m[mt] = -1e30f; a.l[mt] = 0.f;
#pragma unroll
        for (int dt = 0; dt < 4; ++dt) a.o[mt][dt] = (f32x4){0.f, 0.f, 0.f, 0.f}; }
}
constexpr int KP = 160, VP = 160;
constexpr int TB_K0 = 0, TB_V0 = 10240, TB_K1 = 20480, TB_V1 = 30720, TB_END = 40960;
struct MaskInfo { int qb; int tq[2]; int nmax[2]; u64 selm[2]; };
template <int KIND> __device__ __forceinline__ bool mask_el(const MaskInfo& M, int mt, int tile, int kl) {
    if (KIND == 0) return tile * 64 + kl <= M.nmax[mt];
    if (KIND == 1) return kl <= M.tq[mt];
    if (KIND == 2) return tile == M.qb ? (kl <= M.tq[mt]) : (kl > M.tq[mt]);
    return true;
}
template <int MODE, int KIND, bool MASKED, int MT0 = 0, int MT1 = 2>
__device__ __forceinline__ void attn_tile(const LAS unsigned char* Kt, const LAS unsigned char* Vt, const bf16x8 (&qf)[2][2], AttnAcc& a, const MaskInfo& M, int tile, float cexp,
                                          int fr, int fq, LAS float* impA, LAS float* impB, int qbase) {
    f32x4 s[2][4];
#pragma unroll
    for (int nt = 0; nt < 4; ++nt) {
        const bf16x8 k0 = *(const LAS bf16x8*)(Kt + (16 * nt + fr) * KP + fq * 16), k1 = *(const LAS bf16x8*)(Kt + (16 * nt + fr) * KP + 64 + fq * 16);
#pragma unroll
        for (int mt = MT0; mt < MT1; ++mt) { f32x4 z = {0.f, 0.f, 0.f, 0.f}; z = __builtin_amdgcn_mfma_f32_16x16x32_bf16(k0, qf[mt][0], z, 0, 0, 0); z = __builtin_amdgcn_mfma_f32_16x16x32_bf16(k1, qf[mt][1], z, 0, 0, 0); s[mt][nt] = z;
#if PROBE_MFMA2X
            if (MODE == 0) { f32x4 z2 = {1.f, 0.f, 0.f, 0.f}; z2 = __builtin_amdgcn_mfma_f32_16x16x32_bf16(k1, qf[mt][0], z2, 0, 0, 0); z2 = __builtin_amdgcn_mfma_f32_16x16x32_bf16(k0, qf[mt][1], z2, 0, 0, 0); asm volatile("" :: "v"(z2)); }
#endif
        }
    }
#pragma unroll
    for (int mt = MT0; mt < MT1; ++mt) {
        bool flag = true;
        if (KIND == 1) flag = ((M.selm[mt] >> tile) & 1ull) != 0ull;
        float mx = -1e30f;
#pragma unroll
        for (int nt = 0; nt < 4; ++nt)
#pragma unroll
            for (int r = 0; r < 4; ++r) { float v = s[mt][nt][r]; if (MASKED) { v = mask_el<KIND>(M, mt, tile, 16 * nt + 4 * fq + r) ? v : -1e30f; s[mt][nt][r] = v; } mx = fmaxf(mx, v); }
        if (MODE != 2) {
            mx = xmax16(mx); mx = xmax32(mx);
            mx = flag ? mx : -1e30f;
            const float mnew = fmaxf(a.m[mt], mx), alpha = __builtin_amdgcn_exp2f((a.m[mt] - mnew) * cexp); a.m[mt] = mnew;
            const float mc = (flag && mnew > -1e29f) ? mnew * cexp : 1e30f;
            float ps = 0.f;
#pragma unroll
            for (int nt = 0; nt < 4; ++nt)
#pragma unroll
                for (int r = 0; r < 4; ++r) { const float pv = __builtin_amdgcn_exp2f(__builtin_fmaf(s[mt][nt][r], cexp, -mc));
#if PROBE_EXP2X
                    { float dummy = __builtin_amdgcn_exp2f(__builtin_fmaf(s[mt][nt][r], cexp * 0.5f, -mc)); asm volatile("" :: "v"(dummy)); }
#endif
                    s[mt][nt][r] = pv; ps += pv; }
            a.l[mt] = a.l[mt] * alpha + ps;
            if (MODE == 0) {
                if (__ballot(alpha != 1.0f) != 0ull) {
#pragma unroll
                    for (int dt = 0; dt < 4; ++dt) a.o[mt][dt] *= alpha;
                }
            }
        } else {
            const float mc = a.m[mt] > -1e29f ? a.m[mt] * cexp : 1e30f;
#pragma unroll
            for (int nt = 0; nt < 4; ++nt) {
#pragma unroll
                for (int r = 0; r < 4; ++r) s[mt][nt][r] = __builtin_amdgcn_exp2f(__builtin_fmaf(s[mt][nt][r], cexp, -mc)) * a.l[mt];
                float A4 = (s[mt][nt][0] + s[mt][nt][1]) + (s[mt][nt][2] + s[mt][nt][3]), B1 = s[mt][nt][3];
                A4 = quad_sum(A4); B1 = quad_sum(B1);
                if ((fr & 3) == 0) { const int ql = qbase + ((fr + 16 * mt) >> 2), J = 16 * tile + 4 * nt + fq; impA[ql * 64 + J] = A4; impB[ql * 64 + J] = B1; }
            }
        }
    }
    if (MODE != 1) {
#pragma unroll
        for (int ks = 0; ks < 2; ++ks) {
            bf16x8 pb[2];
#pragma unroll
            for (int mt = MT0; mt < MT1; ++mt) {
                const f32x4 p0 = s[mt][2 * ks], p1 = s[mt][2 * ks + 1];
                pb[mt] = pg8::cvt8_bf16(p0, p1);
            }
#pragma unroll
            for (int dt = 0; dt < 4; ++dt) {
                const bf16x8 vf = *(const LAS bf16x8*)(Vt + (16 * dt + fr) * VP + (32 * ks + 8 * fq) * 2);
#pragma unroll
                for (int mt = MT0; mt < MT1; ++mt) a.o[mt][dt] = __builtin_amdgcn_mfma_f32_16x16x32_bf16(vf, pb[mt], a.o[mt][dt], 0, 0, 0);
            }
        }
    }
}
template <int KIND> __device__ __forceinline__ bool tile_masked(int qb, int tile) {
    if (KIND == 0) { const int t0 = qb * 64; const int nmin = t0 >= 31 ? ((t0 - 31) >> 4) : -1; return tile * 64 + 63 > nmin; }
    if (KIND == 1) return tile == qb;
    if (KIND == 2) return tile == qb || tile == qb - 8;
    return false;
}
__device__ __forceinline__ int pop_tile(u64& m) { if (m == 0ull) return -1; const int t = __builtin_ctzll(m); m &= m - 1ull; return t; }
template <int MODE, int KIND>
__device__ __forceinline__ void attn_run(const Frame& F, u64 tmask, const bf16_t* Kb, const bf16_t* Vb, int vstride, const bf16x8 (&qf)[2][2], AttnAcc& a, const MaskInfo& M,
                                         LAS float* impA, LAS float* impB, int qbase) {
    const int fr = F.lane & 15, fq = F.lane >> 4, lr = F.tid >> 3, lc = F.tid & 7;
    const float cexp = 0.125f * 1.4426950408889634f;
    if (tmask == 0ull) return;
    const unsigned kofs = (unsigned)(lr * 64 + lc * 8), vofs = (unsigned)(lr * vstride + lc * 8);
    const int kl = lr * KP + lc * 16, vl = lr * VP + lc * 16;
#define AT_LOAD(R, t) do { R##k = *(const u32x4*)(Kb + (kofs + (unsigned)(t) * 4096u)); if (MODE != 1) R##v = *(const u32x4*)(Vb + (vofs + (unsigned)(t) * 64u)); } while (0)
#define AT_WRITE(R, kb, vb) do { *(LAS u32x4*)(F.lds + (kb) + kl) = R##k; if (MODE != 1) *(LAS u32x4*)(F.lds + (vb) + vl) = R##v; } while (0)
#define AT_CALL(MSK, A0, A1) attn_tile<MODE, KIND, MSK, A0, A1>(F.lds + (kb_), F.lds + (vb_), qf, a, M, (t_), cexp, fr, fq, impA, impB, qbase)
#define AT_COMPUTE(kb, vb, t) do { const int kb_ = (kb), vb_ = (vb), t_ = (t); bool n0 = true, n1 = true; \
        if (KIND == 1) { n0 = __ballot(((M.selm[0] >> t_) & 1ull) != 0ull) != 0ull; n1 = __ballot(((M.selm[1] >> t_) & 1ull) != 0ull) != 0ull; } \
        if (tile_masked<KIND>(M.qb, t_)) { if (n0 || n1) AT_CALL(true, 0, 2); }                        \
        else if (KIND != 1 || (n0 && n1)) AT_CALL(false, 0, 2); \
        else if (n0) AT_CALL(false, 0, 1); \
        else if (n1) AT_CALL(false, 1, 2); } while (0)
    u32x4 R0k = {0u, 0u, 0u, 0u}, R0v = {0u, 0u, 0u, 0u}, R1k = {0u, 0u, 0u, 0u}, R1v = {0u, 0u, 0u, 0u};
    int t0 = pop_tile(tmask), t1 = pop_tile(tmask), t2 = pop_tile(tmask), t3 = pop_tile(tmask);
    AT_LOAD(R0, t0);
    if (t1 >= 0) AT_LOAD(R1, t1);
    __syncthreads();
    AT_WRITE(R0, TB_K0, TB_V0);
    if (t2 >= 0) AT_LOAD(R0, t2);
    __syncthreads();
    for (;;) {
        AT_COMPUTE(TB_K0, TB_V0, t0);
        if (t1 < 0) break;
        AT_WRITE(R1, TB_K1, TB_V1);
        if (t3 >= 0) AT_LOAD(R1, t3);
        __syncthreads();
        t0 = t1; t1 = t2; t2 = t3; t3 = pop_tile(tmask);
        AT_COMPUTE(TB_K1, TB_V1, t0);
        if (t1 < 0) break;
        AT_WRITE(R0, TB_K0, TB_V0);
        if (t3 >= 0) AT_LOAD(R0, t3);
        __syncthreads();
        t0 = t1; t1 = t2; t2 = t3; t3 = pop_tile(tmask);
    }
    if (MODE != 1) asm volatile("s_nop 15\n\ts_nop 15\n\ts_nop 15\n\ts_nop 15\n\ts_nop 15\n\ts_nop 15\n\ts_nop 15\n\ts_nop 15"
                                : "+v"(a.o[0][0]), "+v"(a.o[0][1]), "+v"(a.o[0][2]), "+v"(a.o[0][3]), "+v"(a.o[1][0]), "+v"(a.o[1][1]), "+v"(a.o[1][2]), "+v"(a.o[1][3]));
#undef AT_LOAD
#undef AT_WRITE
#undef AT_COMPUTE
#undef AT_CALL
}

__device__ __forceinline__ void nsa_item(const Frame& F, int b, int g, int qb) {
    const int fr = F.lane & 15, fq = F.lane >> 4, t0 = qb * 64, qbase = 8 * F.wave;
    LAS float* impA = (LAS float*)(F.lds + 40960); LAS float* impB = (LAS float*)(F.lds + 40960 + 16384);
    LAS u64* selL = (LAS u64*)(F.lds + 106496); LAS u64* worL = (LAS u64*)(F.lds + 106496 + 512);
    const bf16_t* Q = WSP(const bf16_t, WS_Q); const bf16_t* NG = WSP(const bf16_t, WS_NG);
    const float* ropec = WSP(const float, WS_ROPE); const float* ropes = ropec + 4096 * 32;
    int ql[2]; const int r = fr & 3, head = g * 4 + r;
    bf16x8 qf[2][2];
    MaskInfo M; M.qb = qb;
#pragma unroll
    for (int mt = 0; mt < 2; ++mt) {
        ql[mt] = qbase + ((fr + 16 * mt) >> 2); M.tq[mt] = ql[mt]; const int t = t0 + ql[mt]; M.nmax[mt] = t >= 31 ? ((t - 31) >> 4) : -1; M.selm[mt] = 0ull;
#pragma unroll
        for (int ks = 0; ks < 2; ++ks) qf[mt][ks] = *(const bf16x8*)(Q + ((size_t)(b * 4096 + t) * 512 + head * 64 + ks * 32 + fq * 8));
    }
    LAS float* ysl = (LAS float*)(F.lds + 40960) + F.tid;
    const int ntc = (4 * qb + 2) / 64 + 1; const u64 cmask = (ntc >= 64) ? ~0ull : ((1ull << ntc) - 1ull);
    const bf16_t* KCc = WSP(const bf16_t, WS_KCC) + (size_t)((b * 2 + g) * 256) * 64; const bf16_t* VCt = WSP(const bf16_t, WS_VCCT) + (size_t)((b * 2 + g) * 64) * 256;
    AttnAcc a; attn_init(a);
    attn_run<1, 0>(F, cmask, KCc, VCt, 256, qf, a, M, impA, impB, qbase);
#pragma unroll
    for (int mt = 0; mt < 2; ++mt) { float L = a.l[mt]; L = xsum16(L); L = xsum32(L); a.l[mt] = L > 0.f ? 1.0f / L : 0.f; }
    attn_run<2, 0>(F, cmask, KCc, VCt, 256, qf, a, M, impA, impB, qbase);
    __syncthreads();
    {
        u64 wor = 0ull;
        for (int qi = 0; qi < 8; ++qi) {
            const int q = qbase + qi, J = F.lane; u64 m;
            if (qb < 16) m = (2ull << qb) - 1ull;
            else {
                const float val = impA[q * 64 + J] + (J > 0 ? impB[q * 64 + (J > 0 ? J - 1 : 0)] : 0.f);
                const bool forced = (J == 0) || (J == qb) || (J == qb - 1);
                const unsigned key = (J <= qb) ? (forced ? 0x7f000000u : (val > 0.f ? __float_as_uint(val) : 0u)) : 0u;
                const u64 valid = (2ull << qb) - 1ull;
                unsigned thr = 0u;
                for (int bit = 30; bit >= 0; --bit) { const unsigned cand = thr | (1u << bit); if (__builtin_popcountll(__ballot(key >= cand) & valid) >= 16) thr = cand; }
                const u64 gt = __ballot(key > thr) & valid, eq = __ballot(key == thr) & valid; const int need = 16 - __builtin_popcountll(gt);
                const bool sel = (key > thr) || (key == thr && __builtin_popcountll(eq & ((1ull << J) - 1ull)) < need);
                m = __ballot(sel && J <= qb);
            }
            if (F.lane == 0) selL[q] = m;
            wor |= m;
        }
        if (F.lane == 0) worL[F.wave] = wor;
    }
    __syncthreads();
    u64 umask = 0ull;
#pragma unroll
    for (int w = 0; w < 8; ++w) umask |= worL[w];
    M.selm[0] = selL[ql[0]]; M.selm[1] = selL[ql[1]];
#pragma unroll
    for (int mt = 0; mt < 2; ++mt) { const float gt = sigmoidf_(bf2f(NG[(size_t)(b * 4096 + t0 + ql[mt]) * 32 + head * 3 + 0]));
#pragma unroll
        for (int dt = 0; dt < 4; ++dt)
#pragma unroll
            for (int r4 = 0; r4 < 4; ++r4) ysl[((mt * 4 + dt) * 4 + r4) * 512] = a.o[mt][dt][r4] * gt; }
#pragma unroll
    for (int mt = 0; mt < 2; ++mt) {
        const int t = t0 + ql[mt]; const f32x4 c0 = *(const f32x4*)(ropec + t * 32 + 8 * fq), c1 = *(const f32x4*)(ropec + t * 32 + 8 * fq + 4), s0 = *(const f32x4*)(ropes + t * 32 + 8 * fq), s1 = *(const f32x4*)(ropes + t * 32 + 8 * fq + 4);
        bf16x8 r1, r2;
#pragma unroll
        for (int j = 0; j < 8; ++j) { const float x1 = bf2f((bf16_t)qf[mt][0][j]), x2 = bf2f((bf16_t)qf[mt][1][j]); const float cs = j < 4 ? c0[j & 3] : c1[j & 3], sn = j < 4 ? s0[j & 3] : s1[j & 3];
            r1[j] = (short)f2bf(x1 * cs - x2 * sn); r2[j] = (short)f2bf(x1 * sn + x2 * cs); }
        qf[mt][0] = r1; qf[mt][1] = r2;
    }
    const size_t kvoff = (size_t)((b * 2 + g) * 4096) * 64, vtoff = (size_t)((b * 2 + g) * 64) * 4096;
    attn_init(a);
    attn_run<0, 1>(F, umask, WSP(const bf16_t, WS_KS) + kvoff, WSP(const bf16_t, WS_VST) + vtoff, 4096, qf, a, M, impA, impB, qbase);
#pragma unroll
    for (int mt = 0; mt < 2; ++mt) { float L = a.l[mt]; L = xsum16(L); L = xsum32(L);
        const float sc = (L > 0.f ? 1.0f / L : 0.f) * sigmoidf_(bf2f(NG[(size_t)(b * 4096 + t0 + ql[mt]) * 32 + head * 3 + 1]));
#pragma unroll
        for (int dt = 0; dt < 4; ++dt)
#pragma unroll
            for (int r4 = 0; r4 < 4; ++r4) ysl[((mt * 4 + dt) * 4 + r4) * 512] += a.o[mt][dt][r4] * sc; }
    const int wlo = qb >= 8 ? qb - 8 : 0; const u64 wmask = ((2ull << qb) - 1ull) & ~((1ull << wlo) - 1ull);
    attn_init(a);
    attn_run<0, 2>(F, wmask, WSP(const bf16_t, WS_KW) + kvoff, WSP(const bf16_t, WS_VWT) + vtoff, 4096, qf, a, M, impA, impB, qbase);
#pragma unroll
    for (int mt = 0; mt < 2; ++mt) { float L = a.l[mt]; L = xsum16(L); L = xsum32(L);
        const float sc = (L > 0.f ? 1.0f / L : 0.f) * sigmoidf_(bf2f(NG[(size_t)(b * 4096 + t0 + ql[mt]) * 32 + head * 3 + 2]));
#pragma unroll
        for (int dt = 0; dt < 4; ++dt)
#pragma unroll
            for (int r4 = 0; r4 < 4; ++r4) a.o[mt][dt][r4] = ysl[((mt * 4 + dt) * 4 + r4) * 512] + a.o[mt][dt][r4] * sc; }
    bf16_t* Y = WSP(bf16_t, WS_YCAT);
#pragma unroll
    for (int mt = 0; mt < 2; ++mt)
#pragma unroll
        for (int dt = 0; dt < 4; ++dt) *(u32x2*)(Y + ((size_t)(b * 4096 + t0 + ql[mt]) * 1024 + head * 64 + 16 * dt + 4 * fq)) = pg8::cvt4_bf16(a.o[mt][dt]);
    __syncthreads();
}

__device__ __forceinline__ void xa_item(const Frame& F, int item) {
    const int b = item >> 6, head = (item >> 4) & 3, qt = item & 15, fr = F.lane & 15, fq = F.lane >> 4, t0 = qt * 256 + 32 * F.wave;
    const bf16_t* QX = WSP(const bf16_t, WS_QX);
    bf16x8 qf[2][2];
#pragma unroll
    for (int mt = 0; mt < 2; ++mt)
#pragma unroll
        for (int ks = 0; ks < 2; ++ks) qf[mt][ks] = *(const bf16x8*)(QX + ((size_t)(b * 4096 + t0 + fr + 16 * mt) * 256 + head * 64 + ks * 32 + fq * 8));
    MaskInfo M; M.qb = 0; M.tq[0] = M.tq[1] = 0; M.nmax[0] = M.nmax[1] = 0; M.selm[0] = M.selm[1] = 0ull;
    AttnAcc a; attn_init(a);
    attn_run<0, 3>(F, 0xFull, WSP(const bf16_t, WS_KX) + (size_t)((b * 4 + head) * 256) * 64, WSP(const bf16_t, WS_VXT) + (size_t)((b * 4 + head) * 64) * 256, 256, qf, a, M, nullptr, nullptr, 0);
    bf16_t* O = WSP(bf16_t, WS_XAO);
#pragma unroll
    for (int mt = 0; mt < 2; ++mt) { float L = a.l[mt]; L = xsum16(L); L = xsum32(L); const float sc = L > 0.f ? 1.0f / L : 0.f;
#pragma unroll
        for (int dt = 0; dt < 4; ++dt) *(u32x2*)(O + ((size_t)(b * 4096 + t0 + fr + 16 * mt) * 256 + head * 64 + 16 * dt + 4 * fq)) = pg8::cvt4_bf16(a.o[mt][dt] * sc); }
    __syncthreads();
}

template <class Fn> __device__ __forceinline__ void run_gemm(const Frame& F, const bf16_t* A, const bf16_t* Bt, int M, int N, int K, int G, int c, const Fn& fn) {
    pg8::Gemm g{A, Bt, M, N, K}; pg8::StaticOrder S; S.init(M, N, G, c); Epi8<Fn> E{fn};
    pg8::gemm_phase<Epi8<Fn>, pg8::StaticOrder>((PG8_LAS unsigned char*)F.lds, g, S, E, F.tid);
}

__global__ void __launch_bounds__(NTHR, 2) trunk_fwd(Params prm) {
    extern __shared__ __attribute__((aligned(16))) unsigned char lds_raw[];
    Frame F0; F0.kp = (const __attribute__((address_space(4))) char*)__builtin_amdgcn_kernarg_segment_ptr(); F0.ws = prm.ws; F0.lds = (LAS unsigned char*)lds_raw;
    F0.tid = threadIdx.x; F0.lane = F0.tid & 63; F0.wave = __builtin_amdgcn_readfirstlane(F0.tid >> 6); F0.bid = blockIdx.x; F0.G = gridDim.x;
    const int lo = prm.ph_lo, hi = prm.ph_hi;
    if (F0.tid < 8) ((LAS unsigned*)(F0.lds + LDS_CTL_OFF))[F0.tid] = 0u;
    __syncthreads();
    XcdBarrier bar; bar.bar = F0.ctl(); bar.x = 0; bar.st = nullptr;
    if (hi - lo > 1) bar = xcd_barrier_post(F0.ctl(), (volatile LAS unsigned*)(F0.lds + LDS_CTL_OFF));
#define IN(k) (lo <= (k) && (k) < hi)
#define SEAM(k) do { if (IN(k) && IN((k) + 1)) xcd_barrier(bar); } while (0)
#define PHASE_FRAME Frame F = F0; LAUNDER(F); asm volatile("" : "+v"(F.tid), "+s"(F.bid), "+s"(F.G), "+s"(F.wave)); F.lane = F.tid & 63
    if (PON(0) && IN(0)) {
        PHASE_FRAME;
        float* rc = WSP(float, WS_ROPE); float* rs = rc + 4096 * 32;
        for (int i = F.bid * NTHR + F.tid; i < 4096 * 32; i += F.G * NTHR) { const int t = i >> 5, j = i & 31; const float inv = 1.0f / powf(10000.0f, (float)j / 32.0f); const float ang = (float)t * inv;
            float sn, cs; sincosf(ang, &sn, &cs); rc[i] = cs; rs[i] = sn; }
        conv_layer(F, 0);
        norm_rows(F, TOK, F.in(0), nullptr, nullptr, nullptr, F.x16(), nullptr, nullptr, F.in(2), WSP(bf16_t, WS_H));
    }
    SEAM(0);
    for (int l = 0; l < DEPTH; ++l) {
        const int g0 = 1 + l * PH_PER_LAYER;
        if (PON(1) && IN(g0 + 0)) for (int rep = 0; rep < REPS[1]; ++rep) {
            PHASE_FRAME;
            FIn1 fn{WSP(bf16_t, WS_Q), WSP(bf16_t, WS_KC), WSP(bf16_t, WS_VC), WSP(bf16_t, WS_KS), WSP(bf16_t, WS_KW), WSP(bf16_t, WS_VST), WSP(bf16_t, WS_VWT), WSP(bf16_t, WS_ZR), WSP(bf16_t, WS_ZS), WSP(bf16_t, WS_NG),
                    WSP(const float, WS_ROPE), WSP(const float, WS_ROPE) + 4096 * 32};
            run_gemm(F, WSP(const bf16_t, WS_H), WSP(const bf16_t, W_IN1), TOK, 2816, 1024, F.G, F.bid, fn);
            if (rep == 0 && F.G == 256 && F.bid >= 128 && F.bid < 192) { PHASE_FRAME; cmp_bias(F, l, F.bid - 128); }
        }
        SEAM(g0 + 0);
        if (PON(2) && IN(g0 + 1)) for (int rep = 0; rep < REPS[2]; ++rep) {
            { PHASE_FRAME;
              if (F.bid < 32) run_gemm(F, WSP(const bf16_t, WS_KC), WSP(const bf16_t, W_C1K), 4096, 512, 1024, 32, F.bid, FStore{WSP(bf16_t, WS_PQ), 512});
              else if (F.bid < 64) run_gemm(F, WSP(const bf16_t, WS_VC), WSP(const bf16_t, W_C1V), 4096, 512, 1024, 32, F.bid - 32, FStore{WSP(bf16_t, WS_PQ + 4 * MiB), 512});
              else if (F.bid < 128 && F.G != 256) cmp_bias(F, l, F.bid - 64); }
            for (;;) {
                PHASE_FRAME;
                const int job = next_job(F, F.ctl() + CTL_Q0 + 64 * ((l * 4 + 0) * 4 + rep));
                if (job >= 256 + 512) break;
                if (job < 256) s5_pass1(F, l, job * 8 + F.wave);
                else rwkv_lin_tile(F, l, job - 256);
            }
        }
        SEAM(g0 + 1);
        if (PON(3) && IN(g0 + 2)) for (int rep = 0; rep < REPS[3]; ++rep) {
            { PHASE_FRAME; run_gemm(F, WSP(const bf16_t, WS_LIN), WSP(const bf16_t, W_LORA), TOK, 768, 256, F.G, F.bid, FLora{WSP(bf16_t, WS_LW), WSP(bf16_t, WS_LA), WSP(bf16_t, WS_RG)}); }
            { PHASE_FRAME; cmp_finalize(F, l); }
        }
        SEAM(g0 + 2);
        if (PON(4) && IN(g0 + 3)) for (int rep = 0; rep < REPS[4]; ++rep) { PHASE_FRAME; __syncthreads(); for (int it = F.bid * 8 + F.wave; it < 32 * 256; it += F.G * 8) rwkv_chunk_prep(F, l, it); }
        SEAM(g0 + 3);
        if (PON(5) && IN(g0 + 4)) for (int rep = 0; rep < REPS[5]; ++rep) {
#if !defined(SUB) || SUB == 1
            if (F0.bid < 32) for (int ra = 0; ra < REP_P4A; ++ra) { PHASE_FRAME; rwkv_chunk_scan(F, F.bid); }
#endif
            for (int rq = 0; rq < REP_P4B; ++rq)
            for (;;) {
                PHASE_FRAME;
                const int job = next_job(F, F.ctl() + CTL_Q0 + 64 * ((l * 4 + 1) * 4 + rep * 2 + rq));
                if (job >= 1024 + 256) break;
#if !defined(SUB) || SUB == 2
                if (job < 1024) { const int qb = 63 - (job >> 4), bg = job & 15; for (int rr = 0; rr < REP_NSA; ++rr) nsa_item(F, bg >> 1, bg & 1, qb); }
#endif
#if !defined(SUB) || SUB == 3
                if (job >= 1024) { __syncthreads(); for (int rr = 0; rr < REP_S5P2; ++rr) s5_pass2(F, l, (job - 1024) * 8 + F.wave); }
#endif
            }
        }
        SEAM(g0 + 4);
        if (PON(6) && IN(g0 + 5)) for (int rep = 0; rep < REPS[6]; ++rep) {
#if !defined(SUB) || SUB == 1
            if (F0.bid < 128) { PHASE_FRAME; run_gemm(F, WSP(const bf16_t, WS_YS5G), WSP(const bf16_t, W_GLU), TOK, 256, 256, 128, F.bid, FGluMul{WSP(const bf16_t, WS_YS5G), WSP(bf16_t, WS_YCAT) + 768, 256, 1024}); }
#endif
#if !defined(SUB) || SUB == 2
            { PHASE_FRAME; rwkv_post(F, l); }
#endif
        }
        SEAM(g0 + 5);
        if (PON(7) && IN(g0 + 6)) for (int rep = 0; rep < REPS[7]; ++rep) {
            { PHASE_FRAME; run_gemm(F, WSP(const bf16_t, WS_H), WSP(const bf16_t, W_MG), TOK, 3072, 1024, F.G, F.bid, FSigmoid{WSP(bf16_t, WS_G), 3072}); }
        }
        SEAM(g0 + 6);
        if (PON(8) && IN(g0 + 7)) for (int rep = 0; rep < REPS[8]; ++rep) {
            { PHASE_FRAME;
              pg8::Gemm g{WSP(const bf16_t, WS_YCAT), WSP(const bf16_t, W_UPN), TOK, 1024, 1024}; pg8::StaticOrder S; S.init(TOK, 1024, F.G, F.bid);
              Epi8<FMulStore> E{FMulStore{WSP(const bf16_t, WS_G), WSP(bf16_t, WS_MERGED)}};
              MergeHook H{WSP(const bf16_t, WS_G)};
              pg8::gemm_phase<Epi8<FMulStore>, pg8::StaticOrder, MergeHook>((PG8_LAS unsigned char*)F.lds, g, S, E, F.tid, H); }
        }
        SEAM(g0 + 7);
        if (PON(9) && IN(g0 + 8)) for (int rep = 0; rep < REPS[9]; ++rep) { PHASE_FRAME; run_gemm(F, WSP(const bf16_t, WS_MERGED), WSP(const bf16_t, W_OUT), TOK, 1024, 1024, F.G, F.bid, FStore{WSP(bf16_t, WS_YOUT), 1024}); }
        SEAM(g0 + 8);
        if (PON(10) && IN(g0 + 9)) {
            PHASE_FRAME; const float* gains = F.in(2) + (size_t)l * 6 * 1024;
            norm_rows(F, TOK, nullptr, F.x16(), WSP(const bf16_t, WS_YOUT), gains + 1024, F.x16(), nullptr, nullptr, gains + 2048, WSP(bf16_t, WS_H));
            norm_rows(F, NB * 256, F.in(1), nullptr, nullptr, nullptr, nullptr, nullptr, nullptr, F.in(3) + (size_t)l * 1024, WSP(bf16_t, WS_MEMN));
        }
        SEAM(g0 + 9);
        if (PON(11) && IN(g0 + 10)) for (int rep = 0; rep < REPS[11]; ++rep) {
            PHASE_FRAME;
            if (F.bid < 128) run_gemm(F, WSP(const bf16_t, WS_H), WSP(const bf16_t, W_XQ), TOK, 256, 1024, 128, F.bid, FStore{WSP(bf16_t, WS_QX), 256});
            else if (F.bid < 144) run_gemm(F, WSP(const bf16_t, WS_MEMN), WSP(const bf16_t, W_XKV), NB * 256, 512, 1024, 16, F.bid - 128, FXKV{WSP(bf16_t, WS_KX), WSP(bf16_t, WS_VXT)});
        }
        SEAM(g0 + 10);
        if (PON(12) && IN(g0 + 11)) for (int rep = 0; rep < REPS[12]; ++rep) { PHASE_FRAME; for (int it = F.bid; it < 512; it += F.G) xa_item(F, it); }
        SEAM(g0 + 11);
        if (PON(13) && IN(g0 + 12)) for (int rep = 0; rep < REPS[13]; ++rep) { PHASE_FRAME; run_gemm(F, WSP(const bf16_t, WS_XAO), WSP(const bf16_t, W_XO), TOK, 1024, 256, F.G, F.bid, FStore{WSP(bf16_t, WS_YOUT), 1024}); }
        SEAM(g0 + 12);
        if (PON(14) && IN(g0 + 13)) { PHASE_FRAME; const float* gains = F.in(2) + (size_t)l * 6 * 1024;
            norm_rows(F, TOK, nullptr, F.x16(), WSP(const bf16_t, WS_YOUT), gains + 3 * 1024, l + 1 < DEPTH ? F.x16() : WSP(bf16_t, WS_XLAST), nullptr, nullptr, gains + 4 * 1024, WSP(bf16_t, WS_H)); }
        SEAM(g0 + 13);
        if (PON(15) && IN(g0 + 14)) for (int rep = 0; rep < REPS[15]; ++rep) { PHASE_FRAME; run_gemm(F, WSP(const bf16_t, WS_H), WSP(const bf16_t, W_GU), TOK, 2 * DFF, 1024, F.G, F.bid, FSwiGLU{WSP(bf16_t, WS_A2), DFF}); }
        SEAM(g0 + 14);
        if (PON(16) && IN(g0 + 15)) for (int rep = 0; rep < REPS[16]; ++rep) { PHASE_FRAME; run_gemm(F, WSP(const bf16_t, WS_A2), WSP(const bf16_t, W_DN), TOK, 1024, DFF, F.G, F.bid, FStore{WSP(bf16_t, WS_YOUT), 1024}); }
        SEAM(g0 + 15);
        if (PON(17) && IN(g0 + 16)) {
            PHASE_FRAME; const float* gains = F.in(2) + (size_t)l * 6 * 1024;
            for (int rep = 1; rep < REPS[17]; ++rep) conv_layer(F, l);
            if (l + 1 < DEPTH) { norm_rows(F, TOK, nullptr, F.x16(), WSP(const bf16_t, WS_YOUT), gains + 5 * 1024, F.x16(), nullptr, nullptr, gains + 6 * 1024, WSP(bf16_t, WS_H)); conv_layer(F, l + 1); }
            else norm_rows(F, TOK, nullptr, WSP(const bf16_t, WS_XLAST), WSP(const bf16_t, WS_YOUT), gains + 5 * 1024, nullptr, F.out(), F.out() + (size_t)TOK * DM / 2, nullptr, nullptr);
        }
        SEAM(g0 + 16);
    }
#undef IN
#undef SEAM
}

extern "C" void kernel_launch(void* const* d_in, const int* in_sizes, int n_in, void* d_out, int out_size, void* d_ws, size_t ws_size, hipStream_t stream) {
    static int grid = 0;
    if (grid == 0) {
        if (n_in != 42 || out_size != TOK * DM || ws_size < WS_END) { fprintf(stderr, "kernel_launch: unexpected shapes (n_in %d out %d ws %zu)\n", n_in, out_size, ws_size); grid = -1; return; }
        int dev = 0, cus = 0, per_cu = 0;
        if (hipGetDevice(&dev) != hipSuccess || hipDeviceGetAttribute(&cus, hipDeviceAttributeMultiprocessorCount, dev) != hipSuccess) { grid = -1; return; }
        if (hipFuncSetAttribute((const void*)trunk_fwd, hipFuncAttributeMaxDynamicSharedMemorySize, LDS_BYTES) != hipSuccess) { fprintf(stderr, "kernel_launch: hipFuncSetAttribute failed\n"); grid = -1; return; }
        if (hipOccupancyMaxActiveBlocksPerMultiprocessor(&per_cu, (const void*)trunk_fwd, NTHR, LDS_BYTES) != hipSuccess || per_cu < 1) fprintf(stderr, "kernel_launch: occupancy query reports %d\n", per_cu);
        (void)hipGetLastError();
        grid = cus;
    }
    if (grid < 0) return;
    (void)hipMemsetAsync((char*)d_ws + WS_CTL, 0, CTL_BYTES, stream);
    Params p{};
    for (int i = 0; i < 42; ++i) p.in[i] = (const float*)d_in[i];
    p.out = (float*)d_out; p.ws = (unsigned char*)d_ws;
#if MK_N_LAUNCHES == 1
    p.ph_lo = 0; p.ph_hi = N_PHASES;
    hipLaunchKernelGGL(trunk_fwd, dim3(grid), dim3(NTHR), LDS_BYTES, stream, p);
#else
    for (int ph = 0; ph < N_PHASES; ++ph) { p.ph_lo = ph; p.ph_hi = ph + 1; hipLaunchKernelGGL(trunk_fwd, dim3(grid), dim3(NTHR), LDS_BYTES, stream, p); }
#endif
}
```

```cpp
#include <hip/hip_runtime.h>
#include <stdint.h>
#include <cstdio>

#ifndef MK_N_LAUNCHES
#define MK_N_LAUNCHES 1
#endif

#ifndef ONLY_PHASE
#define ONLY_PHASE -1
#endif
#define PON(k) (ONLY_PHASE < 0 || ONLY_PHASE == (k))
#define LAS __attribute__((address_space(3)))
typedef unsigned short bf16_t;
typedef short bf16x8 __attribute__((ext_vector_type(8)));
typedef short bf16x4 __attribute__((ext_vector_type(4)));
typedef float f32x4 __attribute__((ext_vector_type(4)));
typedef float f32x2 __attribute__((ext_vector_type(2)));
typedef unsigned u32x4 __attribute__((ext_vector_type(4)));
typedef unsigned u32x2 __attribute__((ext_vector_type(2)));
typedef unsigned long long u64;

constexpr int NB = 8, SEQ = 4096, DM = 1024, TOK = NB * SEQ, DEPTH = 4;
constexpr int INW = 5656, DFF = 2816;
constexpr int NTHR = 512;
constexpr int PH_PER_LAYER = 17, N_PHASES = 1 + DEPTH * PH_PER_LAYER;
constexpr int REPS[18] = {1, 1, 1, 1, 1, 1, 1, 1, 1, 1, 1, 1, 1, 1, 1, 1, 1, 1};
constexpr int REP_P4A = 1, REP_P4B = 1;
#define PROBE_EXP2X 0
#define PROBE_MFMA2X 0
constexpr int REP_NSA = 1, REP_S5P2 = 1, REP_PREP = 1, REP_S5P1 = 1, REP_CMPG = 1;

constexpr size_t MiB = 1ull << 20;
constexpr size_t WS_CTL = 0;
constexpr size_t CTL_BYTES = 32768;
constexpr size_t WS_ROPE = 1 * MiB;
constexpr size_t WS_MISC = 2 * MiB;
constexpr size_t WS_KCC = WS_MISC;
constexpr size_t WS_VCCT = WS_MISC + 512 * 1024;
constexpr size_t WS_XEND = WS_MISC + 1 * MiB;
constexpr size_t WS_KX = WS_MISC + 2 * MiB;
constexpr size_t WS_VXT = WS_MISC + 3 * MiB;
constexpr size_t WS_MEMN = WS_MISC + 4 * MiB;
constexpr size_t WS_BONUS = WS_MISC + 8 * MiB;
constexpr size_t WS_CBIAS = WS_MISC + 9 * MiB;
constexpr size_t WS_W = 18 * MiB;
constexpr size_t W_IN1 = WS_W + 0, W_MG = WS_W + 6 * MiB, W_UPN = WS_W + 12 * MiB, W_UPR = WS_W + 13 * MiB, W_UPS = WS_W + 13 * MiB + 512 * 1024,
                 W_OUT = WS_W + 14 * MiB, W_C1K = WS_W + 16 * MiB, W_C1V = WS_W + 17 * MiB, W_XQ = WS_W + 18 * MiB, W_XKV = WS_W + 19 * MiB,
                 W_XO = WS_W + 20 * MiB, W_GLU = WS_W + 21 * MiB, W_LORA = WS_W + 21 * MiB + 512 * 1024, W_GU = WS_W + 22 * MiB, W_DN = WS_W + 33 * MiB,
                 W_C2K = WS_W + 39 * MiB + 131072, W_C2V = WS_W + 39 * MiB + 131072 + 32768;
constexpr size_t WS_H = 58 * MiB;
constexpr size_t WS_Q = 122 * MiB, WS_KC = 154 * MiB, WS_VC = 162 * MiB, WS_KS = 170 * MiB, WS_KW = 178 * MiB, WS_YS5 = 186 * MiB,
                 WS_VST = 202 * MiB, WS_VWT = 210 * MiB, WS_NG = 218 * MiB, WS_ZR = 220 * MiB, WS_ZS = 284 * MiB,
                 WS_YSCAN = 300 * MiB, WS_YS5G = 332 * MiB, WS_LIN = 364 * MiB, WS_RG = 380 * MiB, WS_LW = 396 * MiB, WS_LA = 412 * MiB,
                 WS_PQ = 428 * MiB, WS_END = 508 * MiB;
constexpr size_t WS_CS_AR = 476 * MiB, WS_CS_BKT = 348 * MiB, WS_CS_VMT = 154 * MiB, WS_CS_AAK = 186 * MiB, WS_CS_ARBK = 190 * MiB, WS_CS_GAM = 198 * MiB, WS_CS_MM = 428 * MiB;
constexpr size_t WS_XLAST = 300 * MiB;
constexpr size_t WS_YCAT = 220 * MiB;
constexpr size_t WS_G = 284 * MiB  , WS_MERGED = 122 * MiB, WS_YOUT = 364 * MiB;
constexpr size_t WS_QX = 122 * MiB, WS_XAO = 138 * MiB, WS_A2 = 122 * MiB;
constexpr int CTL_Q0 = 4096;

constexpr int LDS_STAGE = 131072;
constexpr int LDS_CTL_OFF = LDS_STAGE;
constexpr int LDS_BYTES = LDS_STAGE + 256;

struct Params { const float* in[42]; float* out; unsigned char* ws; int ph_lo, ph_hi; };

__device__ __forceinline__ float bf2f(bf16_t b) { return __uint_as_float(((unsigned)b) << 16); }
__device__ __forceinline__ float bflo(unsigned w) { return __uint_as_float(w << 16); }
__device__ __forceinline__ float bfhi(unsigned w) { return __uint_as_float(w & 0xffff0000u); }
__device__ __forceinline__ bf16_t f2bf(float f) { unsigned u = __float_as_uint(f); u += 0x7FFFu + ((u >> 16) & 1u); return (bf16_t)(u >> 16); }
__device__ __forceinline__ unsigned pk2(float lo, float hi) { return (unsigned)f2bf(lo) | ((unsigned)f2bf(hi) << 16); }
__device__ __forceinline__ float sigmoidf_(float x) { return __builtin_amdgcn_rcpf(1.0f + __expf(-x)); }
__device__ __forceinline__ float gelu_tanh(float x) { const float u = 0.7978845608028654f * (x + 0.044715f * x * x * x); return x * sigmoidf_(2.0f * u); }
__device__ __forceinline__ float tanh_fast(float z) { return 2.0f * sigmoidf_(2.0f * z) - 1.0f; }
template <int CTRL> __device__ __forceinline__ float dpp_mov(float x) { return __int_as_float(__builtin_amdgcn_update_dpp(0, __float_as_int(x), CTRL, 0xF, 0xF, false)); }
__device__ __forceinline__ float quad_sum(float x) { x += dpp_mov<0xB1>(x); x += dpp_mov<0x4E>(x); return x; }
__device__ __forceinline__ float row16_sum(float x) { x = quad_sum(x); x += dpp_mov<0x141>(x); x += dpp_mov<0x140>(x); return x; }

__device__ __forceinline__ float xmax16(float x) { const unsigned u = __float_as_uint(x); auto r = __builtin_amdgcn_permlane16_swap(u, u, false, false); return fmaxf(__uint_as_float(r[0]), __uint_as_float(r[1])); }
__device__ __forceinline__ float xmax32(float x) { const unsigned u = __float_as_uint(x); auto r = __builtin_amdgcn_permlane32_swap(u, u, false, false); return fmaxf(__uint_as_float(r[0]), __uint_as_float(r[1])); }
__device__ __forceinline__ float xsum16(float x) { const unsigned u = __float_as_uint(x); auto r = __builtin_amdgcn_permlane16_swap(u, u, false, false); return __uint_as_float(r[0]) + __uint_as_float(r[1]); }
__device__ __forceinline__ float xsum32(float x) { const unsigned u = __float_as_uint(x); auto r = __builtin_amdgcn_permlane32_swap(u, u, false, false); return __uint_as_float(r[0]) + __uint_as_float(r[1]); }

__device__ __forceinline__ float wave_sum(float v) { v = row16_sum(v); v = xsum16(v); return xsum32(v); }

#define XB_TMO      128
#define XB_XCNT(j)  (256  + 64 * (j))
#define XB_XSUB(j)  (1280 + 64 * (j))
#define XB_XGEN(j)  (2304 + 64 * (j))
#define XB_TOP      3328
#define XB_TOPGEN   3392
#define XCD_BAR_WORDS 3456
#define XB_SPIN_CAP (1u << 18)
__device__ __forceinline__ unsigned xb_ld(unsigned* p)              { return __hip_atomic_load(p, __ATOMIC_RELAXED, __HIP_MEMORY_SCOPE_AGENT); }
__device__ __forceinline__ unsigned xb_add(unsigned* p, unsigned v) { return __hip_atomic_fetch_add(p, v, __ATOMIC_RELAXED, __HIP_MEMORY_SCOPE_AGENT); }
__device__ __forceinline__ unsigned xb_xcc_id() { return (unsigned)__builtin_amdgcn_s_getreg((3 << 11) | 20) & 0xFu; }
#define XB_SPIN(cond, bar) do { unsigned _sp = 0; while (cond) { __builtin_amdgcn_s_sleep(1); \
    if ((++_sp & 255u) == 0u) { if (xb_ld(&(bar)[XB_TMO])) break; if (_sp > XB_SPIN_CAP) { atomicAdd(&(bar)[XB_TMO], 1u); break; } } } } while (0)
struct XcdBarrier { unsigned* bar; unsigned x; volatile LAS unsigned* st; };
__device__ __forceinline__ XcdBarrier xcd_barrier_post(unsigned* bar, volatile LAS unsigned* st) {
    XcdBarrier b; b.bar = bar; b.x = xb_xcc_id(); b.st = st;
    if (threadIdx.x == 0) (void)xb_add(&bar[XB_XCNT(b.x)], 1u);
    return b;
}
__device__ __forceinline__ void xcd_barrier_complete(unsigned* bar, unsigned x, unsigned& nloc, unsigned& nx) {
    const unsigned G = gridDim.x * gridDim.y * gridDim.z;
    unsigned sum, cnt, mine, sp = 0u;
    for (;;) {
        sum = 0u; cnt = 0u; mine = 0u;
#pragma unroll
        for (unsigned j = 0; j < 16; ++j) { const unsigned c = xb_ld(&bar[XB_XCNT(j)]); sum += c; cnt += (c > 0u) ? 1u : 0u; mine = (j == x) ? c : mine; }
        if (sum == G) break;
        __builtin_amdgcn_s_sleep(1);
        if ((++sp & 255u) == 0u) { if (xb_ld(&bar[XB_TMO])) break; if (sp > XB_SPIN_CAP) { atomicAdd(&bar[XB_TMO], 1u); break; } }
    }
    nloc = mine > 0u ? mine : 1u; nx = cnt > 0u ? cnt : 1u;
}
__device__ __forceinline__ void xcd_barrier(const XcdBarrier& b) {
    asm volatile("s_waitcnt vmcnt(0)" ::: "memory");
    __syncthreads();
    if (threadIdx.x == 0) {
        unsigned* bar = b.bar;
        __builtin_amdgcn_s_waitcnt(0);
        unsigned nloc = b.st[0], nx = b.st[1];
        if (nloc == 0u) { xcd_barrier_complete(bar, b.x, nloc, nx); b.st[0] = nloc; b.st[1] = nx; }
        const unsigned old = xb_add(&bar[XB_XSUB(b.x)], 1u);
        const unsigned gen = old / nloc;
        if (old + 1u == (gen + 1u) * nloc) {
            __builtin_amdgcn_fence(__ATOMIC_RELEASE, "agent");
            asm volatile("s_waitcnt vmcnt(0)" ::: "memory");
            const unsigned og = xb_add(&bar[XB_TOP], 1u);
            const unsigned tg = og / nx;
            if (og + 1u == (tg + 1u) * nx) xb_add(&bar[XB_TOPGEN], 1u);
            else XB_SPIN(xb_ld(&bar[XB_TOPGEN]) == tg, bar);
            __builtin_amdgcn_fence(__ATOMIC_ACQUIRE, "agent");
            xb_add(&bar[XB_XGEN(b.x)], 1u);
            asm volatile("s_waitcnt vmcnt(0)" ::: "memory");
        } else {
            XB_SPIN(xb_ld(&bar[XB_XGEN(b.x)]) == gen, bar);
            __builtin_amdgcn_fence(__ATOMIC_ACQUIRE, "agent");
            asm volatile("s_waitcnt vmcnt(0)" ::: "memory");
        }
    }
    __syncthreads();
}

namespace pg8 {
#define PG8_LAS __attribute__((address_space(3)))
constexpr int BM = 256, BK = 64, HALF = 128, HTB = HALF * BK * 2, STAGE_BYTES = 8 * HTB, NXCD = 8, WGM = 8;
__host__ __device__ __forceinline__ int lds_byte(int r, int c) { const int st = (r >> 4) * 2 + (c >> 5), rr = r & 15, cc = c & 31, ob = rr * 64 + cc * 2; return st * 1024 + (ob ^ (((ob >> 9) & 1) << 5)); }
__host__ __device__ __forceinline__ void stage_rc(int b, int& R, int& C) { const int st = b / 1024, sb = b % 1024, swz = sb ^ (((sb >> 9) & 1) << 5); R = (st >> 1) * 16 + swz / 64; C = (st & 1) * 32 + (swz % 64) / 2; }
__host__ __device__ __forceinline__ int perm32(int rho) { const int n = rho >> 4, i = rho & 15; return 8 * (i >> 2) + 4 * n + (i & 3); }
struct Unit { int pm, pn; };
struct Gemm { const bf16_t* A; const bf16_t* Bt; int M, N, K; };
struct StaticOrder {
    int nM, nN, nwg, G, c;
    __host__ __device__ void init(int M, int N, int G_, int c_) { nM = M / BM; nN = N / BM; nwg = nM * nN; G = G_; c = c_; }
    __host__ __device__ bool next(int i, Unit& u) const {
        const long L = (long)i * G + c; if (L >= nwg) return false;
        int wgid = (int)L; { const int q = nwg / NXCD, r = nwg % NXCD, xcd = wgid % NXCD, off = wgid / NXCD; wgid = (xcd < r ? xcd * (q + 1) : r * (q + 1) + (xcd - r) * q) + off; }
        const int nig = WGM * nN, gid = wgid / nig, fm = gid * WGM, gsz = (nM - fm) < WGM ? (nM - fm) : WGM;
        u.pm = fm + ((wgid % nig) % gsz); u.pn = (wgid % nig) / gsz; return true;
    }
    __device__ __forceinline__ void a_ready(const Unit&) const {}
    __device__ __forceinline__ void done(const Unit&) const {}
};
typedef __bf16 bf16v2_t __attribute__((ext_vector_type(2)));
typedef float f32x2_t __attribute__((ext_vector_type(2)));
typedef __bf16 bf16v4_t __attribute__((ext_vector_type(4)));
typedef __bf16 bf16v8_t __attribute__((ext_vector_type(8)));
typedef float f32x8_t __attribute__((ext_vector_type(8)));
typedef unsigned u32x2_t __attribute__((ext_vector_type(2)));
__device__ __forceinline__ unsigned cvt_pk_bf16(float lo, float hi) { const f32x2_t f = {lo, hi}; return __builtin_bit_cast(unsigned, __builtin_convertvector(f, bf16v2_t)); }
__device__ __forceinline__ u32x2_t cvt4_bf16(const f32x4 a) { return __builtin_bit_cast(u32x2_t, __builtin_convertvector(a, bf16v4_t)); }
__device__ __forceinline__ bf16x8 cvt8_bf16(const f32x4 a, const f32x4 b) { const f32x8_t f = __builtin_shufflevector(a, b, 0, 1, 2, 3, 4, 5, 6, 7); return __builtin_bit_cast(bf16x8, __builtin_convertvector(f, bf16v8_t)); }

struct NoHook { static constexpr bool ACTIVE = false; __device__ __forceinline__ void operator()(f32x4 (&)[2][2][4][2], const Unit&, int, int, int, int, int) const {} };
template <class Epi, class Sched, class Hook = NoHook>
__device__ __forceinline__ void gemm_phase(PG8_LAS unsigned char* lds, const Gemm g, const Sched& S, const Epi& E, const int tid, const Hook& H = Hook()) {
    const int wid = __builtin_amdgcn_readfirstlane(tid >> 6), lane = tid & 63, wr = wid >> 2, wc = wid & 3, fr = lane & 15, fq = lane >> 4;
    const int K = g.K, nt = K / BK;
    unsigned voffA[2], voffB[2];
#pragma unroll
    for (int i = 0; i < 2; ++i) { int R, C; stage_rc(tid * 16 + i * 8192, R, C); const int Rb = Epi::PERM ? ((R & ~31) + perm32(R & 31)) : R;
        voffA[i] = (unsigned)(R * K + C) * 2u; voffB[i] = (unsigned)(Rb * K + C) * 2u; }
    const size_t kstep = (size_t)(BK * 2);
    const size_t hstep = (size_t)HALF * K * 2;
    const size_t tstep = 2 * hstep;
    const unsigned ldsw = (unsigned)wid * 1024u;
    const int aoff = lds_byte(wr * 64 + fr, fq * 8), boff = lds_byte(wc * 32 + fr, fq * 8);
#define PG8_SA(b, h) (((b) * 2 + (h)) * HTB)
#define PG8_SB(b, h) ((4 + (b) * 2 + (h)) * HTB)
#define PG8_STAGE(bufoff, gbase, voff) do { _Pragma("unroll") for (int _i = 0; _i < 2; ++_i) \
        __builtin_amdgcn_global_load_lds((const unsigned*)((const char*)(gbase) + (voff)[_i]), (PG8_LAS unsigned*)(lds + (bufoff) + ldsw + _i * 8192), 16, 0, 0); } while (0)
#define PG8_LDA(dst, b, h) do { _Pragma("unroll") for (int m = 0; m < 4; ++m) _Pragma("unroll") for (int k = 0; k < 2; ++k) dst[m][k] = *(const PG8_LAS bf16x8*)(lds + PG8_SA(b, h) + aoff + m * 2048 + k * 1024); } while (0)
#define PG8_LDB(dst, b, h) do { _Pragma("unroll") for (int n = 0; n < 2; ++n) _Pragma("unroll") for (int k = 0; k < 2; ++k) dst[n][k] = *(const PG8_LAS bf16x8*)(lds + PG8_SB(b, h) + boff + n * 2048 + k * 1024); } while (0)
#define PG8_MMA(ai, bj, At, Bt) do { __builtin_amdgcn_s_setprio(1); _Pragma("unroll") for (int m = 0; m < 4; ++m) _Pragma("unroll") for (int n = 0; n < 2; ++n) _Pragma("unroll") for (int k = 0; k < 2; ++k) \
        acc[ai][bj][m][n] = __builtin_amdgcn_mfma_f32_16x16x32_bf16(Bt[n][k], At[m][k], acc[ai][bj][m][n], 0, 0, 0); __builtin_amdgcn_s_setprio(0); } while (0)
#define PG8_WAIT_V(n) asm volatile("s_waitcnt vmcnt(" #n ")" ::: "memory")
#define PG8_WAIT_L(n) asm volatile("s_waitcnt lgkmcnt(" #n ")" ::: "memory")
#define PG8_BAR __builtin_amdgcn_s_barrier()
#define PG8_SCHED __builtin_amdgcn_sched_barrier(0)
    Unit cur, nxt; int ui = 0;
    if (!S.next(0, cur)) return;
    f32x4 acc[2][2][4][2];
#pragma unroll
    for (int a = 0; a < 2; ++a)
#pragma unroll
        for (int b = 0; b < 2; ++b)
#pragma unroll
            for (int m = 0; m < 4; ++m)
#pragma unroll
                for (int n = 0; n < 2; ++n) acc[a][b][m][n] = (f32x4){0.f, 0.f, 0.f, 0.f};
    bf16x8 At[4][2], B0[2][2], B1[2][2];
    const char* cA = (const char*)g.A + (size_t)cur.pm * tstep; const char* cB = (const char*)g.Bt + (size_t)cur.pn * tstep;
    S.a_ready(cur);
    PG8_STAGE(PG8_SB(0, 0), cB, voffB); PG8_STAGE(PG8_SA(0, 0), cA, voffA); PG8_STAGE(PG8_SB(0, 1), cB + hstep, voffB); PG8_STAGE(PG8_SA(0, 1), cA + hstep, voffA);
    if (wr == 1) PG8_BAR;
    PG8_WAIT_V(4); PG8_BAR;
    PG8_STAGE(PG8_SB(1, 0), cB + kstep, voffB); PG8_STAGE(PG8_SA(1, 0), cA + kstep, voffA); PG8_STAGE(PG8_SB(1, 1), cB + hstep + kstep, voffB);
    PG8_WAIT_V(6); PG8_BAR;
    for (;;) {
        const bool has_next = S.next(ui + 1, nxt);
        const char* nA = has_next ? (const char*)g.A + (size_t)nxt.pm * tstep : cA; const char* nB = has_next ? (const char*)g.Bt + (size_t)nxt.pn * tstep : cB;
#pragma nounroll
        for (int t = 0; t < nt; t += 2) {
            const bool last = (t == nt - 2);
            const char* a1 = cA + (size_t)(t + 1) * kstep;
            const char* a2 = last ? nA : cA + (size_t)(t + 2) * kstep; const char* b2 = last ? nB : cB + (size_t)(t + 2) * kstep;
            const char* a3 = a2 + kstep; const char* b3 = b2 + kstep;
            if (last && has_next) S.a_ready(nxt);
            if (Hook::ACTIVE) { if (t == 8 || t == 12) H(acc, cur, t, wr, wc, fr, fq); }
            PG8_LDB(B0, 0, 0); PG8_SCHED; PG8_LDA(At, 0, 0); PG8_STAGE(PG8_SA(1, 1), a1 + hstep, voffA);
            PG8_WAIT_L(8); PG8_BAR; PG8_WAIT_L(0); PG8_MMA(0, 0, At, B0); PG8_BAR; PG8_SCHED;
            PG8_LDB(B1, 0, 1); PG8_STAGE(PG8_SB(0, 0), b2, voffB);
            PG8_BAR; PG8_WAIT_L(0); PG8_MMA(0, 1, At, B1); PG8_BAR;
            PG8_LDA(At, 0, 1); PG8_STAGE(PG8_SA(0, 0), a2, voffA);
            PG8_BAR; PG8_WAIT_L(0); PG8_MMA(1, 0, At, B0); PG8_BAR; PG8_SCHED;
            PG8_STAGE(PG8_SB(0, 1), b2 + hstep, voffB);
            PG8_WAIT_V(6); PG8_BAR; PG8_MMA(1, 1, At, B1); PG8_BAR;
            PG8_LDB(B0, 1, 0); PG8_SCHED; PG8_LDA(At, 1, 0); PG8_STAGE(PG8_SA(0, 1), a2 + hstep, voffA);
            PG8_WAIT_L(8); PG8_BAR; PG8_WAIT_L(0); PG8_MMA(0, 0, At, B0); PG8_BAR; PG8_SCHED;
            PG8_LDB(B1, 1, 1); PG8_STAGE(PG8_SB(1, 0), b3, voffB);
            PG8_BAR; PG8_WAIT_L(0); PG8_MMA(0, 1, At, B1); PG8_BAR;
            PG8_LDA(At, 1, 1); PG8_STAGE(PG8_SA(1, 0), a3, voffA);
            PG8_BAR; PG8_WAIT_L(0); PG8_MMA(1, 0, At, B0); PG8_BAR; PG8_SCHED;
            PG8_STAGE(PG8_SB(1, 1), b3 + hstep, voffB);
            PG8_WAIT_V(6); PG8_BAR; PG8_MMA(1, 1, At, B1); PG8_BAR;
        }
        E(acc, cur, wr, wc, fr, fq); S.done(cur);
        if (!has_next) break;
#pragma unroll
        for (int a = 0; a < 2; ++a)
#pragma unroll
            for (int b = 0; b < 2; ++b)
#pragma unroll
                for (int m = 0; m < 4; ++m)
#pragma unroll
                    for (int n = 0; n < 2; ++n) acc[a][b][m][n] = (f32x4){0.f, 0.f, 0.f, 0.f};
        cur = nxt; cA = nA; cB = nB; ++ui;
    }
    PG8_WAIT_V(0);
    if (wr == 0) PG8_BAR;
    PG8_BAR;
#undef PG8_SA
#undef PG8_SB
#undef PG8_STAGE
#undef PG8_LDA
#undef PG8_LDB
#undef PG8_MMA
#undef PG8_WAIT_V
#undef PG8_WAIT_L
#undef PG8_BAR
#undef PG8_SCHED
}
}

__device__ __forceinline__ int vperm(int t) { const int kq = (t >> 2) & 7, e = t & 3; return (t & ~31) | ((kq < 4 ? 2 * kq : 2 * (kq - 4) + 1) << 2) | e; }
template <class F> struct Epi8 {
    static constexpr bool PERM = true, AFTER_DRAIN = false;
    F f;
    __device__ __forceinline__ void operator()(const f32x4 (&acc)[2][2][4][2], const pg8::Unit& u, int wr, int wc, int fr, int fq) const {
        const int row0 = u.pm * 256 + wr * 64 + fr, col0 = u.pn * 256 + wc * 32 + 8 * fq;
#pragma unroll
        for (int ai = 0; ai < 2; ++ai)
#pragma unroll
            for (int m = 0; m < 4; ++m)
            {
#pragma unroll
                for (int bj = 0; bj < 2; ++bj) f(row0 + ai * 128 + m * 16, col0 + bj * 128, acc[ai][bj][m][0], acc[ai][bj][m][1], u.pn);
                asm volatile("" ::: "memory"); }
    }
};
__device__ __forceinline__ u32x4 pack8(const f32x4 a, const f32x4 b) {
    return __builtin_bit_cast(u32x4, pg8::cvt8_bf16(a, b));
}
struct FStore { bf16_t* O; int ld;
    __device__ __forceinline__ void operator()(int row, int col, f32x4 a, f32x4 b, int) const { *(u32x4*)(O + (unsigned)(row * ld + col)) = pack8(a, b); } };
__device__ __forceinline__ unsigned gate_off(int row, int col) { return (unsigned)((((row >> 4) * 96 + (col >> 5)) << 9) + ((row & 15) << 5) + (col & 31)); }
struct MergeHook { static constexpr bool ACTIVE = true; const bf16_t* G;
    __device__ __forceinline__ void operator()(f32x4 (&acc)[2][2][4][2], const pg8::Unit& u, int t, int wr, int wc, int fr, int fq) const {
        const int cn = t == 8 ? 0 : 1024;
        const int row0 = u.pm * 256 + wr * 64 + fr, col0 = u.pn * 256 + wc * 32 + 8 * fq;
        u32x4 gn[2][2][2], gd[2][2][2];
#define MH_LOAD(buf, k) do { const int ai_ = (k) >> 1, mh_ = (k) & 1; _Pragma("unroll") for (int mm = 0; mm < 2; ++mm) _Pragma("unroll") for (int bj = 0; bj < 2; ++bj) { \
            const int r_ = row0 + ai_ * 128 + (2 * mh_ + mm) * 16, c_ = cn + col0 + bj * 128; gn[buf][mm][bj] = *(const u32x4*)(G + gate_off(r_, c_)); gd[buf][mm][bj] = *(const u32x4*)(G + gate_off(r_, c_ + 1024)); } } while (0)
#define MH_APPLY(buf, k) do { const int ai_ = (k) >> 1, mh_ = (k) & 1; _Pragma("unroll") for (int mm = 0; mm < 2; ++mm) _Pragma("unroll") for (int bj = 0; bj < 2; ++bj) { const int m = 2 * mh_ + mm; \
            const unsigned nw[4] = {gn[buf][mm][bj].x, gn[buf][mm][bj].y, gn[buf][mm][bj].z, gn[buf][mm][bj].w}, dw[4] = {gd[buf][mm][bj].x, gd[buf][mm][bj].y, gd[buf][mm][bj].z, gd[buf][mm][bj].w}; \
            _Pragma("unroll") for (int j = 0; j < 8; ++j) { const float gnj = (j & 1) ? bfhi(nw[j >> 1]) : bflo(nw[j >> 1]), gdj = (j & 1) ? bfhi(dw[j >> 1]) : bflo(dw[j >> 1]); \
                acc[ai_][bj][m][j >> 2][j & 3] *= gnj * __builtin_amdgcn_rcpf(fmaxf(gdj, 1e-12f)); } } } while (0)
        MH_LOAD(0, 0);
        MH_LOAD(1, 1); asm volatile("" ::: "memory"); MH_APPLY(0, 0); asm volatile("" ::: "memory"); __builtin_amdgcn_sched_barrier(0);
        MH_LOAD(0, 2); asm volatile("" ::: "memory"); MH_APPLY(1, 1); asm volatile("" ::: "memory"); __builtin_amdgcn_sched_barrier(0);
        MH_LOAD(1, 3); asm volatile("" ::: "memory"); MH_APPLY(0, 2); asm volatile("" ::: "memory"); __builtin_amdgcn_sched_barrier(0);
        MH_APPLY(1, 3); asm volatile("" ::: "memory"); __builtin_amdgcn_sched_barrier(0);
#undef MH_LOAD
#undef MH_APPLY
    } };
struct FMulStore { const bf16_t* G; bf16_t* O;
    __device__ __forceinline__ void operator()(int row, int col, f32x4 a, f32x4 b, int) const {
        const u32x4 g = *(const u32x4*)(G + gate_off(row, 2048 + col));
        const f32x4 g0 = {bflo(g.x), bfhi(g.x), bflo(g.y), bfhi(g.y)}, g1 = {bflo(g.z), bfhi(g.z), bflo(g.w), bfhi(g.w)};
        *(u32x4*)(O + (unsigned)(row * 1024 + col)) = pack8(g0 * a, g1 * b); } };
struct FSigmoid { bf16_t* O; int ld;
    __device__ __forceinline__ void operator()(int row, int col, f32x4 a, f32x4 b, int) const {
#pragma unroll
        for (int j = 0; j < 4; ++j) { a[j] = sigmoidf_(a[j]); b[j] = sigmoidf_(b[j]); }
        *(u32x4*)(O + gate_off(row, col)) = pack8(a, b); } };
struct FGluMul { const bf16_t* Y; bf16_t* O; int ld, ldo;
    __device__ __forceinline__ void operator()(int row, int col, f32x4 a, f32x4 b, int) const {
        const unsigned o = (unsigned)(row * ld + col), oo = (unsigned)(row * ldo + col); const u32x4 y = *(const u32x4*)(Y + o);
        const f32x4 y0 = {bflo(y.x), bfhi(y.x), bflo(y.y), bfhi(y.y)}, y1 = {bflo(y.z), bfhi(y.z), bflo(y.w), bfhi(y.w)};
#pragma unroll
        for (int j = 0; j < 4; ++j) { a[j] = y0[j] * sigmoidf_(a[j]); b[j] = y1[j] * sigmoidf_(b[j]); }
        *(u32x4*)(O + oo) = pack8(a, b); } };
struct FSwiGLU { bf16_t* O; int ld;
    __device__ __forceinline__ void operator()(int row, int col, f32x4 a, f32x4 b, int) const {
        const float o0 = a[0] * sigmoidf_(a[0]) * a[1], o1 = a[2] * sigmoidf_(a[2]) * a[3], o2 = b[0] * sigmoidf_(b[0]) * b[1], o3 = b[2] * sigmoidf_(b[2]) * b[3];
        *(u32x2*)(O + (unsigned)(row * ld + (col >> 1))) = pg8::cvt4_bf16((f32x4){o0, o1, o2, o3}); } };
struct EpiSwiGLU16 {
    static constexpr bool PERM = true, AFTER_DRAIN = false;
    bf16_t* O; int ld;
    __device__ __forceinline__ void operator()(const f32x4 (&acc)[2][2][4][2], const pg8::Unit& u, int wr, int wc, int fr, int fq) const {
        const int row0 = u.pm * 256 + wr * 64 + fr, col0 = u.pn * 256 + wc * 32 + 8 * fq;
        const int ocol = (fq & 1) ? (((col0 - 8) >> 1) + 64) : (col0 >> 1);
#pragma unroll
        for (int ai = 0; ai < 2; ++ai)
#pragma unroll
            for (int m = 0; m < 4; ++m) {
                u32x2 p[2];
#pragma unroll
                for (int bj = 0; bj < 2; ++bj) { const f32x4 a = acc[ai][bj][m][0], b = acc[ai][bj][m][1];
                    const float o0 = a[0] * sigmoidf_(a[0]) * a[1], o1 = a[2] * sigmoidf_(a[2]) * a[3], o2 = b[0] * sigmoidf_(b[0]) * b[1], o3 = b[2] * sigmoidf_(b[2]) * b[3];
                    p[bj] = pg8::cvt4_bf16((f32x4){o0, o1, o2, o3}); }
                const auto rx = __builtin_amdgcn_permlane16_swap(p[0].x, p[1].x, false, false), ry = __builtin_amdgcn_permlane16_swap(p[0].y, p[1].y, false, false);
                const u32x4 w = {rx[0], ry[0], rx[1], ry[1]};
                *(u32x4*)(O + (unsigned)((row0 + ai * 128 + m * 16) * ld + ocol)) = w;
                asm volatile("" ::: "memory"); }
    }
};
struct FLora { bf16_t *LW, *LA, *RG;
    __device__ __forceinline__ void operator()(int row, int col, f32x4 a, f32x4 b, int pn) const {
        bf16_t* O = pn == 0 ? LW : (pn == 1 ? LA : RG); *(u32x4*)(O + (unsigned)(row * 256 + (col & 255))) = pack8(a, b); } };
struct FXKV { bf16_t* Kx; bf16_t* Vxt;
    __device__ __forceinline__ void operator()(int row, int col, f32x4 a, f32x4 b, int) const {
        const int bb = row >> 8, m = row & 255;
        if (col < 256) { const int h = col >> 6, d = col & 63; *(u32x4*)(Kx + (unsigned)(((bb * 4 + h) * 256 + m) * 64 + d)) = pack8(a, b); }
        else { const int c = col - 256, h = c >> 6, d = c & 63; bf16_t* p = Vxt + (unsigned)(((bb * 4 + h) * 64 + d) * 256 + vperm(m));
#pragma unroll
            for (int j = 0; j < 4; ++j) { p[j * 256] = f2bf(a[j]); p[(j + 4) * 256] = f2bf(b[j]); } } } };
struct FIn1 { bf16_t *Q, *KC, *VC, *KS, *KW, *VSt, *VWt, *ZR, *ZS, *NG; const float* ropec; const float* ropes;
    __device__ __forceinline__ void operator()(int row, int col, f32x4 a, f32x4 b, int pn) const {
        if (pn < 2) { *(u32x4*)(Q + (unsigned)(row * 512 + col)) = pack8(a, b); }
        else if (pn < 5) {
            const int c = col - 512, which = c >> 7, g = (c >> 6) & 1, j0 = c & 63, bb = row >> 12, t = row & 4095;
            const unsigned base = (unsigned)(((bb * 2 + g) * 4096 + t) * 64);
            if (which == 0) *(u32x4*)(KC + base + j0) = pack8(a, b);
            else if (which == 1) *(u32x4*)(VC + base + j0) = pack8(a, b);
            else if (which == 2 || which == 4) {
                const int i0 = j0 >> 1; const f32x4 cs = *(const f32x4*)(ropec + t * 32 + i0), sn = *(const f32x4*)(ropes + t * 32 + i0);
                const float x1[4] = {a[0], a[2], b[0], b[2]}, x2[4] = {a[1], a[3], b[1], b[3]}; float r1[4], r2[4];
#pragma unroll
                for (int j = 0; j < 4; ++j) { r1[j] = x1[j] * cs[j] - x2[j] * sn[j]; r2[j] = x1[j] * sn[j] + x2[j] * cs[j]; }
                bf16_t* K = (which == 2 ? KS : KW) + base;
                const u32x2 w1 = pg8::cvt4_bf16((f32x4){r1[0], r1[1], r1[2], r1[3]}), w2 = pg8::cvt4_bf16((f32x4){r2[0], r2[1], r2[2], r2[3]});
                const auto rx = __builtin_amdgcn_permlane16_swap(w1.x, w2.x, false, false), ry = __builtin_amdgcn_permlane16_swap(w1.y, w2.y, false, false);
                *(u32x4*)(K + (((col >> 3) & 1) ? 32 + i0 - 4 : i0)) = (u32x4){rx[0], ry[0], rx[1], ry[1]};
            } else {
                bf16_t* p = (which == 3 ? VSt : VWt) + (unsigned)(((bb * 2 + g) * 64 + j0) * 4096 + vperm(t));
#pragma unroll
                for (int j = 0; j < 4; ++j) { p[j * 4096] = f2bf(a[j]); p[(j + 4) * 4096] = f2bf(b[j]); }
            }
        }
        else if (pn < 9) { *(u32x4*)(ZR + (unsigned)(row * 1024 + (col - 1280))) = pack8(a, b); }
        else if (pn == 9) { *(u32x4*)(ZS + (unsigned)(row * 256 + (col - 2304))) = pack8(a, b); }
        else { const int c = col - 2560; if (c < 32) *(u32x4*)(NG + (unsigned)(row * 32 + c)) = pack8(a, b); }
    } };

typedef const float* const __attribute__((address_space(4)))* KArgPtrs;
struct Frame {
    const __attribute__((address_space(4))) char* kp; unsigned char* ws; LAS unsigned char* lds;
    int tid, lane, wave, bid, G;
    __device__ __forceinline__ const float* in(int i) const { return (const float*)(const __attribute__((address_space(1))) float*)(((KArgPtrs)kp)[i]); }
    __device__ __forceinline__ float* out() const { return (float*)(__attribute__((address_space(1))) float*)(((KArgPtrs)kp)[42]); }
    __device__ __forceinline__ bf16_t* x16() const { return (bf16_t*)(out() + (size_t)TOK * DM / 2); }
    __device__ __forceinline__ unsigned* ctl() const { return (unsigned*)(ws + WS_CTL); }
};
#define LAUNDER(F) do { __attribute__((address_space(1))) unsigned char* _g = (__attribute__((address_space(1))) unsigned char*)(F).ws; asm volatile("" : "+s"(_g), "+s"((F).kp)); (F).ws = (unsigned char*)_g; } while (0)
#define WSP(T, off) ((T*)(F.ws + (off)))

__device__ __forceinline__ int next_job(const Frame& F, unsigned* counter) {
    volatile LAS int* slot = (volatile LAS int*)(F.lds + LDS_CTL_OFF + 16);
    __syncthreads();
    if (F.tid == 0) *slot = (int)__hip_atomic_fetch_add(counter, 1u, __ATOMIC_RELAXED, __HIP_MEMORY_SCOPE_AGENT);
    __syncthreads();
    return *slot;
}

struct ConvDesc { int N, K; size_t dst; };
__device__ __forceinline__ const float* conv_col(const Frame& F, int l, int kind, int n, int& ld, int& klo, int& khi) {
    klo = 0; khi = 1 << 30;
    switch (kind) {
    case 0: {
        int c; ld = INW;
        if (n < 512) c = n;
        else if (n < 1280) { const int cc = n - 512, which = cc >> 7, g = (cc >> 6) & 1, j = cc & 63; const int dim = (which == 2 || which == 4) ? ((j & 1) ? (j >> 1) + 32 : (j >> 1)) : j; c = 512 + which * 128 + g * 64 + dim; }
        else if (n < 2304) c = 1304 + (n - 1280);
        else if (n < 2560) c = 2328 + (n - 2304);
        else if (n < 2584) c = 1280 + (n - 2560);
        else return nullptr;
        return F.in(4) + (size_t)l * DM * INW + c; }
    case 1: ld = INW; return F.in(4) + (size_t)l * DM * INW + 2584 + n;
    case 2: ld = 1024; return F.in(31) + (size_t)l * 512 * 1024 + n;
    case 3: return nullptr;
    case 4: return nullptr;
    case 5: ld = 1024; return F.in(34) + (size_t)l * 1024 * 1024 + n;
    case 6: ld = 256; return F.in(7) + ((size_t)l * 2048 + (n < 256 ? 0 : 1024)) * 256 + (n & 255);
    case 7: ld = 256; return F.in(9) + ((size_t)l * 2048 + (n < 256 ? 0 : 1024)) * 256 + (n & 255);
    case 8: ld = 256; return F.in(35) + (size_t)l * 1024 * 256 + n;
    case 9: ld = 256; return (n < 256 ? F.in(36) : F.in(37)) + (size_t)l * 1024 * 256 + (n & 255);
    case 10: ld = 1024; return F.in(38) + (size_t)l * 256 * 1024 + n;
    case 11: ld = 256; return F.in(30) + (size_t)l * 256 * 256 + n;
    case 12: ld = DFF; return ((n & 1) ? F.in(40) : F.in(39)) + (size_t)l * 1024 * DFF + (n >> 1);
    case 13: ld = 1024; return F.in(41) + (size_t)l * DFF * 1024 + n;
    case 15: ld = 64; return F.in(8) + (size_t)l * 256 * 64 + n;
    case 16: ld = 64; return F.in(10) + (size_t)l * 256 * 64 + n;
    default: {
        ld = 256;
        if (n < 256) { klo = 0; khi = 64; return F.in(13) + (size_t)l * 64 * 256 + n; }
        if (n < 512) { klo = 64; khi = 128; return F.in(15) + (size_t)l * 64 * 256 + (n - 256); }
        klo = 128; khi = 256; return F.in(16) + (size_t)l * 128 * 256 + (n - 512); }
    }
}
__device__ __forceinline__ void conv_layer(const Frame& F, int l) {
    const ConvDesc D[17] = {{2816, 1024, W_IN1}, {3072, 1024, W_MG}, {1024, 1024, W_UPN}, {64, 64, WS_W + 39 * MiB}, {64, 64, WS_W + 39 * MiB + 65536}, {1024, 1024, W_OUT}, {512, 1024, W_C1K}, {512, 1024, W_C1V},
                            {256, 1024, W_XQ}, {512, 1024, W_XKV}, {1024, 256, W_XO}, {256, 256, W_GLU}, {5632, 1024, W_GU}, {1024, 2816, W_DN}, {768, 256, W_LORA}, {64, 256, W_C2K}, {64, 256, W_C2V}};
    LAS float* tile = (LAS float*)F.lds;
    {
        constexpr int WJ_MG = 12 * 16, WJ_OUT = 4 * 16, WJ_GU = 22 * 16, WJ_DN = 4 * 44, WJ_IN1 = 8 * 16, WJ_UPN = 4 * 16, WJ_C1 = 2 * 16, WJ_XQ = 16, WJ_XKV = 2 * 16, WJ_XO = 4 * 4, WJ_GLU = 4;
        constexpr int WJ_TOTAL = WJ_MG + WJ_OUT + WJ_GU + WJ_DN + WJ_IN1 + WJ_UPN + 2 * WJ_C1 + WJ_XQ + WJ_XKV + WJ_XO + WJ_GLU;
        const int nq = F.tid & 63, kr = F.tid >> 6;
        for (int wj = F.bid; wj < WJ_TOTAL; wj += F.G) {
            int kind, rem = wj, K, ld, n0, k0, koff = 0; size_t dst; const float* base;
            if (rem < WJ_MG) { kind = 1; K = 1024; dst = W_MG; ld = INW; n0 = (rem / 16) * 256; k0 = (rem % 16) * 64; base = F.in(4) + (size_t)l * DM * INW + 2584 + n0; }
            else if ((rem -= WJ_MG) < WJ_OUT) { kind = 5; K = 1024; dst = W_OUT; ld = 1024; n0 = (rem / 16) * 256; k0 = (rem % 16) * 64; base = F.in(34) + (size_t)l * 1024 * 1024 + n0; }
            else if ((rem -= WJ_OUT) < WJ_GU) { kind = 12; K = 1024; dst = W_GU; ld = DFF; n0 = (rem / 16) * 256; k0 = (rem % 16) * 64; base = F.in(39) + (size_t)l * 1024 * DFF + (n0 >> 1); }
            else if ((rem -= WJ_GU) < WJ_DN) { kind = 13; K = DFF; dst = W_DN; ld = 1024; n0 = (rem / 44) * 256; k0 = (rem % 44) * 64; base = F.in(41) + (size_t)l * DFF * 1024 + n0; }
            else if ((rem -= WJ_DN) < WJ_IN1) { kind = 0; K = 1024; dst = W_IN1; ld = INW; const int t8 = rem / 16, tl = t8 < 3 ? t8 : t8 + 2; n0 = tl * 256; k0 = (rem % 16) * 64;
                base = F.in(4) + (size_t)l * DM * INW + n0 + (tl >= 5 ? 24 : 0); }
            else if ((rem -= WJ_IN1) < WJ_UPN) { kind = 2; K = 1024; dst = W_UPN; ld = 1024; n0 = (rem / 16) * 256; k0 = (rem % 16) * 64;
                if (k0 < 512) base = F.in(31) + (size_t)l * 512 * 1024 + n0; else if (k0 < 768) { base = F.in(32) + (size_t)l * 256 * 1024 + n0; koff = 512; } else { base = F.in(33) + (size_t)l * 256 * 1024 + n0; koff = 768; } }
            else if ((rem -= WJ_UPN) < WJ_C1) { kind = 6; K = 1024; dst = W_C1K; ld = 256; n0 = (rem / 16) * 256; k0 = (rem % 16) * 64; base = F.in(7) + ((size_t)l * 2048 + (n0 ? 1024 : 0)) * 256; }
            else if ((rem -= WJ_C1) < WJ_C1) { kind = 7; K = 1024; dst = W_C1V; ld = 256; n0 = (rem / 16) * 256; k0 = (rem % 16) * 64; base = F.in(9) + ((size_t)l * 2048 + (n0 ? 1024 : 0)) * 256; }
            else if ((rem -= WJ_C1) < WJ_XQ) { kind = 8; K = 1024; dst = W_XQ; ld = 256; n0 = 0; k0 = rem * 64; base = F.in(35) + (size_t)l * 1024 * 256; }
            else if ((rem -= WJ_XQ) < WJ_XKV) { kind = 9; K = 1024; dst = W_XKV; ld = 256; n0 = (rem / 16) * 256; k0 = (rem % 16) * 64; base = (n0 ? F.in(37) : F.in(36)) + (size_t)l * 1024 * 256; }
            else if ((rem -= WJ_XKV) < WJ_XO) { kind = 10; K = 256; dst = W_XO; ld = 1024; n0 = (rem / 4) * 256; k0 = (rem % 4) * 64; base = F.in(38) + (size_t)l * 256 * 1024 + n0; }
            else { rem -= WJ_XO; kind = 11; K = 256; dst = W_GLU; ld = 256; n0 = 0; k0 = rem * 64; base = F.in(30) + (size_t)l * 256 * 256; }
            const float* src;
            if (kind == 12) src = ((nq >= 32) ? F.in(40) + (size_t)l * 1024 * DFF + (n0 >> 1) : base) + 4 * (nq & 31);
            else src = base + 4 * nq;
            f32x4 v[8];
#pragma unroll
            for (int i = 0; i < 8; ++i) v[i] = *(const f32x4*)(src + (size_t)(k0 - koff + kr + 8 * i) * ld);
            __syncthreads();
#pragma unroll
            for (int i = 0; i < 8; ++i)
#pragma unroll
                for (int j = 0; j < 4; ++j) tile[(kr + 8 * i) * 257 + nq + 64 * j] = v[i][j];
            __syncthreads();
            bf16_t* O = WSP(bf16_t, dst);
#pragma unroll
            for (int i = 0; i < 16; ++i) { const int ny = (F.tid >> 5) + 16 * i, kp = F.tid & 31;
                const int cc = (kind == 12) ? (((ny >> 1) >> 2) + 32 * (ny & 1) + 64 * ((ny >> 1) & 3)) : ((ny >> 2) + 64 * (ny & 3));
                *(unsigned*)(O + (size_t)(n0 + ny) * K + k0 + 2 * kp) = pk2(tile[(2 * kp) * 257 + cc], tile[(2 * kp + 1) * 257 + cc]); }
        }
        __syncthreads();
    }
    int total = 0;
#pragma unroll
    for (int i = 0; i < 17; ++i) total += (D[i].N / 64) * (D[i].K / 64);
    (void)total;
    constexpr int NJ = 64 + 64 + 64 + 48 + 4 + 4 + 1 + 1;
    const bool deal172 = (F.G == 256);
    for (int nj = deal172 ? F.bid - 84 : F.bid; nj < NJ; nj += deal172 ? 172 : F.G) {
        if (nj < 0) break;
        int kind, rem;
        if (nj < 64) { kind = 0; rem = 192 + nj; } else if (nj < 128) { kind = 0; rem = 256 + (nj - 64); } else if (nj < 192) { kind = 0; rem = 640 + (nj - 128); }
        else if (nj < 240) { kind = 14; rem = nj - 192; } else if (nj < 244) { kind = 15; rem = nj - 240; } else if (nj < 248) { kind = 16; rem = nj - 244; } else { kind = nj - 248 + 3; rem = 0; }
        int K = 0; size_t dst = 0;
#pragma unroll
        for (int i = 0; i < 17; ++i) if (kind == i) { K = D[i].K; dst = D[i].dst; }
        const int ktiles = K / 64, n0 = (rem / ktiles) * 64, k0 = (rem % ktiles) * 64;
        int ld, klo, khi; const float* col = conv_col(F, l, kind, n0 + (F.tid & 63), ld, klo, khi);
        if (kind == 2) { if (k0 >= 768) { col = F.in(33) + (size_t)l * 256 * 1024 + n0 + (F.tid & 63); klo = 768; } else if (k0 >= 512) { col = F.in(32) + (size_t)l * 256 * 1024 + n0 + (F.tid & 63); klo = 512; } else khi = 512; }
        float v[8];
#pragma unroll
        for (int i = 0; i < 8; ++i) { const int k = k0 + (F.tid >> 6) + 8 * i; v[i] = (col != nullptr && k >= klo && k < khi) ? col[(size_t)(k - klo) * ld] : 0.f; }
        __syncthreads();
#pragma unroll
        for (int i = 0; i < 8; ++i) tile[((F.tid >> 6) + 8 * i) * 65 + (F.tid & 63)] = v[i];
        __syncthreads();
        bf16_t* O = WSP(bf16_t, dst);
#pragma unroll
        for (int i = 0; i < 4; ++i) { const int ny = (F.tid >> 5) + 16 * i, kp = F.tid & 31; *(unsigned*)(O + (size_t)(n0 + ny) * K + k0 + 2 * kp) = pk2(tile[(2 * kp) * 65 + ny], tile[(2 * kp + 1) * 65 + ny]); }
    }
    __syncthreads();
}

__device__ __forceinline__ void norm_rows(const Frame& F, int nrows, const float* xin32, const bf16_t* xin16, const bf16_t* Y, const float* gy, bf16_t* X16, float* X32, float* X32hi, const float* gh, bf16_t* H) {
    constexpr int NR = 8;
    const int nw = F.G * 8;
    f32x4 gyv[4], ghv[4];
#pragma unroll
    for (int i = 0; i < 4; ++i) { const int o_ = (i >> 1) * 512 + F.lane * 8 + (i & 1) * 4;
        gyv[i] = Y ? *(const f32x4*)(gy + o_) : (f32x4){0.f, 0.f, 0.f, 0.f}; ghv[i] = H ? *(const f32x4*)(gh + o_) : (f32x4){0.f, 0.f, 0.f, 0.f}; }
    for (int row0 = F.bid * 8 + F.wave; row0 < nrows; row0 += NR * nw) {
        f32x4 xf[NR][4]; u32x2 xr[NR][4], yr[NR][4];
#pragma unroll
        for (int q = 0; q < NR; ++q) {
            const int row = row0 + q * nw < nrows ? row0 + q * nw : row0;
#pragma unroll
            for (int i2 = 0; i2 < 2; ++i2) {
                const size_t o_ = (size_t)row * 1024 + i2 * 512 + F.lane * 8;
                if (xin32) { xf[q][2 * i2] = *(const f32x4*)(xin32 + o_); xf[q][2 * i2 + 1] = *(const f32x4*)(xin32 + o_ + 4); }
                else { const u32x4 w_ = *(const u32x4*)(xin16 + o_); xr[q][2 * i2] = (u32x2){w_.x, w_.y}; xr[q][2 * i2 + 1] = (u32x2){w_.z, w_.w}; }
                if (Y) { const u32x4 w_ = *(const u32x4*)(Y + o_); yr[q][2 * i2] = (u32x2){w_.x, w_.y}; yr[q][2 * i2 + 1] = (u32x2){w_.z, w_.w}; }
            }
        }
#pragma unroll
        for (int q = 0; q < NR; ++q) {
            const int row = row0 + q * nw;
            if (row < nrows) {
                f32x4 x[4];
#pragma unroll
                for (int i = 0; i < 4; ++i) x[i] = xin32 ? xf[q][i] : (f32x4){bflo(xr[q][i].x), bfhi(xr[q][i].x), bflo(xr[q][i].y), bfhi(xr[q][i].y)};
                if (Y) {
                    f32x4 y[4]; float ss = 0.f;
#pragma unroll
                    for (int i = 0; i < 4; ++i) { y[i] = (f32x4){bflo(yr[q][i].x), bfhi(yr[q][i].x), bflo(yr[q][i].y), bfhi(yr[q][i].y)}; ss += y[i][0] * y[i][0] + y[i][1] * y[i][1] + y[i][2] * y[i][2] + y[i][3] * y[i][3]; }
                    ss = wave_sum(ss); const float rs = rsqrtf(ss * (1.0f / 1024.0f) + 1e-6f);
#pragma unroll
                    for (int i = 0; i < 4; ++i) x[i] += y[i] * rs * gyv[i];
                }
                if (X16) {
#pragma unroll
                    for (int i2 = 0; i2 < 2; ++i2) { const u32x2 a_ = pg8::cvt4_bf16(x[2 * i2]), b_ = pg8::cvt4_bf16(x[2 * i2 + 1]); *(u32x4*)(X16 + (size_t)row * 1024 + i2 * 512 + F.lane * 8) = (u32x4){a_.x, a_.y, b_.x, b_.y}; }
                }
                if (X32) {
                    float* dst = row < TOK / 2 ? X32 + (size_t)row * 1024 : X32hi + (size_t)(row - TOK / 2) * 1024;
#pragma unroll
                    for (int i = 0; i < 4; ++i) *(f32x4*)(dst + (i >> 1) * 512 + F.lane * 8 + (i & 1) * 4) = x[i];
                }
                if (H) {
                    float ss = 0.f;
#pragma unroll
                    for (int i = 0; i < 4; ++i) ss += x[i][0] * x[i][0] + x[i][1] * x[i][1] + x[i][2] * x[i][2] + x[i][3] * x[i][3];
                    ss = wave_sum(ss); const float rs = rsqrtf(ss * (1.0f / 1024.0f) + 1e-6f);
#pragma unroll
                    for (int i2 = 0; i2 < 2; ++i2) { const f32x4 g0 = ghv[2 * i2], g1 = ghv[2 * i2 + 1];
                        const u32x2 a_ = pg8::cvt4_bf16(x[2 * i2] * rs * g0), b_ = pg8::cvt4_bf16(x[2 * i2 + 1] * rs * g1); *(u32x4*)(H + (size_t)row * 1024 + i2 * 512 + F.lane * 8) = (u32x4){a_.x, a_.y, b_.x, b_.y}; }
                }
            }
        }
    }
}

__device__ __forceinline__ void rwkv_lin_tile(const Frame& F, int l, int tile) {
    const bf16_t* ZR = WSP(const bf16_t, WS_ZR); bf16_t* LIN = WSP(bf16_t, WS_LIN);
    const float* mu = F.in(11) + (size_t)l * 1024 + 768;
    const int tk = F.tid >> 3, cg = F.tid & 7, row = tile * 64 + tk, t = row & 4095;
    u32x4 z[4], zp[4];
#pragma unroll
    for (int i = 0; i < 4; ++i) { z[i] = *(const u32x4*)(ZR + (size_t)row * 1024 + 768 + cg * 32 + i * 8); zp[i] = (u32x4){0u, 0u, 0u, 0u}; }
    if (t > 0) {
#pragma unroll
        for (int i = 0; i < 4; ++i) zp[i] = *(const u32x4*)(ZR + (size_t)(row - 1) * 1024 + 768 + cg * 32 + i * 8);
    }
#pragma unroll
    for (int i = 0; i < 4; ++i) {
        const f32x4 m0 = *(const f32x4*)(mu + cg * 32 + i * 8), m1 = *(const f32x4*)(mu + cg * 32 + i * 8 + 4);
        const unsigned zw[4] = {z[i].x, z[i].y, z[i].z, z[i].w}, pw[4] = {zp[i].x, zp[i].y, zp[i].z, zp[i].w}; float o[8];
#pragma unroll
        for (int j = 0; j < 8; ++j) { const float zz = (j & 1) ? bfhi(zw[j >> 1]) : bflo(zw[j >> 1]), pp = (j & 1) ? bfhi(pw[j >> 1]) : bflo(pw[j >> 1]); const float m = j < 4 ? m0[j & 3] : m1[j & 3];
            const float zs = zz + (pp - zz) * m; o[j] = cg < 2 ? tanh_fast(zs) : (cg < 4 ? zs : sigmoidf_(zs)); }
        u32x4 w; w.x = pk2(o[0], o[1]); w.y = pk2(o[2], o[3]); w.z = pk2(o[4], o[5]); w.w = pk2(o[6], o[7]);
        *(u32x4*)(LIN + (size_t)row * 256 + cg * 32 + i * 8) = w;
    }
}

__device__ __forceinline__ f32x4 mm16(const f32x4& XT, const f32x4& Y) {
    f32x4 z = {0.f, 0.f, 0.f, 0.f};
#pragma unroll
    for (int ks = 0; ks < 4; ++ks) z = __builtin_amdgcn_mfma_f32_16x16x4f32(XT[ks], Y[ks], z, 0, 0, 0);
    return z;
}
__device__ __forceinline__ void rwkv_chunk_prep(const Frame& F, int l, int ci) {
    const int bh = ci >> 8, c = ci & 255, b = bh >> 2, h = bh & 3, lane = F.lane, fr = lane & 15, fq = lane >> 4;
    LAS unsigned char* L = F.lds + F.wave * 9216;
    const bf16_t* ZR = WSP(const bf16_t, WS_ZR); const bf16_t* LW = WSP(const bf16_t, WS_LW); const bf16_t* LA = WSP(const bf16_t, WS_LA);
    const int ch = h * 64 + lane;
    const float* mu = F.in(11) + (size_t)l * 1024;
    const float mur = mu[ch], muk = mu[256 + ch], muv = mu[512 + ch], w0 = F.in(12)[l * 256 + ch], a0 = F.in(14)[l * 256 + ch], kkc = F.in(17)[l * 256 + ch], kac = F.in(18)[l * 256 + ch], rkc = F.in(19)[l * 256 + ch];
    const size_t row0 = (size_t)b * 4096 + c * 16;
    float pr = 0.f, pk = 0.f, pv = 0.f;
    if (c > 0) { pr = bf2f(ZR[(row0 - 1) * 1024 + ch]); pk = bf2f(ZR[(row0 - 1) * 1024 + 256 + ch]); pv = bf2f(ZR[(row0 - 1) * 1024 + 512 + ch]); }
    float gam = 1.0f; unsigned bT[8], kT[8], vT[8]; float* BON = WSP(float, WS_BONUS);
    float zr_[16], zk_[16], zv_[16], lw_[16], la_[16];
#pragma unroll
    for (int t = 0; t < 16; ++t) { const size_t row = row0 + t; zr_[t] = bf2f(ZR[row * 1024 + ch]); zk_[t] = bf2f(ZR[row * 1024 + 256 + ch]); zv_[t] = bf2f(ZR[row * 1024 + 512 + ch]);
        lw_[t] = bf2f(LW[row * 256 + ch]); la_[t] = bf2f(LA[row * 256 + ch]); }
    float bprev = 0.f, kprev = 0.f, vprev = 0.f;
#pragma unroll
    for (int t = 0; t < 16; ++t) {
        const float r = zr_[t] + (pr - zr_[t]) * mur, k = zk_[t] + (pk - zk_[t]) * muk, v = zv_[t] + (pv - zv_[t]) * muv; pr = zr_[t]; pk = zk_[t]; pv = zv_[t];
        const float u = w0 + lw_[t]; const float sp = fmaxf(-u, 0.f) + __logf(1.0f + __expf(-fabsf(u))); const float dec = __expf(-__expf(-sp - 0.5f));
        const float a = sigmoidf_(a0 + la_[t]);
        const float kkv = k * kkc; float n2 = row16_sum(kkv * kkv); n2 = xsum16(n2); n2 = xsum32(n2);
        const float kk = kkv * rsqrtf(fmaxf(n2, 1e-24f));
        const float kp = k * (1.0f + (a - 1.0f) * kac);
        float bon = row16_sum(r * kp * rkc); bon = xsum16(bon); bon = xsum32(bon);
        if (lane == 0) BON[(row0 + t) * 4 + h] = bon;
        const float gprev = gam; gam *= dec; const float ginv = __builtin_amdgcn_rcpf(gam);
        const float ah = -gprev * kk, bh_ = kk * a * ginv, kh = kp * ginv, rh = gam * r;
        *(LAS bf16_t*)(L + 0 * 2304 + t * 144 + lane * 2) = f2bf(ah); *(LAS bf16_t*)(L + 1 * 2304 + t * 144 + lane * 2) = f2bf(rh);
        *(LAS bf16_t*)(L + 2 * 2304 + t * 144 + lane * 2) = f2bf(bh_); *(LAS bf16_t*)(L + 3 * 2304 + t * 144 + lane * 2) = f2bf(kh);
        if (t & 1) { bT[t >> 1] = pk2(bprev, bh_); kT[t >> 1] = pk2(kprev, kh); vT[t >> 1] = pk2(vprev, v); } else { bprev = bh_; kprev = kh; vprev = v; }
    }
    {
        bf16_t* BKT = WSP(bf16_t, WS_CS_BKT) + ((size_t)ci * 64 + lane) * 32; bf16_t* VMT = WSP(bf16_t, WS_CS_VMT) + ((size_t)ci * 64 + lane) * 16;
        *(u32x4*)(BKT) = (u32x4){bT[0], bT[1], bT[2], bT[3]}; *(u32x4*)(BKT + 8) = (u32x4){bT[4], bT[5], bT[6], bT[7]};
        *(u32x4*)(BKT + 16) = (u32x4){kT[0], kT[1], kT[2], kT[3]}; *(u32x4*)(BKT + 24) = (u32x4){kT[4], kT[5], kT[6], kT[7]};
        *(u32x4*)(VMT) = (u32x4){vT[0], vT[1], vT[2], vT[3]}; *(u32x4*)(VMT + 8) = (u32x4){vT[4], vT[5], vT[6], vT[7]};
        WSP(float, WS_CS_GAM)[(size_t)ci * 64 + lane] = gam;
    }
    asm volatile("s_waitcnt lgkmcnt(0)" ::: "memory");
    {
        bf16_t* AR = WSP(bf16_t, WS_CS_AR) + (size_t)ci * 2048;
#pragma unroll
        for (int j = 0; j < 4; ++j) { const int e = lane + 64 * j, which = e >> 7, row = (e >> 3) & 15, c16 = e & 7;
            *(u32x4*)(AR + e * 8) = *(const LAS u32x4*)(L + which * 2304 + row * 144 + c16 * 16); }
    }
    bf16x8 Af[2], Rf[2], Bf[2], Kf[2];
#pragma unroll
    for (int ks = 0; ks < 2; ++ks) { Af[ks] = *(const LAS bf16x8*)(L + 0 * 2304 + fr * 144 + ks * 64 + fq * 16); Rf[ks] = *(const LAS bf16x8*)(L + 1 * 2304 + fr * 144 + ks * 64 + fq * 16);
        Bf[ks] = *(const LAS bf16x8*)(L + 2 * 2304 + fr * 144 + ks * 64 + fq * 16); Kf[ks] = *(const LAS bf16x8*)(L + 3 * 2304 + fr * 144 + ks * 64 + fq * 16); }
    f32x4 Pab = {0.f, 0.f, 0.f, 0.f}, PabT = Pab, Pak = Pab, Prb = Pab, Prk = Pab;
#pragma unroll
    for (int ks = 0; ks < 2; ++ks) { Pab = __builtin_amdgcn_mfma_f32_16x16x32_bf16(Af[ks], Bf[ks], Pab, 0, 0, 0); PabT = __builtin_amdgcn_mfma_f32_16x16x32_bf16(Bf[ks], Af[ks], PabT, 0, 0, 0);
        Pak = __builtin_amdgcn_mfma_f32_16x16x32_bf16(Af[ks], Kf[ks], Pak, 0, 0, 0); Prb = __builtin_amdgcn_mfma_f32_16x16x32_bf16(Rf[ks], Bf[ks], Prb, 0, 0, 0); Prk = __builtin_amdgcn_mfma_f32_16x16x32_bf16(Rf[ks], Kf[ks], Prk, 0, 0, 0); }
    f32x4 One = {0.f, 0.f, 0.f, 0.f};
#pragma unroll
    for (int r = 0; r < 4; ++r) { const int rho = 4 * fq + r;
        Pab[r] = fr < rho ? Pab[r] : 0.f; Pak[r] = fr < rho ? Pak[r] : 0.f; PabT[r] = rho < fr ? PabT[r] : 0.f; Prb[r] = fr <= rho ? Prb[r] : 0.f; Prk[r] = fr <= rho ? Prk[r] : 0.f; One[r] = fr == rho ? 1.f : 0.f; }
    {
        bf16_t* AAK = WSP(bf16_t, WS_CS_AAK) + (size_t)ci * 256; bf16_t* ARBK = WSP(bf16_t, WS_CS_ARBK) + (size_t)ci * 512;
#pragma unroll
        for (int r = 0; r < 4; ++r) { const int rho = 4 * fq + r; AAK[rho * 16 + fr] = f2bf(Pak[r]); ARBK[rho * 32 + fr] = f2bf(Prb[r]); ARBK[rho * 32 + 16 + fr] = f2bf(Prk[r]); }
    }
    const f32x4 A2 = mm16(PabT, Pab), A2T = mm16(Pab, PabT), A4 = mm16(A2T, A2), A4T = mm16(A2, A2T), A8 = mm16(A4T, A4);
    const f32x4 G1 = mm16(One + PabT, One + A2), G1T = mm16(One + A2, One + PabT), G2 = mm16(One + A4T, One + A8);
    const f32x4 Mm = mm16(G1T, G2);
    { float* MM = WSP(float, WS_CS_MM) + (size_t)ci * 256;
#pragma unroll
      for (int r = 0; r < 4; ++r) MM[(4 * fq + r) * 16 + fr] = Mm[r]; }
    asm volatile("s_waitcnt lgkmcnt(0)" ::: "memory");
}
constexpr int CS_AH = 0, CS_RH = 2304, CS_BKT = 4608, CS_VMT = 9728, CS_AAK = 11776, CS_ARBK = 12288, CS_MM = 13568, CS_GAM = 14848, CS_REC = 15360;
__device__ __forceinline__ void rwkv_chunk_scan(const Frame& F, int bh) {
    const int b = bh >> 2, h = bh & 3, lane = F.lane, fr = lane & 15, fq = lane >> 4, tid = F.tid;
    const bf16_t* AR = WSP(const bf16_t, WS_CS_AR) + (size_t)bh * 256 * 2048; const bf16_t* BKT = WSP(const bf16_t, WS_CS_BKT) + (size_t)bh * 256 * 2048;
    const bf16_t* VMT = WSP(const bf16_t, WS_CS_VMT) + (size_t)bh * 256 * 1024; const bf16_t* AAK = WSP(const bf16_t, WS_CS_AAK) + (size_t)bh * 256 * 256;
    const bf16_t* ARBK = WSP(const bf16_t, WS_CS_ARBK) + (size_t)bh * 256 * 512; const float* MMg = WSP(const float, WS_CS_MM) + (size_t)bh * 256 * 256; const float* GAM = WSP(const float, WS_CS_GAM) + (size_t)bh * 256 * 64;
    float* YS = WSP(float, WS_YSCAN);
    const unsigned char* g1; int l1, s1;
    if (tid < 256) { g1 = (const unsigned char*)AR + tid * 16; l1 = (tid >> 7) * 2304 + ((tid >> 3) & 15) * 144 + (tid & 7) * 16; s1 = 4096; }
    else { const int e = tid - 256; g1 = (const unsigned char*)BKT + e * 16; l1 = CS_BKT + (e >> 2) * 80 + (e & 3) * 16; s1 = 4096; }
    const unsigned char* g2 = (const unsigned char*)VMT; int l2 = 0, s2 = 0; const bool has2 = tid < 304;
    if (tid < 128) { g2 = (const unsigned char*)VMT + tid * 16; l2 = CS_VMT + (tid >> 1) * 32 + (tid & 1) * 16; s2 = 2048; }
    else if (tid < 160) { const int e = tid - 128; g2 = (const unsigned char*)AAK + e * 16; l2 = CS_AAK + (e >> 1) * 32 + (e & 1) * 16; s2 = 512; }
    else if (tid < 224) { const int e = tid - 160; g2 = (const unsigned char*)ARBK + e * 16; l2 = CS_ARBK + (e >> 2) * 80 + (e & 3) * 16; s2 = 1024; }
    else if (tid < 288) { const int e = tid - 224; g2 = (const unsigned char*)MMg + e * 16; l2 = CS_MM + (e >> 2) * 80 + (e & 3) * 16; s2 = 1024; }
    else if (tid < 304) { const int e = tid - 288; g2 = (const unsigned char*)GAM + e * 16; l2 = CS_GAM + e * 16; s2 = 256; }
    f32x4 S[4];
#pragma unroll
    for (int kt = 0; kt < 4; ++kt) S[kt] = (f32x4){0.f, 0.f, 0.f, 0.f};
    const int v0 = 16 * F.wave;
    u32x4 R0a, R0b = {0u, 0u, 0u, 0u}, R1a, R1b = {0u, 0u, 0u, 0u};
#define CS_LOAD(R, c) do { R##a = *(const u32x4*)(g1 + (size_t)(c) * s1); if (has2) R##b = *(const u32x4*)(g2 + (size_t)(c) * s2); } while (0)
#define CS_WRITE(R, buf) do { *(LAS u32x4*)(F.lds + (buf) * CS_REC + l1) = R##a; if (has2) *(LAS u32x4*)(F.lds + (buf) * CS_REC + l2) = R##b; } while (0)
#define CS_COMPUTE(buf, c) do { if (F.wave < 4) { const LAS unsigned char* B = F.lds + (buf) * CS_REC; \
        bf16x8 sp[2]; \
        _Pragma("unroll") for (int ks = 0; ks < 2; ++ks) sp[ks] = pg8::cvt8_bf16(S[2 * ks], S[2 * ks + 1]); \
        const u32x2 vmf = *(const LAS u32x2*)(B + CS_VMT + (v0 + fr) * 32 + fq * 8); \
        f32x4 wt = {0.f, 0.f, 0.f, 0.f}, yt = {0.f, 0.f, 0.f, 0.f}; \
        _Pragma("unroll") for (int ks = 0; ks < 2; ++ks) { \
            const u32x2 a0_ = *(const LAS u32x2*)(B + CS_AH + fr * 144 + (32 * ks + 4 * fq) * 2), a1_ = *(const LAS u32x2*)(B + CS_AH + fr * 144 + (32 * ks + 16 + 4 * fq) * 2); \
            const u32x2 r0_ = *(const LAS u32x2*)(B + CS_RH + fr * 144 + (32 * ks + 4 * fq) * 2), r1_ = *(const LAS u32x2*)(B + CS_RH + fr * 144 + (32 * ks + 16 + 4 * fq) * 2); \
            wt = __builtin_amdgcn_mfma_f32_16x16x32_bf16(__builtin_bit_cast(bf16x8, ((u32x4){a0_.x, a0_.y, a1_.x, a1_.y})), sp[ks], wt, 0, 0, 0); \
            yt = __builtin_amdgcn_mfma_f32_16x16x32_bf16(__builtin_bit_cast(bf16x8, ((u32x4){r0_.x, r0_.y, r1_.x, r1_.y})), sp[ks], yt, 0, 0, 0); } \
        { const u32x2 ak = *(const LAS u32x2*)(B + CS_AAK + fr * 32 + fq * 8); \
          wt = __builtin_amdgcn_mfma_f32_16x16x32_bf16(__builtin_bit_cast(bf16x8, ((u32x4){ak.x, ak.y, 0u, 0u})), __builtin_bit_cast(bf16x8, ((u32x4){vmf.x, vmf.y, 0u, 0u})), wt, 0, 0, 0); } \
        const f32x4 mrow = *(const LAS f32x4*)(B + CS_MM + fr * 80 + fq * 16); \
        f32x4 ut = {0.f, 0.f, 0.f, 0.f}; \
        _Pragma("unroll") for (int ks = 0; ks < 4; ++ks) ut = __builtin_amdgcn_mfma_f32_16x16x4f32(mrow[ks], wt[ks], ut, 0, 0, 0); \
        const u32x2 utp = pg8::cvt4_bf16(ut); const bf16x8 uv = __builtin_bit_cast(bf16x8, ((u32x4){utp.x, utp.y, vmf.x, vmf.y})); \
        { const u32x2 q0_ = *(const LAS u32x2*)(B + CS_ARBK + fr * 80 + fq * 8), q1_ = *(const LAS u32x2*)(B + CS_ARBK + fr * 80 + 32 + fq * 8); \
          yt = __builtin_amdgcn_mfma_f32_16x16x32_bf16(__builtin_bit_cast(bf16x8, ((u32x4){q0_.x, q0_.y, q1_.x, q1_.y})), uv, yt, 0, 0, 0); } \
        _Pragma("unroll") for (int r = 0; r < 4; ++r) YS[((size_t)b * 4096 + (c) * 16 + 4 * fq + r) * 256 + h * 64 + v0 + fr] = yt[r]; \
        _Pragma("unroll") for (int kt = 0; kt < 4; ++kt) { \
            const u32x2 b0_ = *(const LAS u32x2*)(B + CS_BKT + (16 * kt + fr) * 80 + fq * 8), b1_ = *(const LAS u32x2*)(B + CS_BKT + (16 * kt + fr) * 80 + 32 + fq * 8); \
            const f32x4 gm = *(const LAS f32x4*)(B + CS_GAM + (16 * kt + 4 * fq) * 4); \
            S[kt] = __builtin_amdgcn_mfma_f32_16x16x32_bf16(__builtin_bit_cast(bf16x8, ((u32x4){b0_.x, b0_.y, b1_.x, b1_.y})), uv, S[kt], 0, 0, 0) * gm; } } } while (0)
    CS_LOAD(R0, 0); CS_LOAD(R1, 1);
    __syncthreads();
    CS_WRITE(R0, 0); CS_LOAD(R0, 2);
    __syncthreads();
    for (int c = 0; c < 256; c += 2) {
        CS_COMPUTE(0, c);
        CS_WRITE(R1, 1); if (c + 3 < 256) CS_LOAD(R1, c + 3);
        __syncthreads();
        CS_COMPUTE(1, c + 1);
        if (c + 2 < 256) { CS_WRITE(R0, 0); if (c + 4 < 256) CS_LOAD(R0, c + 4); }
        __syncthreads();
    }
#undef CS_LOAD
#undef CS_WRITE
#undef CS_COMPUTE
}

__device__ __forceinline__ void rwkv_post(const Frame& F, int l) {
    const float* YS = WSP(const float, WS_YSCAN); const bf16_t* VMT = WSP(const bf16_t, WS_CS_VMT); const bf16_t* RG = WSP(const bf16_t, WS_RG); const float* BON = WSP(const float, WS_BONUS);
    bf16_t* YR = WSP(bf16_t, WS_YCAT) + 512;
    for (int ci = F.bid * 8 + F.wave; ci < 32 * 256; ci += F.G * 8) {
        const int bh = ci >> 8, c = ci & 255, b = bh >> 2, h = bh & 3, ch = h * 64 + F.lane;
        const float lnw = F.in(20)[l * 256 + ch], lnb = F.in(21)[l * 256 + ch];
        const u32x4 v0 = *(const u32x4*)(VMT + ((size_t)ci * 64 + F.lane) * 16), v1 = *(const u32x4*)(VMT + ((size_t)ci * 64 + F.lane) * 16 + 8);
        const unsigned vw[8] = {v0.x, v0.y, v0.z, v0.w, v1.x, v1.y, v1.z, v1.w};
        const size_t row0 = (size_t)b * 4096 + c * 16;
        float y[16], g[16], bo[16];
#pragma unroll
        for (int t = 0; t < 16; ++t) { y[t] = YS[(row0 + t) * 256 + ch]; g[t] = bf2f(RG[(row0 + t) * 256 + ch]); bo[t] = BON[(row0 + t) * 4 + h]; }
#pragma unroll
        for (int t = 0; t < 16; ++t) {
            const float mean = wave_sum(y[t]) * (1.0f / 64.0f); const float d = y[t] - mean; const float var = wave_sum(d * d) * (1.0f / 64.0f);
            const float yn = d * rsqrtf(var + 64e-5f) * lnw + lnb; const float v = (t & 1) ? bfhi(vw[t >> 1]) : bflo(vw[t >> 1]);
            YR[(row0 + t) * 1024 + ch] = f2bf((yn + bo[t] * v) * g[t]);
        }
    }
}

struct S5Coef { float are, aim; bf16x8 Bf[8]; };
__device__ __forceinline__ void s5_abar(const Frame& F, int l, int g, int p, float& are, float& aim, float& cre, float& cim) {
    const float lr = F.in(22)[(l * 16 + g) * 64 + p], li = F.in(23)[(l * 16 + g) * 64 + p], dt = expf(F.in(24)[l * 16 + g]);
    const float mag = expf(lr * dt); float sn, cs; sincosf(li * dt, &sn, &cs);
    are = mag * cs; aim = mag * sn;
    const float den = lr * lr + li * li; cre = ((are - 1.0f) * lr + aim * li) / den; cim = (aim * lr - (are - 1.0f) * li) / den;
}
__device__ __forceinline__ void s5_setup(const Frame& F, int l, int g, int lane, S5Coef& C) {
    float cre, cim; s5_abar(F, l, g, lane, C.are, C.aim, cre, cim);
    const int fr = lane & 15, fq = lane >> 4;
#pragma unroll
    for (int pt = 0; pt < 4; ++pt) {
        const int p = 16 * pt + fr; float are, aim, c_re, c_im; s5_abar(F, l, g, p, are, aim, c_re, c_im);
        u32x4 wr = {0u, 0u, 0u, 0u}, wi = {0u, 0u, 0u, 0u};
        if (fq < 2) {
            const float* bre = F.in(25) + ((size_t)(l * 16 + g) * 64 + p) * 16 + 8 * fq; const float* bim = F.in(26) + ((size_t)(l * 16 + g) * 64 + p) * 16 + 8 * fq;
            float re[8], im[8];
#pragma unroll
            for (int j = 0; j < 8; ++j) { re[j] = c_re * bre[j] - c_im * bim[j]; im[j] = c_re * bim[j] + c_im * bre[j]; }
            wr = (u32x4){pk2(re[0], re[1]), pk2(re[2], re[3]), pk2(re[4], re[5]), pk2(re[6], re[7])}; wi = (u32x4){pk2(im[0], im[1]), pk2(im[2], im[3]), pk2(im[4], im[5]), pk2(im[6], im[7])};
        }
        C.Bf[pt] = __builtin_bit_cast(bf16x8, wr); C.Bf[pt + 4] = __builtin_bit_cast(bf16x8, wi);
    }
}
template <int NSTEPS>
__device__ __forceinline__ void s5_stage_u(const bf16_t* ZS, int b, int g, int t0, LAS unsigned char* us, int lane) {
#pragma unroll
    for (int i = 0; i < NSTEPS / 32; ++i) { const int id = lane + 64 * i, step = id >> 1, hf = id & 1;
        const u32x4 v = *(const u32x4*)(ZS + ((size_t)(b * 4096 + t0 + step) * 256 + g * 16 + hf * 8));
        *(LAS u32x4*)(us + id * 16) = v; }
    asm volatile("s_waitcnt vmcnt(0) lgkmcnt(0)" ::: "memory");
}
__device__ __forceinline__ void s5_project16(const S5Coef& C, const LAS unsigned char* us16, LAS unsigned* bu, int fr, int fq) {
    u32x4 a = {0u, 0u, 0u, 0u};
    if (fq < 2) a = *(const LAS u32x4*)(us16 + fr * 32 + fq * 16);
    const bf16x8 af = __builtin_bit_cast(bf16x8, a);
    f32x4 c[8];
#pragma unroll
    for (int i = 0; i < 8; ++i) { const int nt = (i >> 1) + 4 * (i & 1);
        c[nt] = __builtin_amdgcn_mfma_f32_16x16x32_bf16(af, C.Bf[nt], (f32x4){0.f, 0.f, 0.f, 0.f}, 0, 0, 0); }
    asm volatile("s_nop 15\n\ts_nop 15\n\ts_nop 15\n\ts_nop 15\n\ts_nop 15\n\ts_nop 15\n\ts_nop 15\n\ts_nop 15\n\ts_nop 15\n\ts_nop 15" : "+v"(c[0]), "+v"(c[1]), "+v"(c[2]), "+v"(c[3]), "+v"(c[4]), "+v"(c[5]), "+v"(c[6]), "+v"(c[7]));
    unsigned w[16];
#pragma unroll
    for (int pt = 0; pt < 4; ++pt)
#pragma unroll
        for (int r = 0; r < 4; ++r) w[pt * 4 + r] = pg8::cvt_pk_bf16(c[pt][r], c[pt + 4][r]);
    asm volatile("" : "+v"(w[0]), "+v"(w[1]), "+v"(w[2]), "+v"(w[3]), "+v"(w[4]), "+v"(w[5]), "+v"(w[6]), "+v"(w[7]), "+v"(w[8]), "+v"(w[9]), "+v"(w[10]), "+v"(w[11]), "+v"(w[12]), "+v"(w[13]), "+v"(w[14]), "+v"(w[15]));
#pragma unroll
    for (int pt = 0; pt < 4; ++pt)
#pragma unroll
        for (int r = 0; r < 4; ++r) bu[(4 * fq + r) * 64 + 16 * pt + fr] = w[pt * 4 + r];
    asm volatile("s_waitcnt lgkmcnt(0)" : "+v"(w[0]), "+v"(w[1]), "+v"(w[2]), "+v"(w[3]), "+v"(w[4]), "+v"(w[5]), "+v"(w[6]), "+v"(w[7]), "+v"(w[8]), "+v"(w[9]), "+v"(w[10]), "+v"(w[11]), "+v"(w[12]), "+v"(w[13]), "+v"(w[14]), "+v"(w[15]) :: "memory");
}
__device__ __forceinline__ void s5_pass1(const Frame& F, int l, int item) {
    const int b = item >> 8, g = (item >> 4) & 15, ch = item & 15, p = F.lane, fr = F.lane & 15, fq = F.lane >> 4;
    LAS unsigned char* us = F.lds + F.wave * 12288;
    LAS unsigned* bu = (LAS unsigned*)(us + 8192);
    S5Coef C; s5_setup(F, l, g, F.lane, C);
    s5_stage_u<256>(WSP(const bf16_t, WS_ZS), b, g, ch * 256, us, F.lane);
    float xr = 0.f, xi = 0.f;
    for (int t16 = 0; t16 < 16; ++t16) {
        s5_project16(C, us + t16 * 512, bu, fr, fq);
#pragma unroll
        for (int q = 0; q < 16; ++q) { const unsigned v = bu[q * 64 + p]; const float nr = C.are * xr - C.aim * xi + bflo(v), ni = C.are * xi + C.aim * xr + bfhi(v); xr = nr; xi = ni; }
        asm volatile("s_waitcnt lgkmcnt(0)" ::: "memory");
    }
    *(f32x2*)(WSP(float, WS_XEND) + ((size_t)((b * 16 + g) * 16 + ch) * 64 + p) * 2) = (f32x2){xr, xi};
}
__device__ __forceinline__ void s5_pass2(const Frame& F, int l, int item) {
    const int b = item >> 8, g = (item >> 4) & 15, ch = item & 15, p = F.lane, fr = F.lane & 15, fq = F.lane >> 4;
    LAS unsigned char* us = F.lds + F.wave * 12544;
    LAS unsigned* bu = (LAS unsigned*)(us + 4096); LAS unsigned char* xs = us + 8192;
    S5Coef C; s5_setup(F, l, g, F.lane, C);
    bf16x8 cb[4];
    {
        const float* cre = F.in(27) + ((size_t)(l * 16 + g) * 16 + fr) * 64; const float* cim = F.in(28) + ((size_t)(l * 16 + g) * 16 + fr) * 64;
#pragma unroll
        for (int ks = 0; ks < 4; ++ks) { const float* src = (ks < 2 ? cre : cim) + (ks & 1) * 32 + 8 * fq; const f32x4 a0 = *(const f32x4*)src, a1 = *(const f32x4*)(src + 4); const float sg = ks < 2 ? 1.f : -1.f;
            u32x4 w; w.x = pk2(sg * a0[0], sg * a0[1]); w.y = pk2(sg * a0[2], sg * a0[3]); w.z = pk2(sg * a1[0], sg * a1[1]); w.w = pk2(sg * a1[2], sg * a1[3]); cb[ks] = __builtin_bit_cast(bf16x8, w); }
    }
    float ar = C.are, ai = C.aim;
#pragma unroll
    for (int i = 0; i < 8; ++i) { const float nr = ar * ar - ai * ai, ni = 2.f * ar * ai; ar = nr; ai = ni; }
    float xr = 0.f, xi = 0.f;
    const float* XE = WSP(const float, WS_XEND) + ((size_t)((b * 16 + g) * 16) * 64 + p) * 2;
    for (int c2 = 0; c2 < ch; ++c2) { const f32x2 e = *(const f32x2*)(XE + (size_t)c2 * 128); const float nr = ar * xr - ai * xi + e[0], ni = ar * xi + ai * xr + e[1]; xr = nr; xi = ni; }
    bf16_t* YG = WSP(bf16_t, WS_YS5G);
    const float dcoef = F.in(29)[(l * 16 + g) * 16 + fr];
    for (int t16 = 0; t16 < 16; ++t16) {
        if ((t16 & 7) == 0) s5_stage_u<128>(WSP(const bf16_t, WS_ZS), b, g, ch * 256 + t16 * 16, us, F.lane);
        const LAS unsigned char* us16 = us + (t16 & 7) * 512;
        s5_project16(C, us16, bu, fr, fq);
#pragma unroll
        for (int q = 0; q < 16; ++q) { const unsigned v = bu[q * 64 + p]; const float nr = C.are * xr - C.aim * xi + bflo(v), ni = C.are * xi + C.aim * xr + bfhi(v); xr = nr; xi = ni;
            *(LAS bf16_t*)(xs + q * 272 + p * 2) = f2bf(xr); *(LAS bf16_t*)(xs + q * 272 + 128 + p * 2) = f2bf(xi); }
        asm volatile("s_waitcnt lgkmcnt(0)" ::: "memory");
        f32x4 acc = {0.f, 0.f, 0.f, 0.f};
#pragma unroll
        for (int ks = 0; ks < 4; ++ks) { const bf16x8 af = *(const LAS bf16x8*)(xs + fr * 272 + ks * 64 + fq * 16); acc = __builtin_amdgcn_mfma_f32_16x16x32_bf16(af, cb[ks], acc, 0, 0, 0); }
#pragma unroll
        for (int r = 0; r < 4; ++r) { const int st = 4 * fq + r; const float u = bf2f(*(const LAS bf16_t*)(us16 + st * 32 + fr * 2));
            YG[(size_t)(b * 4096 + ch * 256 + t16 * 16 + st) * 256 + g * 16 + fr] = f2bf(gelu_tanh(acc[r] + dcoef * u)); }
        asm volatile("s_waitcnt lgkmcnt(0)" ::: "memory");
    }
}

__device__ __forceinline__ void cmp_bias(const Frame& F, int l, int w) {
    const int kv = w >> 5, part = w & 31;
    const float* pos = F.in(kv ? 6 : 5) + (size_t)l * 2048; const float* w1 = F.in(kv ? 9 : 7) + (size_t)l * 2048 * 256;
    LAS float* red = (LAS float*)F.lds;
    __syncthreads();
    const int j = F.tid & 255, hf = F.tid >> 8; float s = 0.f;
#pragma unroll 8
    for (int ii = 0; ii < 32; ++ii) { const int i = part * 64 + hf * 32 + ii; s += pos[i] * w1[(size_t)i * 256 + j]; }
    red[F.tid] = s;
    __syncthreads();
    if (F.tid < 256) WSP(float, WS_CBIAS)[(size_t)w * 256 + F.tid] = red[F.tid] + red[F.tid + 256];
    __syncthreads();
}
__device__ __forceinline__ void cmp_finalize(const Frame& F, int l, int tile0, int ntiles_total) {
    LAS float* biasL = (LAS float*)(F.lds + 98304);
    const int pair = F.wave >> 1, hw = F.wave & 1;
    LAS unsigned char* hb = F.lds + pair * 8448;
    const int fr = F.lane & 15, fq = F.lane >> 4;
    __syncthreads();
    { const float* part = WSP(const float, WS_CBIAS) + (size_t)(F.tid >> 8) * 32 * 256 + (F.tid & 255); float sb = 0.f;
#pragma unroll 8
      for (int q = 0; q < 32; ++q) sb += part[q * 256];
      biasL[F.tid] = sb; }
    __syncthreads();
    const int tile = tile0 + pair; const bool live = tile < ntiles_total;
    const int kv = (tile >> 8) & 1, bg = (tile >> 4) & 15, n0 = (tile & 15) * 16;
    if (live) {
        const bf16_t* PQ = WSP(const bf16_t, WS_PQ + (size_t)kv * 4 * MiB); const LAS float* bias = biasL + kv * 256;
        const int r = F.lane >> 2, c0 = hw * 128 + (F.lane & 3) * 32, n = n0 + r;
#pragma unroll
        for (int i = 0; i < 4; ++i) {
            unsigned z_ = 0u; asm volatile("" : "+v"(z_)); u32x4 w = {z_, z_, z_, z_};
            if (n < 255) { const u32x4 p = *(const u32x4*)(PQ + (size_t)(bg * 256 + n) * 512 + c0 + 8 * i), q = *(const u32x4*)(PQ + (size_t)(bg * 256 + n + 1) * 512 + 256 + c0 + 8 * i);
                const unsigned pw[4] = {p.x, p.y, p.z, p.w}, qw[4] = {q.x, q.y, q.z, q.w}; unsigned ow[4];
#pragma unroll
                for (int j = 0; j < 4; ++j) { const float h0 = gelu_tanh(bflo(pw[j]) + bflo(qw[j]) + bias[c0 + 8 * i + 2 * j]), h1 = gelu_tanh(bfhi(pw[j]) + bfhi(qw[j]) + bias[c0 + 8 * i + 2 * j + 1]); ow[j] = pk2(h0, h1); }
                w = (u32x4){ow[0], ow[1], ow[2], ow[3]}; }
            *(LAS u32x4*)(hb + r * 528 + (c0 + 8 * i) * 2) = w; }
    }
    __syncthreads();
    if (live) {
        const bf16_t* W2T = WSP(const bf16_t, kv ? W_C2V : W_C2K);
        f32x4 acc[2];
#pragma unroll
        for (int j = 0; j < 2; ++j) acc[j] = (f32x4){0.f, 0.f, 0.f, 0.f};
#pragma unroll
        for (int ks = 0; ks < 8; ++ks) { const bf16x8 af = *(const LAS bf16x8*)(hb + fr * 528 + (32 * ks + 8 * fq) * 2);
#pragma unroll
            for (int j = 0; j < 2; ++j) { const int nt = 2 * hw + j; const bf16x8 bf = *(const bf16x8*)(W2T + (size_t)(16 * nt + fr) * 256 + 32 * ks + 8 * fq); acc[j] = __builtin_amdgcn_mfma_f32_16x16x32_bf16(af, bf, acc[j], 0, 0, 0); } }
#pragma unroll
        for (int j = 0; j < 2; ++j)
#pragma unroll
            for (int r = 0; r < 4; ++r) { const int n = n0 + 4 * fq + r, ch = 16 * (2 * hw + j) + fr; const bf16_t o = f2bf(acc[j][r]);
                if (kv == 0) WSP(bf16_t, WS_KCC)[(size_t)(bg * 256 + n) * 64 + ch] = o; else WSP(bf16_t, WS_VCCT)[(size_t)(bg * 64 + ch) * 256 + vperm(n)] = o; }
    }
    __syncthreads();
}

struct AttnAcc { float m[2], l[2]; f32x4 o[2][4]; };
__device__ __forceinline__ void attn_init(AttnAcc& a) {
#pragma unroll
    for (int mt = 0; mt < 2; ++mt) { a.m[mt] = -1e30f; a.l[mt] = 0.f;
#pragma unroll
        for (int dt = 0; dt < 4; ++dt) a.o[mt][dt] = (f32x4){0.f, 0.f, 0.f, 0.f}; }
}
constexpr int KP = 160, VP = 160;
constexpr int TB_K0 = 0, TB_V0 = 10240, TB_K1 = 20480, TB_V1 = 30720, TB_END = 40960;
struct MaskInfo { int qb; int tq[2]; int nmax[2]; u64 selm[2]; };
template <int KIND> __device__ __forceinline__ bool mask_el(const MaskInfo& M, int mt, int tile, int kl) {
    if (KIND == 0) return tile * 64 + kl <= M.nmax[mt];
    if (KIND == 1) return kl <= M.tq[mt];
    if (KIND == 2) return tile == M.qb ? (kl <= M.tq[mt]) : (kl > M.tq[mt]);
    return true;
}
template <int MODE, int KIND, bool MASKED, int MT0 = 0, int MT1 = 2>
__device__ __forceinline__ void attn_tile(const LAS unsigned char* Kt, const LAS unsigned char* Vt, const bf16x8 (&qf)[2][2], AttnAcc& a, const MaskInfo& M, int tile, float cexp,
                                          int fr, int fq, LAS float* impA, LAS float* impB, int qbase) {
    f32x4 s[2][4];
#pragma unroll
    for (int nt = 0; nt < 4; ++nt) {
        const bf16x8 k0 = *(const LAS bf16x8*)(Kt + (16 * nt + fr) * KP + fq * 16), k1 = *(const LAS bf16x8*)(Kt + (16 * nt + fr) * KP + 64 + fq * 16);
#pragma unroll
        for (int mt = MT0; mt < MT1; ++mt) { f32x4 z = {0.f, 0.f, 0.f, 0.f}; z = __builtin_amdgcn_mfma_f32_16x16x32_bf16(k0, qf[mt][0], z, 0, 0, 0); z = __builtin_amdgcn_mfma_f32_16x16x32_bf16(k1, qf[mt][1], z, 0, 0, 0); s[mt][nt] = z;
#if PROBE_MFMA2X
            if (MODE == 0) { f32x4 z2 = {1.f, 0.f, 0.f, 0.f}; z2 = __builtin_amdgcn_mfma_f32_16x16x32_bf16(k1, qf[mt][0], z2, 0, 0, 0); z2 = __builtin_amdgcn_mfma_f32_16x16x32_bf16(k0, qf[mt][1], z2, 0, 0, 0); asm volatile("" :: "v"(z2)); }
#endif
        }
    }
#pragma unroll
    for (int mt = MT0; mt < MT1; ++mt) {
        bool flag = true;
        if (KIND == 1) flag = ((M.selm[mt] >> tile) & 1ull) != 0ull;
        float mx = -1e30f;
#pragma unroll
        for (int nt = 0; nt < 4; ++nt)
#pragma unroll
            for (int r = 0; r < 4; ++r) { float v = s[mt][nt][r]; if (MASKED) { v = mask_el<KIND>(M, mt, tile, 16 * nt + 4 * fq + r) ? v : -1e30f; s[mt][nt][r] = v; } mx = fmaxf(mx, v); }
        if (MODE != 2) {
            mx = xmax16(mx); mx = xmax32(mx);
            mx = flag ? mx : -1e30f;
            const float mnew = fmaxf(a.m[mt], mx), alpha = __builtin_amdgcn_exp2f((a.m[mt] - mnew) * cexp); a.m[mt] = mnew;
            const float mc = (flag && mnew > -1e29f) ? mnew * cexp : 1e30f;
            float ps = 0.f;
#pragma unroll
            for (int nt = 0; nt < 4; ++nt)
#pragma unroll
                for (int r = 0; r < 4; ++r) { const float pv = __builtin_amdgcn_exp2f(__builtin_fmaf(s[mt][nt][r], cexp, -mc));
#if PROBE_EXP2X
                    { float dummy = __builtin_amdgcn_exp2f(__builtin_fmaf(s[mt][nt][r], cexp * 0.5f, -mc)); asm volatile("" :: "v"(dummy)); }
#endif
                    s[mt][nt][r] = pv; ps += pv; }
            a.l[mt] = a.l[mt] * alpha + ps;
            if (MODE == 0) {
                if (__ballot(alpha != 1.0f) != 0ull) {
#pragma unroll
                    for (int dt = 0; dt < 4; ++dt) a.o[mt][dt] *= alpha;
                }
            }
        } else {
            const float mc = a.m[mt] > -1e29f ? a.m[mt] * cexp : 1e30f;
#pragma unroll
            for (int nt = 0; nt < 4; ++nt) {
#pragma unroll
                for (int r = 0; r < 4; ++r) s[mt][nt][r] = __builtin_amdgcn_exp2f(__builtin_fmaf(s[mt][nt][r], cexp, -mc)) * a.l[mt];
                float A4 = (s[mt][nt][0] + s[mt][nt][1]) + (s[mt][nt][2] + s[mt][nt][3]), B1 = s[mt][nt][3];
                A4 = quad_sum(A4); B1 = quad_sum(B1);
                if ((fr & 3) == 0) { const int ql = qbase + ((fr + 16 * mt) >> 2), J = 16 * tile + 4 * nt + fq; impA[ql * 64 + J] = A4; impB[ql * 64 + J] = B1; }
            }
        }
    }
    if (MODE != 1) {
#pragma unroll
        for (int ks = 0; ks < 2; ++ks) {
            bf16x8 pb[2];
#pragma unroll
            for (int mt = MT0; mt < MT1; ++mt) {
                const f32x4 p0 = s[mt][2 * ks], p1 = s[mt][2 * ks + 1];
                pb[mt] = pg8::cvt8_bf16(p0, p1);
            }
#pragma unroll
            for (int dt = 0; dt < 4; ++dt) {
                const bf16x8 vf = *(const LAS bf16x8*)(Vt + (16 * dt + fr) * VP + (32 * ks + 8 * fq) * 2);
#pragma unroll
                for (int mt = MT0; mt < MT1; ++mt) a.o[mt][dt] = __builtin_amdgcn_mfma_f32_16x16x32_bf16(vf, pb[mt], a.o[mt][dt], 0, 0, 0);
            }
        }
    }
}
template <int KIND> __device__ __forceinline__ bool tile_masked(int qb, int tile) {
    if (KIND == 0) { const int t0 = qb * 64; const int nmin = t0 >= 31 ? ((t0 - 31) >> 4) : -1; return tile * 64 + 63 > nmin; }
    if (KIND == 1) return tile == qb;
    if (KIND == 2) return tile == qb || tile == qb - 8;
    return false;
}
__device__ __forceinline__ int pop_tile(u64& m) { if (m == 0ull) return -1; const int t = __builtin_ctzll(m); m &= m - 1ull; return t; }
template <int MODE, int KIND>
__device__ __forceinline__ void attn_run(const Frame& F, u64 tmask, const bf16_t* Kb, const bf16_t* Vb, int vstride, const bf16x8 (&qf)[2][2], AttnAcc& a, const MaskInfo& M,
                                         LAS float* impA, LAS float* impB, int qbase) {
    const int fr = F.lane & 15, fq = F.lane >> 4, lr = F.tid >> 3, lc = F.tid & 7;
    const float cexp = 0.125f * 1.4426950408889634f;
    if (tmask == 0ull) return;
    const unsigned kofs = (unsigned)(lr * 64 + lc * 8), vofs = (unsigned)(lr * vstride + lc * 8);
    const int kl = lr * KP + lc * 16, vl = lr * VP + lc * 16;
#define AT_LOAD(R, t) do { R##k = *(const u32x4*)(Kb + (kofs + (unsigned)(t) * 4096u)); if (MODE != 1) R##v = *(const u32x4*)(Vb + (vofs + (unsigned)(t) * 64u)); } while (0)
#define AT_WRITE(R, kb, vb) do { *(LAS u32x4*)(F.lds + (kb) + kl) = R##k; if (MODE != 1) *(LAS u32x4*)(F.lds + (vb) + vl) = R##v; } while (0)
#define AT_CALL(MSK, A0, A1) attn_tile<MODE, KIND, MSK, A0, A1>(F.lds + (kb_), F.lds + (vb_), qf, a, M, (t_), cexp, fr, fq, impA, impB, qbase)
#define AT_COMPUTE(kb, vb, t) do { const int kb_ = (kb), vb_ = (vb), t_ = (t); bool n0 = true, n1 = true; \
        if (KIND == 1) { n0 = __ballot(((M.selm[0] >> t_) & 1ull) != 0ull) != 0ull; n1 = __ballot(((M.selm[1] >> t_) & 1ull) != 0ull) != 0ull; } \
        if (tile_masked<KIND>(M.qb, t_)) { if (n0 || n1) AT_CALL(true, 0, 2); }                        \
        else if (KIND != 1 || (n0 && n1)) AT_CALL(false, 0, 2); \
        else if (n0) AT_CALL(false, 0, 1); \
        else if (n1) AT_CALL(false, 1, 2); } while (0)
    unsigned z0_ = 0u; asm volatile("" : "+v"(z0_));
    u32x4 R0k = {z0_, z0_, z0_, z0_}, R0v = R0k, R1k = R0k, R1v = R0k;
    int t0 = pop_tile(tmask), t1 = pop_tile(tmask), t2 = pop_tile(tmask), t3 = pop_tile(tmask);
    AT_LOAD(R0, t0);
    if (t1 >= 0) AT_LOAD(R1, t1);
    __syncthreads();
    AT_WRITE(R0, TB_K0, TB_V0);
    if (t2 >= 0) AT_LOAD(R0, t2);
    __syncthreads();
    for (;;) {
        AT_COMPUTE(TB_K0, TB_V0, t0);
        if (t1 < 0) break;
        AT_WRITE(R1, TB_K1, TB_V1);
        if (t3 >= 0) AT_LOAD(R1, t3);
        __syncthreads();
        t0 = t1; t1 = t2; t2 = t3; t3 = pop_tile(tmask);
        AT_COMPUTE(TB_K1, TB_V1, t0);
        if (t1 < 0) break;
        AT_WRITE(R0, TB_K0, TB_V0);
        if (t3 >= 0) AT_LOAD(R0, t3);
        __syncthreads();
        t0 = t1; t1 = t2; t2 = t3; t3 = pop_tile(tmask);
    }
    if (MODE != 1) asm volatile("s_nop 15\n\ts_nop 15\n\ts_nop 15\n\ts_nop 15\n\ts_nop 15\n\ts_nop 15\n\ts_nop 15\n\ts_nop 15"
                                : "+v"(a.o[0][0]), "+v"(a.o[0][1]), "+v"(a.o[0][2]), "+v"(a.o[0][3]), "+v"(a.o[1][0]), "+v"(a.o[1][1]), "+v"(a.o[1][2]), "+v"(a.o[1][3]));
#undef AT_LOAD
#undef AT_WRITE
#undef AT_COMPUTE
#undef AT_CALL
}

__device__ __forceinline__ void nsa_item(const Frame& F, int b, int g, int qb) {
    const int fr = F.lane & 15, fq = F.lane >> 4, t0 = qb * 64, qbase = 8 * F.wave;
    LAS float* impA = (LAS float*)(F.lds + 40960); LAS float* impB = (LAS float*)(F.lds + 40960 + 16384);
    LAS u64* selL = (LAS u64*)(F.lds + 106496); LAS u64* worL = (LAS u64*)(F.lds + 106496 + 512);
    const bf16_t* Q = WSP(const bf16_t, WS_Q); const bf16_t* NG = WSP(const bf16_t, WS_NG);
    const float* ropec = WSP(const float, WS_ROPE); const float* ropes = ropec + 4096 * 32;
    int ql[2]; const int r = fr & 3, head = g * 4 + r;
    bf16x8 qf[2][2];
    MaskInfo M; M.qb = qb;
#pragma unroll
    for (int mt = 0; mt < 2; ++mt) {
        ql[mt] = qbase + ((fr + 16 * mt) >> 2); M.tq[mt] = ql[mt]; const int t = t0 + ql[mt]; M.nmax[mt] = t >= 31 ? ((t - 31) >> 4) : -1; M.selm[mt] = 0ull;
#pragma unroll
        for (int ks = 0; ks < 2; ++ks) qf[mt][ks] = *(const bf16x8*)(Q + ((size_t)(b * 4096 + t) * 512 + head * 64 + ks * 32 + fq * 8));
    }
    LAS float* ysl = (LAS float*)(F.lds + 40960) + F.tid;
    const int ntc = (4 * qb + 2) / 64 + 1; const u64 cmask = (ntc >= 64) ? ~0ull : ((1ull << ntc) - 1ull);
    const bf16_t* KCc = WSP(const bf16_t, WS_KCC) + (size_t)((b * 2 + g) * 256) * 64; const bf16_t* VCt = WSP(const bf16_t, WS_VCCT) + (size_t)((b * 2 + g) * 64) * 256;
    AttnAcc a; attn_init(a);
    attn_run<1, 0>(F, cmask, KCc, VCt, 256, qf, a, M, impA, impB, qbase);
#pragma unroll
    for (int mt = 0; mt < 2; ++mt) { float L = a.l[mt]; L = xsum16(L); L = xsum32(L); a.l[mt] = L > 0.f ? 1.0f / L : 0.f; }
    attn_run<2, 0>(F, cmask, KCc, VCt, 256, qf, a, M, impA, impB, qbase);
    __syncthreads();
    {
        u64 wor = 0ull;
        if (qb < 16) {
            const u64 m = (2ull << qb) - 1ull;
            if (F.lane < 8) selL[qbase + F.lane] = m;
            wor = m;
        } else {
            const int J = F.lane; const bool valid = J <= qb, forced = (J == 0) || (J == qb) || (J == qb - 1);
            LAS unsigned* keytab = (LAS unsigned*)impA;
            unsigned mykey[8];
#pragma unroll
            for (int qi = 0; qi < 8; ++qi) { const int q = qbase + qi; const float val = impA[q * 64 + J] + (J > 0 ? impB[q * 64 + (J > 0 ? J - 1 : 0)] : 0.f);
                const unsigned k0 = forced ? 0x7f000000u : (val > 0.f ? __float_as_uint(val) : 0u);
                mykey[qi] = valid ? ((k0 & ~63u) | (unsigned)(63 - J)) : 0u; }
#pragma unroll
            for (int qi = 0; qi < 8; ++qi) keytab[(qbase + qi) * 64 + J] = mykey[qi];
            asm volatile("s_waitcnt lgkmcnt(0)" ::: "memory");
#pragma unroll
            for (int qi = 0; qi < 8; ++qi) {
                const LAS u32x4* row = (const LAS u32x4*)(keytab + (qbase + qi) * 64); int rank = 0;
#pragma unroll
                for (int j4 = 0; j4 < 16; ++j4) { const u32x4 k = row[j4]; rank += (int)(k.x > mykey[qi]) + (int)(k.y > mykey[qi]) + (int)(k.z > mykey[qi]) + (int)(k.w > mykey[qi]); }
                const u64 m = __ballot(valid && rank < 16);
                if (F.lane == 0) selL[qbase + qi] = m;
                wor |= m;
            }
        }
        if (F.lane == 0) worL[F.wave] = wor;
    }
    __syncthreads();
    u64 umask = 0ull;
#pragma unroll
    for (int w = 0; w < 8; ++w) umask |= worL[w];
    M.selm[0] = selL[ql[0]]; M.selm[1] = selL[ql[1]];
#pragma unroll
    for (int mt = 0; mt < 2; ++mt) { const float gt = sigmoidf_(bf2f(NG[(size_t)(b * 4096 + t0 + ql[mt]) * 32 + head * 3 + 0]));
#pragma unroll
        for (int dt = 0; dt < 4; ++dt)
#pragma unroll
            for (int r4 = 0; r4 < 4; ++r4) ysl[((mt * 4 + dt) * 4 + r4) * 512] = a.o[mt][dt][r4] * gt; }
#pragma unroll
    for (int mt = 0; mt < 2; ++mt) {
        const int t = t0 + ql[mt]; const f32x4 c0 = *(const f32x4*)(ropec + t * 32 + 8 * fq), c1 = *(const f32x4*)(ropec + t * 32 + 8 * fq + 4), s0 = *(const f32x4*)(ropes + t * 32 + 8 * fq), s1 = *(const f32x4*)(ropes + t * 32 + 8 * fq + 4);
        bf16x8 r1, r2;
#pragma unroll
        for (int j = 0; j < 8; ++j) { const float x1 = bf2f((bf16_t)qf[mt][0][j]), x2 = bf2f((bf16_t)qf[mt][1][j]); const float cs = j < 4 ? c0[j & 3] : c1[j & 3], sn = j < 4 ? s0[j & 3] : s1[j & 3];
            r1[j] = (short)f2bf(x1 * cs - x2 * sn); r2[j] = (short)f2bf(x1 * sn + x2 * cs); }
        qf[mt][0] = r1; qf[mt][1] = r2;
    }
    const size_t kvoff = (size_t)((b * 2 + g) * 4096) * 64, vtoff = (size_t)((b * 2 + g) * 64) * 4096;
    attn_init(a);
    attn_run<0, 1>(F, umask, WSP(const bf16_t, WS_KS) + kvoff, WSP(const bf16_t, WS_VST) + vtoff, 4096, qf, a, M, impA, impB, qbase);
#pragma unroll
    for (int mt = 0; mt < 2; ++mt) { float L = a.l[mt]; L = xsum16(L); L = xsum32(L);
        const float sc = (L > 0.f ? 1.0f / L : 0.f) * sigmoidf_(bf2f(NG[(size_t)(b * 4096 + t0 + ql[mt]) * 32 + head * 3 + 1]));
#pragma unroll
        for (int dt = 0; dt < 4; ++dt)
#pragma unroll
            for (int r4 = 0; r4 < 4; ++r4) ysl[((mt * 4 + dt) * 4 + r4) * 512] += a.o[mt][dt][r4] * sc; }
    const int wlo = qb >= 8 ? qb - 8 : 0; const u64 wmask = ((2ull << qb) - 1ull) & ~((1ull << wlo) - 1ull);
    attn_init(a);
    attn_run<0, 2>(F, wmask, WSP(const bf16_t, WS_KW) + kvoff, WSP(const bf16_t, WS_VWT) + vtoff, 4096, qf, a, M, impA, impB, qbase);
#pragma unroll
    for (int mt = 0; mt < 2; ++mt) { float L = a.l[mt]; L = xsum16(L); L = xsum32(L);
        const float sc = (L > 0.f ? 1.0f / L : 0.f) * sigmoidf_(bf2f(NG[(size_t)(b * 4096 + t0 + ql[mt]) * 32 + head * 3 + 2]));
#pragma unroll
        for (int dt = 0; dt < 4; ++dt)
#pragma unroll
            for (int r4 = 0; r4 < 4; ++r4) a.o[mt][dt][r4] = ysl[((mt * 4 + dt) * 4 + r4) * 512] + a.o[mt][dt][r4] * sc; }
    bf16_t* Y = WSP(bf16_t, WS_YCAT);
#pragma unroll
    for (int mt = 0; mt < 2; ++mt)
#pragma unroll
        for (int j = 0; j < 2; ++j) {
            const u32x2 p0 = pg8::cvt4_bf16(a.o[mt][2 * j]), p1 = pg8::cvt4_bf16(a.o[mt][2 * j + 1]);
            const auto rx = __builtin_amdgcn_permlane16_swap(p0.x, p1.x, false, false), ry = __builtin_amdgcn_permlane16_swap(p0.y, p1.y, false, false);
            const int col = (fq & 1) ? 16 * (2 * j + 1) + 4 * (fq - 1) : 16 * (2 * j) + 4 * fq;
            *(u32x4*)(Y + ((size_t)(b * 4096 + t0 + ql[mt]) * 1024 + head * 64 + col)) = (u32x4){rx[0], ry[0], rx[1], ry[1]}; }
    __syncthreads();
}

__device__ __forceinline__ void xa_item(const Frame& F, int item) {
    const int b = item >> 6, head = (item >> 4) & 3, qt = item & 15, fr = F.lane & 15, fq = F.lane >> 4, t0 = qt * 256 + 32 * F.wave;
    const bf16_t* QX = WSP(const bf16_t, WS_QX);
    bf16x8 qf[2][2];
#pragma unroll
    for (int mt = 0; mt < 2; ++mt)
#pragma unroll
        for (int ks = 0; ks < 2; ++ks) qf[mt][ks] = *(const bf16x8*)(QX + ((size_t)(b * 4096 + t0 + fr + 16 * mt) * 256 + head * 64 + ks * 32 + fq * 8));
    MaskInfo M; M.qb = 0; M.tq[0] = M.tq[1] = 0; M.nmax[0] = M.nmax[1] = 0; M.selm[0] = M.selm[1] = 0ull;
    AttnAcc a; attn_init(a);
    attn_run<0, 3>(F, 0xFull, WSP(const bf16_t, WS_KX) + (size_t)((b * 4 + head) * 256) * 64, WSP(const bf16_t, WS_VXT) + (size_t)((b * 4 + head) * 64) * 256, 256, qf, a, M, nullptr, nullptr, 0);
    bf16_t* O = WSP(bf16_t, WS_XAO);
#pragma unroll
    for (int mt = 0; mt < 2; ++mt) { float L = a.l[mt]; L = xsum16(L); L = xsum32(L); const float sc = L > 0.f ? 1.0f / L : 0.f;
#pragma unroll
        for (int j = 0; j < 2; ++j) {
            const u32x2 p0 = pg8::cvt4_bf16(a.o[mt][2 * j] * sc), p1 = pg8::cvt4_bf16(a.o[mt][2 * j + 1] * sc);
            const auto rx = __builtin_amdgcn_permlane16_swap(p0.x, p1.x, false, false), ry = __builtin_amdgcn_permlane16_swap(p0.y, p1.y, false, false);
            const int col = (fq & 1) ? 16 * (2 * j + 1) + 4 * (fq - 1) : 16 * (2 * j) + 4 * fq;
            *(u32x4*)(O + ((size_t)(b * 4096 + t0 + fr + 16 * mt) * 256 + head * 64 + col)) = (u32x4){rx[0], ry[0], rx[1], ry[1]}; } }
    __syncthreads();
}

template <class Fn> __device__ __forceinline__ void run_gemm(const Frame& F, const bf16_t* A, const bf16_t* Bt, int M, int N, int K, int G, int c, const Fn& fn) {
    pg8::Gemm g{A, Bt, M, N, K}; pg8::StaticOrder S; S.init(M, N, G, c); Epi8<Fn> E{fn};
    pg8::gemm_phase<Epi8<Fn>, pg8::StaticOrder>((PG8_LAS unsigned char*)F.lds, g, S, E, F.tid);
}

__global__ void __launch_bounds__(NTHR, 2) trunk_fwd(Params prm) {
    extern __shared__ __attribute__((aligned(16))) unsigned char lds_raw[];
    Frame F0; F0.kp = (const __attribute__((address_space(4))) char*)__builtin_amdgcn_kernarg_segment_ptr(); F0.ws = prm.ws; F0.lds = (LAS unsigned char*)lds_raw;
    F0.tid = threadIdx.x; F0.lane = F0.tid & 63; F0.wave = __builtin_amdgcn_readfirstlane(F0.tid >> 6); F0.bid = blockIdx.x; F0.G = gridDim.x;
    const int lo = prm.ph_lo, hi = prm.ph_hi;
    if (F0.tid < 8) ((LAS unsigned*)(F0.lds + LDS_CTL_OFF))[F0.tid] = 0u;
    __syncthreads();
    XcdBarrier bar; bar.bar = F0.ctl(); bar.x = 0; bar.st = nullptr;
    if (hi - lo > 1) bar = xcd_barrier_post(F0.ctl(), (volatile LAS unsigned*)(F0.lds + LDS_CTL_OFF));
#define IN(k) (lo <= (k) && (k) < hi)
#define SEAM(k) do { if (IN(k) && IN((k) + 1)) xcd_barrier(bar); } while (0)
#define PHASE_FRAME Frame F = F0; LAUNDER(F); asm volatile("" : "+s"(F.bid), "+s"(F.G), "+s"(F.wave)); \
    { int l_; asm volatile("v_mbcnt_lo_u32_b32 %0, -1, 0\n\tv_mbcnt_hi_u32_b32 %0, -1, %0" : "=v"(l_)); F.tid = F.wave * 64 + l_; } F.lane = F.tid & 63
    if (PON(0) && IN(0)) {
        PHASE_FRAME;
        float* rc = WSP(float, WS_ROPE); float* rs = rc + 4096 * 32;
        for (int i = F.bid * NTHR + F.tid; i < 4096 * 32; i += F.G * NTHR) { const int t = i >> 5, j = i & 31; const float inv = 1.0f / powf(10000.0f, (float)j / 32.0f); const float ang = (float)t * inv;
            float sn, cs; sincosf(ang, &sn, &cs); rc[i] = cs; rs[i] = sn; }
        conv_layer(F, 0);
        norm_rows(F, TOK, F.in(0), nullptr, nullptr, nullptr, F.x16(), nullptr, nullptr, F.in(2), WSP(bf16_t, WS_H));
    }
    SEAM(0);
    for (int l = 0; l < DEPTH; ++l) {
        const int g0 = 1 + l * PH_PER_LAYER;
        if (PON(1) && IN(g0 + 0)) for (int rep = 0; rep < REPS[1]; ++rep) {
            PHASE_FRAME;
            FIn1 fn{WSP(bf16_t, WS_Q), WSP(bf16_t, WS_KC), WSP(bf16_t, WS_VC), WSP(bf16_t, WS_KS), WSP(bf16_t, WS_KW), WSP(bf16_t, WS_VST), WSP(bf16_t, WS_VWT), WSP(bf16_t, WS_ZR), WSP(bf16_t, WS_ZS), WSP(bf16_t, WS_NG),
                    WSP(const float, WS_ROPE), WSP(const float, WS_ROPE) + 4096 * 32};
            run_gemm(F, WSP(const bf16_t, WS_H), WSP(const bf16_t, W_IN1), TOK, 2816, 1024, F.G, F.bid, fn);
            if (rep == 0 && F.G == 256 && F.bid >= 128 && F.bid < 192) { PHASE_FRAME; cmp_bias(F, l, F.bid - 128); }
        }
        SEAM(g0 + 0);
        if (PON(2) && IN(g0 + 1)) for (int rep = 0; rep < REPS[2]; ++rep) {
            { PHASE_FRAME;
              if (F.bid < 32) run_gemm(F, WSP(const bf16_t, WS_KC), WSP(const bf16_t, W_C1K), 4096, 512, 1024, 32, F.bid, FStore{WSP(bf16_t, WS_PQ), 512});
              else if (F.bid < 64) run_gemm(F, WSP(const bf16_t, WS_VC), WSP(const bf16_t, W_C1V), 4096, 512, 1024, 32, F.bid - 32, FStore{WSP(bf16_t, WS_PQ + 4 * MiB), 512});
              else if (F.bid < 128 && F.G != 256) cmp_bias(F, l, F.bid - 64); }
            for (;;) {
                PHASE_FRAME;
                const int job = next_job(F, F.ctl() + CTL_Q0 + 64 * ((l * 4 + 0) * 4 + rep));
                if (job >= 256 + 512) break;
                if (job < 256) s5_pass1(F, l, job * 8 + F.wave);
                else rwkv_lin_tile(F, l, job - 256);
            }
        }
        SEAM(g0 + 1);
        if (PON(3) && IN(g0 + 2)) for (int rep = 0; rep < REPS[3]; ++rep) {
            { PHASE_FRAME; run_gemm(F, WSP(const bf16_t, WS_LIN), WSP(const bf16_t, W_LORA), TOK, 768, 256, F.G, F.bid, FLora{WSP(bf16_t, WS_LW), WSP(bf16_t, WS_LA), WSP(bf16_t, WS_RG)}); }
            { PHASE_FRAME; if (F.G == 256) { if (F.bid >= 128) cmp_finalize(F, l, (F.bid - 128) * 4, 512); } else for (int t0_ = F.bid * 4; t0_ < 512; t0_ += F.G * 4) cmp_finalize(F, l, t0_, 512); }
        }
        SEAM(g0 + 2);
        if (PON(4) && IN(g0 + 3)) for (int rep = 0; rep < REPS[4]; ++rep) { PHASE_FRAME; __syncthreads(); for (int it = F.bid * 8 + F.wave; it < 32 * 256; it += F.G * 8) rwkv_chunk_prep(F, l, it); }
        SEAM(g0 + 3);
        if (PON(5) && IN(g0 + 4)) for (int rep = 0; rep < REPS[5]; ++rep) {
#if !defined(SUB) || SUB == 1
            if (F0.bid < 32) for (int ra = 0; ra < REP_P4A; ++ra) { PHASE_FRAME; rwkv_chunk_scan(F, F.bid); }
#endif
            for (int rq = 0; rq < REP_P4B; ++rq)
            for (;;) {
                PHASE_FRAME;
                const int job = next_job(F, F.ctl() + CTL_Q0 + 64 * ((l * 4 + 1) * 4 + rep * 2 + rq));
                if (job >= 1024 + 256) break;
#if !defined(SUB) || SUB == 2
                if (job < 1024) { const int qb = 63 - (job >> 4), bg = job & 15; for (int rr = 0; rr < REP_NSA; ++rr) nsa_item(F, bg >> 1, bg & 1, qb); }
#endif
#if !defined(SUB) || SUB == 3
                if (job >= 1024) { __syncthreads(); for (int rr = 0; rr < REP_S5P2; ++rr) s5_pass2(F, l, (job - 1024) * 8 + F.wave); }
#endif
            }
        }
        SEAM(g0 + 4);
        if (PON(6) && IN(g0 + 5)) for (int rep = 0; rep < REPS[6]; ++rep) {
#if !defined(SUB) || SUB == 1
            if (F0.bid < 128) { PHASE_FRAME; run_gemm(F, WSP(const bf16_t, WS_YS5G), WSP(const bf16_t, W_GLU), TOK, 256, 256, 128, F.bid, FGluMul{WSP(const bf16_t, WS_YS5G), WSP(bf16_t, WS_YCAT) + 768, 256, 1024}); }
#endif
#if !defined(SUB) || SUB == 2
            { PHASE_FRAME; rwkv_post(F, l); }
#endif
        }
        SEAM(g0 + 5);
        if (PON(7) && IN(g0 + 6)) for (int rep = 0; rep < REPS[7]; ++rep) {
            { PHASE_FRAME; run_gemm(F, WSP(const bf16_t, WS_H), WSP(const bf16_t, W_MG), TOK, 3072, 1024, F.G, F.bid, FSigmoid{WSP(bf16_t, WS_G), 3072}); }
        }
        SEAM(g0 + 6);
        if (PON(8) && IN(g0 + 7)) for (int rep = 0; rep < REPS[8]; ++rep) {
            { PHASE_FRAME;
              pg8::Gemm g{WSP(const bf16_t, WS_YCAT), WSP(const bf16_t, W_UPN), TOK, 1024, 1024}; pg8::StaticOrder S; S.init(TOK, 1024, F.G, F.bid);
              Epi8<FMulStore> E{FMulStore{WSP(const bf16_t, WS_G), WSP(bf16_t, WS_MERGED)}};
              MergeHook H{WSP(const bf16_t, WS_G)};
              pg8::gemm_phase<Epi8<FMulStore>, pg8::StaticOrder, MergeHook>((PG8_LAS unsigned char*)F.lds, g, S, E, F.tid, H); }
        }
        SEAM(g0 + 7);
        if (PON(9) && IN(g0 + 8)) for (int rep = 0; rep < REPS[9]; ++rep) { PHASE_FRAME; run_gemm(F, WSP(const bf16_t, WS_MERGED), WSP(const bf16_t, W_OUT), TOK, 1024, 1024, F.G, F.bid, FStore{WSP(bf16_t, WS_YOUT), 1024}); }
        SEAM(g0 + 8);
        if (PON(10) && IN(g0 + 9)) {
            PHASE_FRAME; const float* gains = F.in(2) + (size_t)l * 6 * 1024;
            norm_rows(F, TOK, nullptr, F.x16(), WSP(const bf16_t, WS_YOUT), gains + 1024, F.x16(), nullptr, nullptr, gains + 2048, WSP(bf16_t, WS_H));
            norm_rows(F, NB * 256, F.in(1), nullptr, nullptr, nullptr, nullptr, nullptr, nullptr, F.in(3) + (size_t)l * 1024, WSP(bf16_t, WS_MEMN));
        }
        SEAM(g0 + 9);
        if (PON(11) && IN(g0 + 10)) for (int rep = 0; rep < REPS[11]; ++rep) {
            PHASE_FRAME;
            if (F.bid < 128) run_gemm(F, WSP(const bf16_t, WS_H), WSP(const bf16_t, W_XQ), TOK, 256, 1024, 128, F.bid, FStore{WSP(bf16_t, WS_QX), 256});
            else if (F.bid < 144) run_gemm(F, WSP(const bf16_t, WS_MEMN), WSP(const bf16_t, W_XKV), NB * 256, 512, 1024, 16, F.bid - 128, FXKV{WSP(bf16_t, WS_KX), WSP(bf16_t, WS_VXT)});
        }
        SEAM(g0 + 10);
        if (PON(12) && IN(g0 + 11)) for (int rep = 0; rep < REPS[12]; ++rep) { PHASE_FRAME; for (int it = F.bid; it < 512; it += F.G) xa_item(F, it); }
        SEAM(g0 + 11);
        if (PON(13) && IN(g0 + 12)) for (int rep = 0; rep < REPS[13]; ++rep) { PHASE_FRAME; run_gemm(F, WSP(const bf16_t, WS_XAO), WSP(const bf16_t, W_XO), TOK, 1024, 256, F.G, F.bid, FStore{WSP(bf16_t, WS_YOUT), 1024}); }
        SEAM(g0 + 12);
        if (PON(14) && IN(g0 + 13)) { PHASE_FRAME; const float* gains = F.in(2) + (size_t)l * 6 * 1024;
            norm_rows(F, TOK, nullptr, F.x16(), WSP(const bf16_t, WS_YOUT), gains + 3 * 1024, l + 1 < DEPTH ? F.x16() : WSP(bf16_t, WS_XLAST), nullptr, nullptr, gains + 4 * 1024, WSP(bf16_t, WS_H)); }
        SEAM(g0 + 13);
        if (PON(15) && IN(g0 + 14)) for (int rep = 0; rep < REPS[15]; ++rep) { PHASE_FRAME; pg8::Gemm g{WSP(const bf16_t, WS_H), WSP(const bf16_t, W_GU), TOK, 2 * DFF, 1024}; pg8::StaticOrder S; S.init(TOK, 2 * DFF, F.G, F.bid); EpiSwiGLU16 E{WSP(bf16_t, WS_A2), DFF};
            pg8::gemm_phase<EpiSwiGLU16, pg8::StaticOrder>((PG8_LAS unsigned char*)F.lds, g, S, E, F.tid); }
        SEAM(g0 + 14);
        if (PON(16) && IN(g0 + 15)) for (int rep = 0; rep < REPS[16]; ++rep) { PHASE_FRAME; run_gemm(F, WSP(const bf16_t, WS_A2), WSP(const bf16_t, W_DN), TOK, 1024, DFF, F.G, F.bid, FStore{WSP(bf16_t, WS_YOUT), 1024}); }
        SEAM(g0 + 15);
        if (PON(17) && IN(g0 + 16)) {
            PHASE_FRAME; const float* gains = F.in(2) + (size_t)l * 6 * 1024;
            for (int rep = 1; rep < REPS[17]; ++rep) conv_layer(F, l);
            if (l + 1 < DEPTH) { norm_rows(F, TOK, nullptr, F.x16(), WSP(const bf16_t, WS_YOUT), gains + 5 * 1024, F.x16(), nullptr, nullptr, gains + 6 * 1024, WSP(bf16_t, WS_H)); conv_layer(F, l + 1); }
            else norm_rows(F, TOK, nullptr, WSP(const bf16_t, WS_XLAST), WSP(const bf16_t, WS_YOUT), gains + 5 * 1024, nullptr, F.out(), F.out() + (size_t)TOK * DM / 2, nullptr, nullptr);
        }
        SEAM(g0 + 16);
    }
#undef IN
#undef SEAM
}

extern "C" void kernel_launch(void* const* d_in, const int* in_sizes, int n_in, void* d_out, int out_size, void* d_ws, size_t ws_size, hipStream_t stream) {
    static int grid = 0;
    if (grid == 0) {
        if (n_in != 42 || out_size != TOK * DM || ws_size < WS_END) { fprintf(stderr, "kernel_launch: unexpected shapes (n_in %d out %d ws %zu)\n", n_in, out_size, ws_size); grid = -1; return; }
        int dev = 0, cus = 0, per_cu = 0;
        if (hipGetDevice(&dev) != hipSuccess || hipDeviceGetAttribute(&cus, hipDeviceAttributeMultiprocessorCount, dev) != hipSuccess) { grid = -1; return; }
        if (hipFuncSetAttribute((const void*)trunk_fwd, hipFuncAttributeMaxDynamicSharedMemorySize, LDS_BYTES) != hipSuccess) { fprintf(stderr, "kernel_launch: hipFuncSetAttribute failed\n"); grid = -1; return; }
        if (hipOccupancyMaxActiveBlocksPerMultiprocessor(&per_cu, (const void*)trunk_fwd, NTHR, LDS_BYTES) != hipSuccess || per_cu < 1) fprintf(stderr, "kernel_launch: occupancy query reports %d\n", per_cu);
        (void)hipGetLastError();
        grid = cus;
    }
    if (grid < 0) return;
    (void)hipMemsetAsync((char*)d_ws + WS_CTL, 0, CTL_BYTES, stream);
    Params p{};
    for (int i = 0; i < 42; ++i) p.in[i] = (const float*)d_in[i];
    p.out = (float*)d_out; p.ws = (unsigned char*)d_ws;
#if MK_N_LAUNCHES == 1
    p.ph_lo = 0; p.ph_hi = N_PHASES;
    hipLaunchKernelGGL(trunk_fwd, dim3(grid), dim3(NTHR), LDS_BYTES, stream, p);
#else
    for (int ph = 0; ph < N_PHASES; ++ph) { p.ph_lo = ph; p.ph_hi = ph + 1; hipLaunchKernelGGL(trunk_fwd, dim3(grid), dim3(NTHR), LDS_BYTES, stream, p); }
#endif
}
```
